# Optimizing an MI355X kernel written in HIP

```python
import jax, jax.numpy as jnp
from jax import lax
import numpy as np

D_MODEL = 1024
BATCH = 4
SEQ = 8192
DEPTH = 1

CHUNK = 64
Q_BLOCK = 2 * CHUNK
HEAD_DIM = 64
N_FOX_HEADS = 8
N_SB_HEADS = 8
FOX_WIDTH = N_FOX_HEADS * HEAD_DIM
SB_WIDTH = N_SB_HEADS * HEAD_DIM
MIX_WIDTH = FOX_WIDTH + SB_WIDTH
IN_COLS = 3 * FOX_WIDTH + N_FOX_HEADS + 3 * SB_WIDTH
PEER_HEADS = 8
PEER_N_KEYS = 128
PEER_N_EXPERTS = PEER_N_KEYS * PEER_N_KEYS
PEER_TOPK = 16
PEER_D_KEY = 256
PEER_HALF = PEER_D_KEY // 2
PEER_TOKEN_BLOCK = 128
N_MOD = 6
EPS = 1e-6

kernel_name = "hybrid_fox_stickbreak_peer_adaln_block"


def rms_norm(x, g):
    xf = x.astype(jnp.float32)
    inv = lax.rsqrt(jnp.mean(xf * xf, axis=-1, keepdims=True) + EPS)
    return (xf * inv).astype(x.dtype) * g


def split_heads(t, n_heads):
    b, s, _ = t.shape
    return t.reshape(b, s, n_heads, HEAD_DIM).transpose(0, 2, 1, 3)


def merge_blocks(o):
    nb, b, h, qb, dh = o.shape
    return o.transpose(1, 0, 3, 2, 4).reshape(b, nb * qb, h, dh)


def forgetting_attention(q, k, v, log_fcum):
    seq = q.shape[2]
    n_blocks = seq // Q_BLOCK
    scale = HEAD_DIM ** -0.5
    k_pos = jnp.arange(seq)

    def block(i):
        start = i * Q_BLOCK
        qb = lax.dynamic_slice_in_dim(q, start, Q_BLOCK, axis=2)
        fq = lax.dynamic_slice_in_dim(log_fcum, start, Q_BLOCK, axis=2)
        q_pos = start + jnp.arange(Q_BLOCK)
        logits = jnp.einsum('bhqd,bhkd->bhqk', qb, k, preferred_element_type=jnp.float32) * scale
        logits = logits + fq[..., :, None] - log_fcum[..., None, :]
        mask = k_pos[None, :] <= q_pos[:, None]
        logits = jnp.where(mask, logits, -jnp.inf)
        p = jax.nn.softmax(logits, axis=-1)
        return jnp.einsum('bhqk,bhkd->bhqd', p.astype(v.dtype), v)

    return merge_blocks(lax.map(block, jnp.arange(n_blocks)))


def stick_breaking_attention(q, k, v):
    seq = q.shape[2]
    n_blocks = seq // Q_BLOCK
    scale = HEAD_DIM ** -0.5
    k_pos = jnp.arange(seq)

    def block(i):
        start = i * Q_BLOCK
        qb = lax.dynamic_slice_in_dim(q, start, Q_BLOCK, axis=2)
        q_pos = start + jnp.arange(Q_BLOCK)
        z = jnp.einsum('bhqd,bhkd->bhqk', qb, k, preferred_element_type=jnp.float32) * scale
        mask = k_pos[None, :] < q_pos[:, None]
        log_beta = jax.nn.log_sigmoid(z)
        log_one_minus = jnp.where(mask, jax.nn.log_sigmoid(-z), 0.0)
        rest = lax.cumsum(log_one_minus, axis=3, reverse=True) - log_one_minus
        a = jnp.where(mask, jnp.exp(log_beta + rest), 0.0)
        return jnp.einsum('bhqk,bhkd->bhqd', a.astype(v.dtype), v)

    return merge_blocks(lax.map(block, jnp.arange(n_blocks)))


def peer_layer(h, w_query, sub_keys, expert_down, expert_up):
    b, s, d = h.shape
    t = b * s
    ht = h.reshape(t, d)
    query = (ht @ w_query).reshape(t, PEER_HEADS, 2, PEER_HALF)
    sub_scores = jnp.einsum('thpd,hpkd->thpk', query, sub_keys,
                            preferred_element_type=jnp.float32)
    half_vals, half_idx = lax.top_k(sub_scores, PEER_TOPK)
    cand = (half_vals[:, :, 0, :, None] + half_vals[:, :, 1, None, :]
            ).reshape(t, PEER_HEADS, PEER_TOPK * PEER_TOPK)
    top_vals, top_pos = lax.top_k(cand, PEER_TOPK)
    i1 = jnp.take_along_axis(half_idx[:, :, 0, :], top_pos // PEER_TOPK, axis=-1)
    i2 = jnp.take_along_axis(half_idx[:, :, 1, :], top_pos % PEER_TOPK, axis=-1)
    experts = i1 * PEER_N_KEYS + i2
    gates = jax.nn.softmax(top_vals, axis=-1).astype(h.dtype)

    n_blk = t // PEER_TOKEN_BLOCK
    xs = (ht.reshape(n_blk, PEER_TOKEN_BLOCK, d),
          experts.reshape(n_blk, PEER_TOKEN_BLOCK, PEER_HEADS, PEER_TOPK),
          gates.reshape(n_blk, PEER_TOKEN_BLOCK, PEER_HEADS, PEER_TOPK))

    def block(args):
        xb, eb, gb = args
        u = expert_down[eb]
        act = jax.nn.gelu(jnp.einsum('td,thkd->thk', xb, u), approximate=False) * gb
        vv = expert_up[eb]
        return jnp.einsum('thk,thkd->td', act, vv)

    return lax.map(block, xs).reshape(b, s, d)


def setup_inputs(seed: int = 0) -> dict:
    key = jax.random.key(seed)
    ks = jax.random.split(key, 17)
    nrm = jax.random.normal
    L, D = DEPTH, D_MODEL
    return {
        "x": nrm(ks[0], (BATCH, SEQ, D), jnp.float32),
        "c": nrm(ks[1], (BATCH, D), jnp.float32),
        "w_ada": nrm(ks[2], (L, D, N_MOD * D), jnp.float32) * D ** -0.5,
        "b_ada": 0.02 * nrm(ks[3], (L, N_MOD * D), jnp.float32),
        "g_norm_mix": 1.0 + 0.05 * nrm(ks[4], (L, D), jnp.float32),
        "w_in": nrm(ks[5], (L, D, IN_COLS), jnp.float32) * D ** -0.5,
        "b_forget": 1.5 + 0.5 * nrm(ks[6], (L, N_FOX_HEADS), jnp.float32),
        "g_out_fox": 1.0 + 0.05 * nrm(ks[7], (L, HEAD_DIM), jnp.float32),
        "g_out_sb": 1.0 + 0.05 * nrm(ks[8], (L, HEAD_DIM), jnp.float32),
        "w_out": nrm(ks[9], (L, MIX_WIDTH, D), jnp.float32) * MIX_WIDTH ** -0.5,
        "g_norm_ffn": 1.0 + 0.05 * nrm(ks[10], (L, D), jnp.float32),
        "w_query": nrm(ks[11], (L, D, PEER_HEADS * PEER_D_KEY), jnp.float32) * D ** -0.5,
        "sub_keys": nrm(ks[12], (L, PEER_HEADS, 2, PEER_N_KEYS, PEER_HALF), jnp.float32) * PEER_HALF ** -0.5,
        "expert_down": nrm(ks[13], (L, PEER_N_EXPERTS, D), jnp.float32) * D ** -0.5,
        "expert_up": nrm(ks[14], (L, PEER_N_EXPERTS, D), jnp.float32) * PEER_HEADS ** -0.5,
        "g_final": 1.0 + 0.05 * nrm(ks[15], (D,), jnp.float32),
    }


def reference(x, c, w_ada, b_ada, g_norm_mix, w_in, b_forget, g_out_fox, g_out_sb,
              w_out, g_norm_ffn, w_query, sub_keys, expert_down, expert_up, g_final):
    b, s, d = x.shape
    c_act = jax.nn.silu(c)
    for l in range(DEPTH):
        mod = c_act @ w_ada[l] + b_ada[l]
        sh1, sc1, gt1, sh2, sc2, gt2 = [m[:, None, :] for m in jnp.split(mod, N_MOD, axis=-1)]

        h = rms_norm(x, g_norm_mix[l]) * (1.0 + sc1) + sh1
        proj = h @ w_in[l]
        o1 = 3 * FOX_WIDTH
        o2 = o1 + N_FOX_HEADS
        fq, fk, fv = jnp.split(proj[..., :o1], 3, axis=-1)
        f_logit = proj[..., o1:o2]
        sq, sk, sv = jnp.split(proj[..., o2:], 3, axis=-1)

        log_f = jax.nn.log_sigmoid((f_logit + b_forget[l]).astype(jnp.float32))
        log_fcum = lax.cumsum(log_f, axis=1).transpose(0, 2, 1)
        fox_out = forgetting_attention(split_heads(fq, N_FOX_HEADS), split_heads(fk, N_FOX_HEADS),
                                       split_heads(fv, N_FOX_HEADS), log_fcum)
        sb_out = stick_breaking_attention(split_heads(sq, N_SB_HEADS), split_heads(sk, N_SB_HEADS),
                                          split_heads(sv, N_SB_HEADS))
        mixed = jnp.concatenate([rms_norm(fox_out, g_out_fox[l]).reshape(b, s, FOX_WIDTH),
                                 rms_norm(sb_out, g_out_sb[l]).reshape(b, s, SB_WIDTH)], axis=-1)
        x = x + gt1 * (mixed @ w_out[l])

        h2 = rms_norm(x, g_norm_ffn[l]) * (1.0 + sc2) + sh2
        x = x + gt2 * peer_layer(h2, w_query[l], sub_keys[l], expert_down[l], expert_up[l])
    return rms_norm(x, g_final)
```

```cpp
#include <hip/hip_runtime.h>
#include <hip/hip_cooperative_groups.h>
#include <cstdio>
#include <cstdint>
namespace cg = cooperative_groups;

#ifndef PROBE_DUP
#define PROBE_DUP -1
#endif

namespace pg8 {
#define PG8_LAS __attribute__((address_space(3)))
typedef unsigned short bf16_t;
typedef short bf16x8 __attribute__((ext_vector_type(8)));
typedef float f32x4 __attribute__((ext_vector_type(4)));
typedef unsigned u32x4 __attribute__((ext_vector_type(4)));
constexpr int BM = 256, BK = 64, HALF = 128, HTB = HALF * BK * 2  , STAGE_BYTES = 8 * HTB, NXCD = 8, WGM = 8;

__host__ __device__ __forceinline__ int lds_byte(int r, int c) { const int st = (r >> 4) * 2 + (c >> 5), rr = r & 15, cc = c & 31, ob = rr * 64 + cc * 2; return st * 1024 + (ob ^ (((ob >> 9) & 1) << 5)); }
__host__ __device__ __forceinline__ void stage_rc(int b, int& R, int& C) { const int st = b / 1024, sb = b % 1024, swz = sb ^ (((sb >> 9) & 1) << 5); R = (st >> 1) * 16 + swz / 64; C = (st & 1) * 32 + (swz % 64) / 2; }
__host__ __device__ __forceinline__ int perm32(int rho) { const int n = rho >> 4, i = rho & 15; return 8 * (i >> 2) + 4 * n + (i & 3); }

struct Unit { int pm, pn; };
struct Gemm { const bf16_t* A; const bf16_t* Bt; int M, N, K; };

struct StaticOrder {
    int nM, nN, nwg, G, c;
    __host__ __device__ void init(int M, int N, int G_, int c_) { nM = M / BM; nN = N / BM; nwg = nM * nN; G = G_; c = c_; }
    __host__ __device__ bool next(int i, Unit& u) const {
        const long L = (long)i * G + c; if (L >= nwg) return false;
        int wgid = (int)L; { const int q = nwg / NXCD, r = nwg % NXCD, xcd = wgid % NXCD, off = wgid / NXCD; wgid = (xcd < r ? xcd * (q + 1) : r * (q + 1) + (xcd - r) * q) + off; }
        const int nig = WGM * nN, gid = wgid / nig, fm = gid * WGM, gsz = (nM - fm) < WGM ? (nM - fm) : WGM;
        u.pm = fm + ((wgid % nig) % gsz); u.pn = (wgid % nig) / gsz; return true;
    }
    __device__ __forceinline__ void a_ready(const Unit&) const {}
    __device__ __forceinline__ void done(const Unit&) const {}
};
template <class Epi, class Sched, bool ALIGN_EPI = false, bool SP2 = false>
__device__ __forceinline__ void gemm_phase(PG8_LAS unsigned char* lds, const Gemm g, const Sched& S, const Epi& E) {
    const int tid = threadIdx.x, wid = __builtin_amdgcn_readfirstlane(tid >> 6), lane = tid & 63, wr = wid >> 2, wc = wid & 3, fr = lane & 15, fq = lane >> 4;
    const int K = g.K, nt = K / BK;
    unsigned voffA[2], voffB[2];
#pragma unroll
    for (int i = 0; i < 2; ++i) { int R, C; stage_rc(tid * 16 + i * 8192, R, C); const int Rb = Epi::PERM ? ((R & ~31) + perm32(R & 31)) : R;
        voffA[i] = (unsigned)(R * K + C) * 2u; voffB[i] = (unsigned)(Rb * K + C) * 2u; }
    const size_t kstep = (size_t)(BK * 2);
    const size_t hstep = (size_t)HALF * K * 2;
    const size_t tstep = 2 * hstep;
    const unsigned ldsw = (unsigned)wid * 1024u;
    const int aoff = lds_byte(wr * 64 + fr, fq * 8), boff = lds_byte(wc * 32 + fr, fq * 8);
#define PG8_SA(b, h) (((b) * 2 + (h)) * HTB)
#define PG8_SB(b, h) ((4 + (b) * 2 + (h)) * HTB)
#define PG8_STAGE(bufoff, gbase, voff) do { _Pragma("unroll") for (int _i = 0; _i < 2; ++_i) \
        __builtin_amdgcn_global_load_lds((const unsigned*)((const char*)(gbase) + (voff)[_i]), (PG8_LAS unsigned*)(lds + (bufoff) + ldsw + _i * 8192), 16, 0, 0); } while (0)
#define PG8_LDA(dst, b, h) do { _Pragma("unroll") for (int m = 0; m < 4; ++m) _Pragma("unroll") for (int k = 0; k < 2; ++k) dst[m][k] = *(const PG8_LAS bf16x8*)(lds + PG8_SA(b, h) + aoff + m * 2048 + k * 1024); } while (0)
#define PG8_LDB(dst, b, h) do { _Pragma("unroll") for (int n = 0; n < 2; ++n) _Pragma("unroll") for (int k = 0; k < 2; ++k) dst[n][k] = *(const PG8_LAS bf16x8*)(lds + PG8_SB(b, h) + boff + n * 2048 + k * 1024); } while (0)
#define PG8_MMA(ai, bj, At, Bt) do { __builtin_amdgcn_s_setprio(1); _Pragma("unroll") for (int m = 0; m < 4; ++m) _Pragma("unroll") for (int n = 0; n < 2; ++n) _Pragma("unroll") for (int k = 0; k < 2; ++k) \
        acc[ai][bj][m][n] = __builtin_amdgcn_mfma_f32_16x16x32_bf16(Bt[n][k], At[m][k], acc[ai][bj][m][n], 0, 0, 0); __builtin_amdgcn_s_setprio(0); } while (0)
#define PG8_WAIT_V(n) asm volatile("s_waitcnt vmcnt(" #n ")" ::: "memory")
#define PG8_WAIT_L(n) asm volatile("s_waitcnt lgkmcnt(" #n ")" ::: "memory")
#define PG8_BAR __builtin_amdgcn_s_barrier()
#define PG8_SCHED __builtin_amdgcn_sched_barrier(0)
    Unit cur, nxt; int ui = 0;
    if (!S.next(0, cur)) return;
    f32x4 acc[2][2][4][2];
#pragma unroll
    for (int a = 0; a < 2; ++a)
#pragma unroll
        for (int b = 0; b < 2; ++b)
#pragma unroll
            for (int m = 0; m < 4; ++m)
#pragma unroll
                for (int n = 0; n < 2; ++n) acc[a][b][m][n] = (f32x4){0.f, 0.f, 0.f, 0.f};
    bf16x8 At[4][2], B0[2][2], B1[2][2];
    const char* cA = (const char*)g.A + (size_t)cur.pm * tstep; const char* cB = (const char*)g.Bt + (size_t)cur.pn * tstep;
    S.a_ready(cur);
    if constexpr (SP2) {
        PG8_STAGE(PG8_SB(0, 0), cB, voffB); PG8_STAGE(PG8_SB(0, 1), cB + hstep, voffB); PG8_STAGE(PG8_SA(0, 0), cA, voffA); PG8_STAGE(PG8_SA(0, 1), cA + hstep, voffA);
        if (wr == 1) PG8_BAR;
        PG8_WAIT_V(2); PG8_BAR;
        PG8_STAGE(PG8_SB(1, 0), cB + kstep, voffB); PG8_STAGE(PG8_SA(1, 0), cA + kstep, voffA); PG8_STAGE(PG8_SB(1, 1), cB + hstep + kstep, voffB);
        PG8_WAIT_V(6); PG8_BAR;
    } else {
        PG8_STAGE(PG8_SB(0, 0), cB, voffB); PG8_STAGE(PG8_SA(0, 0), cA, voffA); PG8_STAGE(PG8_SB(0, 1), cB + hstep, voffB); PG8_STAGE(PG8_SA(0, 1), cA + hstep, voffA);
        if (wr == 1) PG8_BAR;
        PG8_WAIT_V(4); PG8_BAR;
        PG8_STAGE(PG8_SB(1, 0), cB + kstep, voffB); PG8_STAGE(PG8_SA(1, 0), cA + kstep, voffA); PG8_STAGE(PG8_SB(1, 1), cB + hstep + kstep, voffB);
        PG8_WAIT_V(6); PG8_BAR;
    }
    for (;;) {
        const bool has_next = S.next(ui + 1, nxt);
        const char* nA = has_next ? (const char*)g.A + (size_t)nxt.pm * tstep : cA; const char* nB = has_next ? (const char*)g.Bt + (size_t)nxt.pn * tstep : cB;
        for (int t = 0; t < nt; t += 2) {
            const bool last = (t == nt - 2);
            const char* a1 = cA + (size_t)(t + 1) * kstep;
            const char* a2 = last ? nA : cA + (size_t)(t + 2) * kstep; const char* b2 = last ? nB : cB + (size_t)(t + 2) * kstep;
            const char* a3 = a2 + kstep; const char* b3 = b2 + kstep;
            if (last && has_next) S.a_ready(nxt);
            if constexpr (SP2) {
            PG8_LDB(B0, 0, 0); PG8_LDB(B1, 0, 1); PG8_SCHED; PG8_LDA(At, 0, 0); PG8_STAGE(PG8_SA(1, 1), a1 + hstep, voffA);
            PG8_WAIT_V(8); PG8_WAIT_L(0); PG8_BAR; PG8_MMA(0, 0, At, B0); PG8_MMA(0, 1, At, B1); PG8_BAR; PG8_SCHED;
            PG8_LDA(At, 0, 1); PG8_STAGE(PG8_SB(0, 0), b2, voffB); PG8_STAGE(PG8_SB(0, 1), b2 + hstep, voffB); PG8_STAGE(PG8_SA(0, 0), a2, voffA);
            PG8_WAIT_V(8); PG8_WAIT_L(0); PG8_BAR; PG8_MMA(1, 0, At, B0); PG8_MMA(1, 1, At, B1); PG8_BAR; PG8_SCHED;
            PG8_LDB(B0, 1, 0); PG8_LDB(B1, 1, 1); PG8_SCHED; PG8_LDA(At, 1, 0); PG8_STAGE(PG8_SA(0, 1), a2 + hstep, voffA);
            PG8_WAIT_V(8); PG8_WAIT_L(0); PG8_BAR; PG8_MMA(0, 0, At, B0); PG8_MMA(0, 1, At, B1); PG8_BAR; PG8_SCHED;
            PG8_LDA(At, 1, 1); PG8_STAGE(PG8_SB(1, 0), b3, voffB); PG8_STAGE(PG8_SB(1, 1), b3 + hstep, voffB); PG8_STAGE(PG8_SA(1, 0), a3, voffA);
            PG8_WAIT_V(8); PG8_WAIT_L(0); PG8_BAR; PG8_MMA(1, 0, At, B0); PG8_MMA(1, 1, At, B1); PG8_BAR; PG8_SCHED;
            } else {
            PG8_LDB(B0, 0, 0); PG8_SCHED; PG8_LDA(At, 0, 0); PG8_STAGE(PG8_SA(1, 1), a1 + hstep, voffA);
            PG8_WAIT_L(8); PG8_BAR; PG8_WAIT_L(0); PG8_MMA(0, 0, At, B0); PG8_BAR; PG8_SCHED;
            PG8_LDB(B1, 0, 1); PG8_STAGE(PG8_SB(0, 0), b2, voffB);
            PG8_BAR; PG8_WAIT_L(0); PG8_MMA(0, 1, At, B1); PG8_BAR;
            PG8_LDA(At, 0, 1); PG8_STAGE(PG8_SA(0, 0), a2, voffA);
            PG8_BAR; PG8_WAIT_L(0); PG8_MMA(1, 0, At, B0); PG8_BAR; PG8_SCHED;
            PG8_STAGE(PG8_SB(0, 1), b2 + hstep, voffB);
            PG8_WAIT_V(6); PG8_BAR; PG8_MMA(1, 1, At, B1); PG8_BAR;
            PG8_LDB(B0, 1, 0); PG8_SCHED; PG8_LDA(At, 1, 0); PG8_STAGE(PG8_SA(0, 1), a2 + hstep, voffA);
            PG8_WAIT_L(8); PG8_BAR; PG8_WAIT_L(0); PG8_MMA(0, 0, At, B0); PG8_BAR; PG8_SCHED;
            PG8_LDB(B1, 1, 1); PG8_STAGE(PG8_SB(1, 0), b3, voffB);
            PG8_BAR; PG8_WAIT_L(0); PG8_MMA(0, 1, At, B1); PG8_BAR;
            PG8_LDA(At, 1, 1); PG8_STAGE(PG8_SA(1, 0), a3, voffA);
            PG8_BAR; PG8_WAIT_L(0); PG8_MMA(1, 0, At, B0); PG8_BAR; PG8_SCHED;
            PG8_STAGE(PG8_SB(1, 1), b3 + hstep, voffB);
            PG8_WAIT_V(6); PG8_BAR; PG8_MMA(1, 1, At, B1); PG8_BAR;
            }
        }
        if constexpr (ALIGN_EPI) { if (wr == 0) PG8_BAR; }
        if constexpr (!Epi::AFTER_DRAIN) { E(acc, cur, wr, wc, fr, fq); S.done(cur); }
        if (!has_next) break;
#pragma unroll
        for (int a = 0; a < 2; ++a)
#pragma unroll
            for (int b = 0; b < 2; ++b)
#pragma unroll
                for (int m = 0; m < 4; ++m)
#pragma unroll
                    for (int n = 0; n < 2; ++n) acc[a][b][m][n] = (f32x4){0.f, 0.f, 0.f, 0.f};
        cur = nxt; cA = nA; cB = nB; ++ui;
        if constexpr (ALIGN_EPI) { if (wr == 1) PG8_BAR; }
    }
    PG8_WAIT_V(0);
    if constexpr (!ALIGN_EPI) { if (wr == 0) PG8_BAR; }
    PG8_BAR;
    if constexpr (Epi::AFTER_DRAIN) { E.fused(acc, cur, wr, wc, fr, fq, lds, wid, lane); S.done(cur); }
#undef PG8_SA
#undef PG8_SB
#undef PG8_STAGE
#undef PG8_LDA
#undef PG8_LDB
#undef PG8_MMA
#undef PG8_WAIT_V
#undef PG8_WAIT_L
#undef PG8_BAR
#undef PG8_SCHED
}
}
typedef unsigned short bf16_t;
typedef short bf16x8 __attribute__((ext_vector_type(8)));
typedef float f32x16 __attribute__((ext_vector_type(16)));
typedef float f32x4 __attribute__((ext_vector_type(4)));
typedef unsigned u32x4 __attribute__((ext_vector_type(4)));
typedef unsigned u32x2 __attribute__((ext_vector_type(2)));

constexpr int D = 1024, NBATCH = 4, SEQ = 8192, T = NBATCH * SEQ;
constexpr int NH = 8, HD = 64, INC = 3080, NMOD = 6144;
constexpr float EPS = 1e-6f, ATT_SCALE = 0.125f, THRESH = 105.0f, LOG2E = 1.4426950408889634f;
constexpr float SC2 = ATT_SCALE * LOG2E, THRESH2 = THRESH * LOG2E;

constexpr size_t MiB = 1u << 20;
constexpr size_t WS_MOD = 0, WS_KMAX = 128 * 1024, WS_BAR = 136 * 1024, WS_CTOT = 192 * 1024, WS_FLOC = 1 * MiB;
constexpr size_t WS_WQK = 2 * MiB, WS_WV = 6 * MiB, WS_WOUT = 8 * MiB, WS_WQ = 10 * MiB, WS_SK = 14 * MiB, WS_ED = 16 * MiB, WS_EU = 48 * MiB;
constexpr size_t WS_RSD = 15 * MiB, WS_RSU = 15 * MiB + 64 * 1024;
constexpr size_t WS_H = 80 * MiB, WS_QF = 144 * MiB;
constexpr size_t WS_MIX = 336 * MiB, WS_EXP = 400 * MiB, WS_GATE = 416 * MiB, WS_END = 432 * MiB;
constexpr size_t WS_X1 = 272 * MiB;
constexpr size_t WS_ACT = 144 * MiB;
constexpr size_t WS_QUERY = 144 * MiB;

struct P {
    const float *x, *c, *w_ada, *b_ada, *g_mix, *w_in, *b_forget, *g_fox, *g_sb, *w_out, *g_ffn, *w_query, *sub_keys, *e_down, *e_up, *g_final;
    float* out;
    unsigned char* ws;
};

constexpr int NWAVE = 8, NTHR = NWAVE * 64;
constexpr int STAGE_LDS = 131072;
constexpr int LDS_BYTES = 147456;

typedef __bf16 bf16v2 __attribute__((ext_vector_type(2)));
__device__ __forceinline__ unsigned cvt_pk_bf16(float lo, float hi) { bf16v2 v; v.x = (__bf16)lo; v.y = (__bf16)hi; return __builtin_bit_cast(unsigned, v); }
__device__ __forceinline__ float bf_lo(unsigned w) { return __uint_as_float(w << 16); }
__device__ __forceinline__ float bf_hi(unsigned w) { return __uint_as_float(w & 0xffff0000u); }
__device__ __forceinline__ float bf2f(bf16_t h) { return __uint_as_float(((unsigned)h) << 16); }
__device__ __forceinline__ float wave_sum(float v) {
#pragma unroll
    for (int o = 1; o < 64; o <<= 1) v += __shfl_xor(v, o);
    return v;
}
__device__ __forceinline__ float wave_max(float v) {
#pragma unroll
    for (int o = 1; o < 64; o <<= 1) v = fmaxf(v, __shfl_xor(v, o));
    return v;
}
__device__ __forceinline__ float xor32_sum(float v) { auto rr = __builtin_amdgcn_permlane32_swap(__float_as_uint(v), __float_as_uint(v), false, false); return __uint_as_float(rr[0]) + __uint_as_float(rr[1]); }
__device__ __forceinline__ float xor32_max(float v) { auto rr = __builtin_amdgcn_permlane32_swap(__float_as_uint(v), __float_as_uint(v), false, false); return fmaxf(__uint_as_float(rr[0]), __uint_as_float(rr[1])); }
__device__ __forceinline__ float xor32_get(float v, int hh) { auto rr = __builtin_amdgcn_permlane32_swap(__float_as_uint(v), __float_as_uint(v), false, false); return __uint_as_float(hh ? rr[0] : rr[1]); }
__device__ __forceinline__ float log_sigmoid(float x) { return fminf(x, 0.f) - log1pf(__expf(-fabsf(x))); }
__device__ __forceinline__ void p0_transpose_item(const float* W, int K, int N, int n0src, bf16_t* WT, int row0, int k0, float* scr, int lane) {
#pragma unroll 8
    for (int i = 0; i < 32; ++i) { const int kk = 2 * i + (lane >> 5); scr[kk * 33 + (lane & 31)] = W[(size_t)(k0 + kk) * N + n0src + (lane & 31)]; }
    asm volatile("s_waitcnt lgkmcnt(0)" ::: "memory");
    asm volatile("" ::: "memory");
    const int c = lane & 7;
#pragma unroll
    for (int j = 0; j < 4; ++j) {
        const int n = (lane >> 3) + 8 * j; const float* s = scr + (8 * c) * 33 + n;
        u32x4 o; o.x = cvt_pk_bf16(s[0 * 33], s[1 * 33]); o.y = cvt_pk_bf16(s[2 * 33], s[3 * 33]); o.z = cvt_pk_bf16(s[4 * 33], s[5 * 33]); o.w = cvt_pk_bf16(s[6 * 33], s[7 * 33]);
        *(u32x4*)(WT + (size_t)(row0 + n) * K + k0 + 8 * c) = o;
    }
    asm volatile("s_waitcnt lgkmcnt(0)" ::: "memory");
    asm volatile("" ::: "memory");
}

__device__ __forceinline__ void cvt_stream(const float* src, bf16_t* dst, size_t n8, size_t gtid, size_t gthreads) {
    for (size_t i = gtid; i < n8; i += gthreads) {
        const f32x4 a = *(const f32x4*)(src + i * 8), b = *(const f32x4*)(src + i * 8 + 4);
        u32x4 o; o.x = cvt_pk_bf16(a.x, a.y); o.y = cvt_pk_bf16(a.z, a.w); o.z = cvt_pk_bf16(b.x, b.y); o.w = cvt_pk_bf16(b.z, b.w);
        *(u32x4*)(dst + i * 8) = o;
    }
}

typedef float f32x2 __attribute__((ext_vector_type(2)));
__device__ __forceinline__ void cvt_row_fp8(const float* src, unsigned char* dst, float* rscale, int row, int lane) {
    const f32x4* s = (const f32x4*)(src + (size_t)row * 1024 + lane * 16);
    f32x4 v[4]; float mx = 0.f;
#pragma unroll
    for (int i = 0; i < 4; ++i) { v[i] = s[i]; mx = fmaxf(mx, fmaxf(fmaxf(fabsf(v[i].x), fabsf(v[i].y)), fmaxf(fabsf(v[i].z), fabsf(v[i].w)))); }
    mx = wave_max(mx);
    const float sc = mx > 0.f ? 224.f / mx : 1.f;
    u32x4 o;
#pragma unroll
    for (int i = 0; i < 4; ++i) {
        int w = 0;
        w = __builtin_amdgcn_cvt_pk_fp8_f32(v[i].x * sc, v[i].y * sc, w, false);
        w = __builtin_amdgcn_cvt_pk_fp8_f32(v[i].z * sc, v[i].w * sc, w, true);
        o[i] = (unsigned)w;
    }
    *(u32x4*)(dst + (size_t)row * 1024 + lane * 16) = o;
    if (lane == 0) rscale[row] = mx > 0.f ? mx * (1.f / 224.f) : 1.f;
}

__device__ __forceinline__ unsigned pack_i8x4(float a, float b, float c, float d) {
    const int ia = (int)__builtin_rintf(a), ib = (int)__builtin_rintf(b), ic = (int)__builtin_rintf(c), id = (int)__builtin_rintf(d);
    return (unsigned)(ia & 0xff) | ((unsigned)(ib & 0xff) << 8) | ((unsigned)(ic & 0xff) << 16) | ((unsigned)id << 24);
}
__device__ __forceinline__ void cvt_row_i8(const float* src, unsigned char* dst, float* rscale, int row, int lane) {
    const f32x4* s = (const f32x4*)(src + (size_t)row * 1024 + lane * 16);
    f32x4 v[4]; float mx = 0.f;
#pragma unroll
    for (int i = 0; i < 4; ++i) { v[i] = s[i]; mx = fmaxf(mx, fmaxf(fmaxf(fabsf(v[i].x), fabsf(v[i].y)), fmaxf(fabsf(v[i].z), fabsf(v[i].w)))); }
    mx = wave_max(mx);
    const float sc = mx > 0.f ? 127.f / mx : 1.f;
    u32x4 o;
#pragma unroll
    for (int i = 0; i < 4; ++i) o[i] = pack_i8x4(v[i].x * sc, v[i].y * sc, v[i].z * sc, v[i].w * sc);
    *(u32x4*)(dst + (size_t)row * 1024 + lane * 16) = o;
    if (lane == 0) rscale[row] = mx > 0.f ? mx * (1.f / 127.f) : 1.f;
}
struct RowF32 { f32x4 v[4]; };
__device__ __forceinline__ void row_load(RowF32& r, const float* src, int row, int lane) {
    const f32x4* s = (const f32x4*)(src + (size_t)row * 1024 + lane * 16);
#pragma unroll
    for (int i = 0; i < 4; ++i) r.v[i] = s[i];
}
__device__ __forceinline__ void cvt_row_q4(const RowF32& r, unsigned char* dst, float* rscale, int row, int lane) {
    const f32x4 (&v)[4] = r.v; float ss = 0.f;
#pragma unroll
    for (int i = 0; i < 4; ++i) ss += (v[i].x * v[i].x + v[i].y * v[i].y) + (v[i].z * v[i].z + v[i].w * v[i].w);
    ss = wave_sum(ss);
    const float step = ss > 0.f ? 0.3352f * sqrtf(ss * (1.f / 1024.f)) : 1e-30f, inv = 1.f / step;
    unsigned w[2] = {0u, 0u};
#pragma unroll
    for (int i = 0; i < 16; ++i) {
        int n = (int)floorf(v[i >> 2][i & 3] * inv) + 8;
        n = n < 0 ? 0 : (n > 15 ? 15 : n);
        w[i >> 3] |= (unsigned)n << (4 * (i & 7));
    }
    u32x2 o; o.x = w[0]; o.y = w[1];
    *(u32x2*)(dst + (size_t)row * 512 + lane * 8) = o;
    if (lane == 0) rscale[row] = step;
}
__device__ __forceinline__ void p0_mod(const P& p, char* smem, int bid, int nblk) {
    const int tid = threadIdx.x, lane = tid & 63, wid = tid >> 6;
    const int gw = bid * NWAVE + wid, NGW = nblk * NWAVE;
    float* sc = (float*)smem;
    for (int i = tid; i < 4096; i += NTHR) { const float v = p.c[i]; sc[i] = v / (1.f + __expf(-v)); }
    __syncthreads();
    float* mod = (float*)(p.ws + WS_MOD);
    for (int it = gw; it < 1536; it += NGW) {
        const int col = it * 4 + (lane & 3), ks = lane >> 2;
        float a0 = 0.f, a1 = 0.f, a2 = 0.f, a3 = 0.f;
        const float* w = p.w_ada + (size_t)(ks * 64) * NMOD + col;
#pragma unroll 16
        for (int k = 0; k < 64; ++k) {
            const float wv = w[(size_t)k * NMOD]; const int kk = ks * 64 + k;
            a0 += sc[kk] * wv; a1 += sc[1024 + kk] * wv; a2 += sc[2048 + kk] * wv; a3 += sc[3072 + kk] * wv;
        }
#pragma unroll
        for (int o = 4; o < 64; o <<= 1) { a0 += __shfl_xor(a0, o); a1 += __shfl_xor(a1, o); a2 += __shfl_xor(a2, o); a3 += __shfl_xor(a3, o); }
        if (ks == 0) { const float bb = p.b_ada[col]; mod[col] = a0 + bb; mod[NMOD + col] = a1 + bb; mod[2 * NMOD + col] = a2 + bb; mod[3 * NMOD + col] = a3 + bb; }
    }
}
__device__ __forceinline__ void p0_convert(const P& p, char* smem, int bid, int nblk) {
    const int tid = threadIdx.x, lane = tid & 63, wid = tid >> 6;
    const int gw = bid * NWAVE + wid, NGW = nblk * NWAVE;
    float* scr = (float*)(smem + 40960 + wid * 8448);
    for (int it = gw; it < 3072; it += NGW) {
        if (it < 1536) {
            const int kb = it / 96, nb = it % 96, seg = nb >> 4, nn = (nb & 15) * 32;
            const int srccol = seg * 512 + nn + (seg >= 3 ? 8 : 0);
            bf16_t* dstw = (bf16_t*)(p.ws + ((seg == 2 || seg == 5) ? WS_WV : WS_WQK));
            const int drow = (seg == 2 ? 0 : seg == 5 ? 512 : seg == 0 ? 0 : seg == 1 ? 512 : seg == 3 ? 1024 : 1536) + nn;
            p0_transpose_item(p.w_in, D, INC, srccol, dstw, drow, kb * 64, scr, lane);
        }
        else if (it < 2048) { const int r = it - 1536, kb = r / 32, nb = r % 32; p0_transpose_item(p.w_out, D, D, nb * 32, (bf16_t*)(p.ws + WS_WOUT), nb * 32, kb * 64, scr, lane); }
        else { const int r = it - 2048, kb = r / 64, nb = r % 64; p0_transpose_item(p.w_query, D, 2048, nb * 32, (bf16_t*)(p.ws + WS_WQ), nb * 32, kb * 64, scr, lane); }
    }
    const size_t gtid = (size_t)bid * NTHR + tid, gth = (size_t)nblk * NTHR;
    cvt_stream(p.sub_keys, (bf16_t*)(p.ws + WS_SK), (size_t)8 * 2 * 128 * 128 / 8, gtid, gth);
}

__device__ __forceinline__ void p1_norm1(const P& p, char* smem, int bid, int nblk) {
    const int tid = threadIdx.x, lane = tid & 63, wid = tid >> 6;
    float* wfs = (float*)smem;
    float* lf = (float*)(smem + 32768);
    const float* mod = (const float*)(p.ws + WS_MOD);
    bf16_t* hbuf = (bf16_t*)(p.ws + WS_H);
    float* Floc = (float*)(p.ws + WS_FLOC);
    float* ctot = (float*)(p.ws + WS_CTOT);
    for (int i = tid; i < 2048; i += NTHR) {
        const int d = i >> 1, hf = i & 1;
        const f32x4 w = *(const f32x4*)(p.w_in + (size_t)d * INC + 1536 + 4 * hf);
        wfs[(4 * hf + 0) * 1024 + d] = w.x; wfs[(4 * hf + 1) * 1024 + d] = w.y; wfs[(4 * hf + 2) * 1024 + d] = w.z; wfs[(4 * hf + 3) * 1024 + d] = w.w;
    }
    __syncthreads();
    for (int ch = bid; ch < T / 64; ch += nblk) {
        const int t0 = ch * 64, b = t0 >> 13;
        f32x4 Am[4], Bm[4];
#pragma unroll
        for (int j = 0; j < 4; ++j) {
            const f32x4 g = ((const f32x4*)p.g_mix)[lane + 64 * j];
            const f32x4 s = ((const f32x4*)(mod + b * NMOD + 1024))[lane + 64 * j];
            Am[j] = g * (s + 1.0f);
            Bm[j] = ((const f32x4*)(mod + b * NMOD))[lane + 64 * j];
        }
        const int up32 = lane & 32, up16 = lane & 16, up8 = lane & 8;
        const int kL = ((lane >> 5) & 1) * 4 + ((lane >> 4) & 1) * 2 + ((lane >> 3) & 1);
        const float bfk = p.b_forget[kL];
        f32x4 vn[4];
        {
            const f32x4* xr = (const f32x4*)(p.x + (size_t)(t0 + wid * (64 / NWAVE)) * D) + lane;
#pragma unroll
            for (int j = 0; j < 4; ++j) vn[j] = xr[64 * j];
        }
        for (int i = 0; i < 64 / NWAVE; ++i) {
            const int t = t0 + wid * (64 / NWAVE) + i;
            f32x4 v[4]; float ss = 0.f;
#pragma unroll
            for (int j = 0; j < 4; ++j) { v[j] = vn[j]; ss += v[j].x * v[j].x + v[j].y * v[j].y + v[j].z * v[j].z + v[j].w * v[j].w; }
            if (i + 1 < 64 / NWAVE) {
                const f32x4* xr = (const f32x4*)(p.x + (size_t)(t + 1) * D) + lane;
#pragma unroll
                for (int j = 0; j < 4; ++j) vn[j] = xr[64 * j];
            }
            const float inv = rsqrtf(wave_sum(ss) * (1.f / D) + EPS);
            u32x2* o8 = (u32x2*)(hbuf + (size_t)t * D) + lane;
            float fa[8];
#pragma unroll
            for (int c = 0; c < 8; ++c) fa[c] = 0.f;
#pragma unroll
            for (int j = 0; j < 4; ++j) {
                const f32x4 h = (v[j] * inv) * Am[j] + Bm[j];
                u32x2 w; w.x = cvt_pk_bf16(h.x, h.y); w.y = cvt_pk_bf16(h.z, h.w); o8[64 * j] = w;
#pragma unroll
                for (int c = 0; c < 8; ++c) { const f32x4 wv = ((const f32x4*)(wfs + c * 1024))[lane + 64 * j]; fa[c] += (wv.x * h.x + wv.y * h.y) + (wv.z * h.z + wv.w * h.w); }
            }
            float k4[4], k2[2];
#pragma unroll
            for (int q = 0; q < 4; ++q) { const float snd = up32 ? fa[q] : fa[q + 4]; k4[q] = (up32 ? fa[q + 4] : fa[q]) + __shfl_xor(snd, 32); }
#pragma unroll
            for (int q = 0; q < 2; ++q) { const float snd = up16 ? k4[q] : k4[q + 2]; k2[q] = (up16 ? k4[q + 2] : k4[q]) + __shfl_xor(snd, 16); }
            const float snd = up8 ? k2[0] : k2[1];
            float f = (up8 ? k2[1] : k2[0]) + __shfl_xor(snd, 8);
            f += __shfl_xor(f, 4); f += __shfl_xor(f, 2); f += __shfl_xor(f, 1);
            if ((lane & 7) == 0) lf[(wid * (64 / NWAVE) + i) * 8 + kL] = log_sigmoid(f + bfk) * LOG2E;
        }
        __syncthreads();
        if (tid < 8) {
            float run = 0.f; float* dst = Floc + (size_t)(b * 8 + tid) * SEQ + (t0 & (SEQ - 1));
            for (int i = 0; i < 64; ++i) { run += lf[i * 8 + tid]; dst[i] = run; }
            ctot[(b * 8 + tid) * 128 + ((t0 & (SEQ - 1)) >> 6)] = run;
        }
        __syncthreads();
    }
}

struct EpiQK {
    static constexpr bool PERM = true, AFTER_DRAIN = false;
    unsigned char* ws;
    __device__ __forceinline__ void operator()(const pg8::f32x4 (&acc)[2][2][4][2], const pg8::Unit& u, int wr, int wc, int fr, int fq) const {
        const int b = (u.pm * 256) >> 13;
#pragma unroll
        for (int bj = 0; bj < 2; ++bj) {
            const int c0 = u.pn * 256 + bj * 128 + wc * 32 + 8 * fq, seg4 = c0 >> 9, hd = (c0 & 511) >> 6, d = c0 & 63;
            bf16_t* dst = (bf16_t*)(ws + WS_QF + (size_t)(seg4 < 2 ? seg4 : seg4 + 1) * 32 * MiB) + (size_t)(b * 8 + hd) * SEQ * 64 + d;
            float mx = 0.f;
#pragma unroll
            for (int ai = 0; ai < 2; ++ai)
#pragma unroll
                for (int m = 0; m < 4; ++m) {
                    const int s = (u.pm * 256 + ai * 128 + wr * 64 + m * 16 + fr) & (SEQ - 1);
                    const pg8::f32x4 v0 = acc[ai][bj][m][0], v1 = acc[ai][bj][m][1];
                    u32x4 w; w.x = cvt_pk_bf16(v0[0], v0[1]); w.y = cvt_pk_bf16(v0[2], v0[3]); w.z = cvt_pk_bf16(v1[0], v1[1]); w.w = cvt_pk_bf16(v1[2], v1[3]);
                    *(u32x4*)(dst + (size_t)s * 64) = w;
                    if (seg4 == 1) {
                        float q = (v0[0] * v0[0] + v0[1] * v0[1]) + (v0[2] * v0[2] + v0[3] * v0[3]) + (v1[0] * v1[0] + v1[1] * v1[1]) + (v1[2] * v1[2] + v1[3] * v1[3]);
                        q += __shfl_xor(q, 16); q += __shfl_xor(q, 32);
                        mx = fmaxf(mx, q);
                    }
                }
            if (seg4 == 1) {
                mx = wave_max(mx);
                if ((threadIdx.x & 63) == 0) atomicMax((unsigned*)(ws + WS_KMAX) + (b * 8 + hd) * 2 + (wc & 1), __float_as_uint(mx));
            }
        }
    }
};
struct EpiV {
    static constexpr bool PERM = true, AFTER_DRAIN = false;
    unsigned char* ws;
    __device__ __forceinline__ void operator()(const pg8::f32x4 (&acc)[2][2][4][2], const pg8::Unit& u, int wr, int wc, int fr, int fq) const {
#pragma unroll
        for (int bj = 0; bj < 2; ++bj) {
            const int t0 = u.pn * 256 + bj * 128 + wc * 32 + 8 * fq, b = t0 >> 13, s = t0 & (SEQ - 1);
#pragma unroll
            for (int ai = 0; ai < 2; ++ai)
#pragma unroll
                for (int m = 0; m < 4; ++m) {
                    const int vc = u.pm * 256 + ai * 128 + wr * 64 + m * 16 + fr, type = vc >> 9, hd = (vc & 511) >> 6, d = vc & 63;
                    bf16_t* dst = (bf16_t*)(ws + WS_QF + (size_t)(type * 3 + 2) * 32 * MiB) + (((size_t)(b * 8 + hd) * 256 + (s >> 5)) * 64 + d) * 32 + (s & 31);
                    const pg8::f32x4 v0 = acc[ai][bj][m][0], v1 = acc[ai][bj][m][1];
                    u32x4 w; w.x = cvt_pk_bf16(v0[0], v0[1]); w.y = cvt_pk_bf16(v0[2], v0[3]); w.z = cvt_pk_bf16(v1[0], v1[1]); w.w = cvt_pk_bf16(v1[2], v1[3]);
                    *(u32x4*)dst = w;
                }
        }
    }
};
struct EpiOut {
    static constexpr bool PERM = true, AFTER_DRAIN = false;
    const float* x; bf16_t* x1; const float* mod;
    __device__ __forceinline__ void operator()(const pg8::f32x4 (&acc)[2][2][4][2], const pg8::Unit& u, int wr, int wc, int fr, int fq) const {
        const int b = (u.pm * 256) >> 13;
#pragma unroll
        for (int bj = 0; bj < 2; ++bj) {
            const int c0 = u.pn * 256 + bj * 128 + wc * 32 + 8 * fq;
            const f32x4 g0 = *(const f32x4*)(mod + b * NMOD + 2048 + c0), g1 = *(const f32x4*)(mod + b * NMOD + 2048 + c0 + 4);
#pragma unroll
            for (int ai = 0; ai < 2; ++ai)
#pragma unroll
                for (int m = 0; m < 4; ++m) {
                    const size_t off = (size_t)(u.pm * 256 + ai * 128 + wr * 64 + m * 16 + fr) * D + c0;
                    const f32x4 v0 = *(const f32x4*)(x + off) + g0 * acc[ai][bj][m][0], v1 = *(const f32x4*)(x + off + 4) + g1 * acc[ai][bj][m][1];
                    u32x4 w; w.x = cvt_pk_bf16(v0[0], v0[1]); w.y = cvt_pk_bf16(v0[2], v0[3]); w.z = cvt_pk_bf16(v1[0], v1[1]); w.w = cvt_pk_bf16(v1[2], v1[3]);
                    *(u32x4*)(x1 + off) = w;
                }
        }
    }
};
struct EpiQuery {
    static constexpr bool PERM = true, AFTER_DRAIN = false;
    bf16_t* q;
    __device__ __forceinline__ void operator()(const pg8::f32x4 (&acc)[2][2][4][2], const pg8::Unit& u, int wr, int wc, int fr, int fq) const {
#pragma unroll
        for (int bj = 0; bj < 2; ++bj) {
            const int c0 = u.pn * 256 + bj * 128 + wc * 32 + 8 * fq;
#pragma unroll
            for (int ai = 0; ai < 2; ++ai)
#pragma unroll
                for (int m = 0; m < 4; ++m) {
                    const pg8::f32x4 v0 = acc[ai][bj][m][0], v1 = acc[ai][bj][m][1];
                    u32x4 w; w.x = cvt_pk_bf16(v0[0], v0[1]); w.y = cvt_pk_bf16(v0[2], v0[3]); w.z = cvt_pk_bf16(v1[0], v1[1]); w.w = cvt_pk_bf16(v1[2], v1[3]);
                    *(u32x4*)(q + (size_t)(u.pm * 256 + ai * 128 + wr * 64 + m * 16 + fr) * 2048 + c0) = w;
                }
        }
    }
};
#define LASP(ptr) ((__attribute__((address_space(3))) unsigned char*)(ptr))
template <class Epi>
__device__ __forceinline__ void run_gemm(char* smem, const bf16_t* A, const bf16_t* Bt, int M, int N, const Epi& E) {
    pg8::Gemm g{A, Bt, M, N, 1024}; pg8::StaticOrder S; S.init(M, N, (int)gridDim.x, (int)blockIdx.x);
    pg8::gemm_phase<Epi, pg8::StaticOrder, true, true>(LASP(smem), g, S, E);
}
__device__ __forceinline__ void gemm_proj(const P& p, char* smem) {
    run_gemm(smem, (const bf16_t*)(p.ws + WS_H), (const bf16_t*)(p.ws + WS_WQK), T, 2048, EpiQK{p.ws});
    run_gemm(smem, (const bf16_t*)(p.ws + WS_WV), (const bf16_t*)(p.ws + WS_H), 1024, T, EpiV{p.ws});
}
__device__ __forceinline__ void gemm_out(const P& p, char* smem) {
    run_gemm(smem, (const bf16_t*)(p.ws + WS_MIX), (const bf16_t*)(p.ws + WS_WOUT), T, 1024, EpiOut{p.x, (bf16_t*)(p.ws + WS_X1), (const float*)(p.ws + WS_MOD)});
}
__device__ __forceinline__ void gemm_query(const P& p, char* smem) {
    run_gemm(smem, (const bf16_t*)(p.ws + WS_H), (const bf16_t*)(p.ws + WS_WQ), T, 2048, EpiQuery{(bf16_t*)(p.ws + WS_QUERY)});
}

__device__ __forceinline__ void attn_store(const P& p, const f32x16& o0, const f32x16& o1, float rs, const float* gout, int b, int h, int qt, int r, int hh, size_t dstoff = WS_MIX) {
    float ss = 0.f;
#pragma unroll
    for (int i = 0; i < 16; ++i) { const float a = o0[i] * rs, c = o1[i] * rs; ss += a * a + c * c; }
    ss = xor32_sum(ss);
    const float inv = rsqrtf(ss * (1.f / 64.f) + EPS) * rs;
    bf16_t* dst = (bf16_t*)(p.ws + dstoff) + (size_t)(b * SEQ + qt * 32 + r) * D + h * 64;
#pragma unroll
    for (int dt = 0; dt < 2; ++dt)
#pragma unroll
        for (int g = 0; g < 4; ++g) {
            const int d = dt * 32 + 8 * g + 4 * hh;
            const f32x4 gg = *(const f32x4*)(gout + d);
            const f32x16& o = dt == 0 ? o0 : o1;
            u32x2 w; w.x = cvt_pk_bf16(o[4 * g] * inv * gg.x, o[4 * g + 1] * inv * gg.y); w.y = cvt_pk_bf16(o[4 * g + 2] * inv * gg.z, o[4 * g + 3] * inv * gg.w);
            *(u32x2*)(dst + d) = w;
        }
}

__device__ __forceinline__ bf16x8 pack8(float a0, float a1, float a2, float a3, float a4, float a5, float a6, float a7) {
    u32x4 w; w.x = cvt_pk_bf16(a0, a1); w.y = cvt_pk_bf16(a2, a3); w.z = cvt_pk_bf16(a4, a5); w.w = cvt_pk_bf16(a6, a7);
    return __builtin_bit_cast(bf16x8, w);
}
__device__ __forceinline__ bf16x8 load_vfrag(const bf16_t* vt, int dt, int r, int s, int hh) {
    const bf16_t* a = vt + (dt * 32 + r) * 32 + 16 * s + 4 * hh;
    const u32x2 lo = *(const u32x2*)a, hi = *(const u32x2*)(a + 8);
    u32x4 w; w.x = lo.x; w.y = lo.y; w.z = hi.x; w.w = hi.y;
    return __builtin_bit_cast(bf16x8, w);
}

constexpr int ATT_WAVE_LDS = 4096 + 64 * 72;
struct RawTile { u32x4 k[4], v[4]; };
__device__ __forceinline__ void raw_load(RawTile& t, const bf16_t* Kp, const bf16_t* Vp, int kt, int lane) {
    const u32x4* gk = (const u32x4*)(Kp + (size_t)kt * 2048) + lane;
    const u32x4* gv = (const u32x4*)(Vp + (size_t)kt * 2048) + lane;
#pragma unroll
    for (int i = 0; i < 4; ++i) { t.k[i] = gk[64 * i]; t.v[i] = gv[64 * i]; }
}
__device__ __forceinline__ void raw_store(const RawTile& t, char* wl, int lane) {
#pragma unroll
    for (int i = 0; i < 4; ++i) {
        const int row = i * 8 + (lane >> 3), ch = lane & 7;
        *(u32x4*)(wl + row * 128 + ((ch ^ ((row >> 1) & 7)) * 16)) = t.k[i];
        const int d = i * 16 + (lane >> 2), c4 = lane & 3;
        u32x2 lo, hi; lo.x = t.v[i].x; lo.y = t.v[i].y; hi.x = t.v[i].z; hi.y = t.v[i].w;
        *(u32x2*)(wl + 4096 + d * 72 + c4 * 16) = lo;
        *(u32x2*)(wl + 4096 + d * 72 + c4 * 16 + 8) = hi;
    }
}
__device__ __forceinline__ void frag_read(bf16x8 (&kf)[4], bf16x8 (&vf)[4], const char* wl, int r, int hh) {
#pragma unroll
    for (int kk = 0; kk < 4; ++kk) kf[kk] = *(const bf16x8*)(wl + r * 128 + (((2 * kk + hh) ^ ((r >> 1) & 7)) * 16));
#pragma unroll
    for (int s2 = 0; s2 < 2; ++s2)
#pragma unroll
        for (int dt = 0; dt < 2; ++dt) {
            const char* a = wl + 4096 + (dt * 32 + r) * 72 + 32 * s2 + 8 * hh;
            const u32x2 lo = *(const u32x2*)a, hi = *(const u32x2*)(a + 16);
            u32x4 w; w.x = lo.x; w.y = lo.y; w.z = hi.x; w.w = hi.y;
            vf[2 * s2 + dt] = __builtin_bit_cast(bf16x8, w);
        }
}

template <bool DIAG>
__device__ __forceinline__ void fox_tile(const bf16x8 (&kf)[4], const bf16x8 (&vf)[4], const bf16x8 (&qf)[4], const f32x4 (&fk)[4], float Fq, float off,
                                         int hh, int r, float& m, float& lsum, f32x16& o0, f32x16& o1) {
    f32x16 s;
#pragma unroll
    for (int i = 0; i < 16; ++i) s[i] = 0.f;
#pragma unroll
    for (int kk = 0; kk < 4; ++kk) s = __builtin_amdgcn_mfma_f32_32x32x16_bf16(kf[kk], qf[kk], s, 0, 0, 0);
    const float fb = Fq - off;
    float lg[16]; float tmax = -INFINITY;
#pragma unroll
    for (int i = 0; i < 16; ++i) {
        float v = s[i] * SC2 + (fb - fk[i >> 2][i & 3]);
        if (DIAG && (8 * (i >> 2) + 4 * hh + (i & 3)) > r) v = -INFINITY;
        lg[i] = v; tmax = fmaxf(tmax, v);
    }
    tmax = xor32_max(tmax);
    const float mnew = fmaxf(m, tmax);
    if (!__all(mnew == m)) {
        const float alpha = __builtin_amdgcn_exp2f(m - mnew);
        lsum *= alpha;
#pragma unroll
        for (int i = 0; i < 16; ++i) { o0[i] *= alpha; o1[i] *= alpha; }
        m = mnew;
    }
    float ps = 0.f;
#pragma unroll
    for (int i = 0; i < 16; ++i) { lg[i] = __builtin_amdgcn_exp2f(lg[i] - m); ps += lg[i]; }
    lsum += xor32_sum(ps);
#pragma unroll
    for (int s2 = 0; s2 < 2; ++s2) {
        const bf16x8 pf = pack8(lg[8 * s2], lg[8 * s2 + 1], lg[8 * s2 + 2], lg[8 * s2 + 3], lg[8 * s2 + 4], lg[8 * s2 + 5], lg[8 * s2 + 6], lg[8 * s2 + 7]);
        o0 = __builtin_amdgcn_mfma_f32_32x32x16_bf16(vf[2 * s2], pf, o0, 0, 0, 0);
        o1 = __builtin_amdgcn_mfma_f32_32x32x16_bf16(vf[2 * s2 + 1], pf, o1, 0, 0, 0);
    }
}

template <bool DIAG>
__device__ __forceinline__ void sb_tile(const bf16x8 (&kf)[4], const bf16x8 (&vf)[4], const bf16x8 (&qf)[4], int hh, int r, float& R, f32x16& o0, f32x16& o1) {
    f32x16 s;
#pragma unroll
    for (int i = 0; i < 16; ++i) s[i] = 0.f;
#pragma unroll
    for (int kk = 0; kk < 4; ++kk) s = __builtin_amdgcn_mfma_f32_32x32x16_bf16(kf[kk], qf[kk], s, 0, 0, 0);
    float lom[16], lb[16];
#pragma unroll
    for (int i = 0; i < 16; ++i) {
        const float z = s[i] * SC2;
        const float sp = fmaxf(z, 0.f) + __builtin_amdgcn_logf(1.f + __builtin_amdgcn_exp2f(-fabsf(z)));
        const bool valid = !DIAG || (8 * (i >> 2) + 4 * hh + (i & 3)) < r;
        lom[i] = valid ? -sp : 0.f;
        lb[i] = valid ? (z - sp) : -INFINITY;
    }
    float G[4], PG[4], Tt[4];
#pragma unroll
    for (int g = 0; g < 4; ++g) { G[g] = (lom[4 * g] + lom[4 * g + 1]) + (lom[4 * g + 2] + lom[4 * g + 3]); PG[g] = xor32_get(G[g], hh); Tt[g] = G[g] + PG[g]; }
    float TS[4]; TS[3] = 0.f; TS[2] = Tt[3]; TS[1] = TS[2] + Tt[2]; TS[0] = TS[1] + Tt[1];
    float a[16];
#pragma unroll
    for (int g = 0; g < 4; ++g) {
        const float r3 = R + TS[g] + (hh == 0 ? PG[g] : 0.f);
        const float r2 = r3 + lom[4 * g + 3], r1 = r2 + lom[4 * g + 2], r0 = r1 + lom[4 * g + 1];
        a[4 * g + 3] = __builtin_amdgcn_exp2f(lb[4 * g + 3] + r3); a[4 * g + 2] = __builtin_amdgcn_exp2f(lb[4 * g + 2] + r2);
        a[4 * g + 1] = __builtin_amdgcn_exp2f(lb[4 * g + 1] + r1); a[4 * g + 0] = __builtin_amdgcn_exp2f(lb[4 * g + 0] + r0);
    }
    R += TS[0] + Tt[0];
#pragma unroll
    for (int s2 = 0; s2 < 2; ++s2) {
        const bf16x8 pf = pack8(a[8 * s2], a[8 * s2 + 1], a[8 * s2 + 2], a[8 * s2 + 3], a[8 * s2 + 4], a[8 * s2 + 5], a[8 * s2 + 6], a[8 * s2 + 7]);
        o0 = __builtin_amdgcn_mfma_f32_32x32x16_bf16(vf[2 * s2], pf, o0, 0, 0, 0);
        o1 = __builtin_amdgcn_mfma_f32_32x32x16_bf16(vf[2 * s2 + 1], pf, o1, 0, 0, 0);
    }
}

template <int PMODE>
__device__ __forceinline__ void attn_task(const P& p, char* wl, const float* gl, int type, int bh, int qt, int lane) {
    const int r = lane & 31, hh = lane >> 5, b = bh >> 3, h = bh & 7;
    const size_t segoff = (size_t)(type * 3) * 32 * MiB;
    const bf16_t* Q = (const bf16_t*)(p.ws + WS_QF + segoff) + ((size_t)bh * SEQ + qt * 32) * 64;
    const bf16_t* Kp = (const bf16_t*)(p.ws + WS_QF + segoff + 32 * MiB) + (size_t)bh * SEQ * 64;
    const bf16_t* Vp = (const bf16_t*)(p.ws + WS_QF + segoff + 64 * MiB) + (size_t)bh * 256 * 2048;
    RawTile raw;
    raw_load(raw, Kp, Vp, qt, lane);
    bf16x8 qf[4];
#pragma unroll
    for (int kk = 0; kk < 4; ++kk) qf[kk] = *(const bf16x8*)(Q + r * 64 + kk * 16 + hh * 8);
    f32x16 o0, o1;
#pragma unroll
    for (int i = 0; i < 16; ++i) { o0[i] = 0.f; o1[i] = 0.f; }
    float rs = 1.f;
    bf16x8 kf[4], vf[4];
    const float* F = (const float*)(p.ws + WS_FLOC) + (size_t)bh * SEQ;
    const float* Ct = (const float*)(p.ws + WS_CTOT) + bh * 128;
    f32x4 fk[4];
#pragma unroll
    for (int g = 0; g < 4; ++g) fk[g] = *(const f32x4*)(F + qt * 32 + 8 * g + 4 * hh);
    const float Fq = F[qt * 32 + r];
    const float kmx = __uint_as_float(((const unsigned*)(p.ws + WS_KMAX))[bh * 2]) + __uint_as_float(((const unsigned*)(p.ws + WS_KMAX))[bh * 2 + 1]);
    raw_store(raw, wl, lane);
    if (type == 0) {
        float Flast = 0.f;
        float qn2 = 0.f;
#pragma unroll
        for (int kk = 0; kk < 4; ++kk)
#pragma unroll
            for (int j = 0; j < 8; ++j) { const float v = bf2f((bf16_t)qf[kk][j]); qn2 += v * v; }
        qn2 = xor32_sum(qn2);
        const float qb = (sqrtf(qn2 * kmx) * ATT_SCALE * 1.01f + 0.01f) * LOG2E;
        float off = 0.f, m = -INFINITY, lsum = 0.f;
        f32x4 fn[4]; float ctn = 0.f;
        frag_read(kf, vf, wl, r, hh);
        if (qt > 0) {
            raw_load(raw, Kp, Vp, qt - 1, lane);
#pragma unroll
            for (int g = 0; g < 4; ++g) fn[g] = *(const f32x4*)(F + (qt - 1) * 32 + 8 * g + 4 * hh);
            Flast = F[(qt - 1) * 32 + 31]; ctn = ((qt - 1) & 1) ? Ct[(qt - 1) >> 1] : 0.f;
        }
        fox_tile<true>(kf, vf, qf, fk, Fq, off, hh, r, m, lsum, o0, o1);
        for (int kt = qt - 1; kt >= 0 && PMODE != 1; --kt) {
            raw_store(raw, wl, lane);
            off -= ctn;
            if (__all((qb + Fq - (Flast + off)) - m < -THRESH2)) break;
#pragma unroll
            for (int g = 0; g < 4; ++g) fk[g] = fn[g];
            frag_read(kf, vf, wl, r, hh);
            if (kt > 0) {
                raw_load(raw, Kp, Vp, kt - 1, lane);
#pragma unroll
                for (int g = 0; g < 4; ++g) fn[g] = *(const f32x4*)(F + (kt - 1) * 32 + 8 * g + 4 * hh);
                Flast = F[(kt - 1) * 32 + 31]; ctn = ((kt - 1) & 1) ? Ct[(kt - 1) >> 1] : 0.f;
            }
            fox_tile<false>(kf, vf, qf, fk, Fq, off, hh, r, m, lsum, o0, o1);
        }
        rs = 1.f / lsum;
    } else {
        float R = 0.f;
        frag_read(kf, vf, wl, r, hh);
        if (qt > 0) raw_load(raw, Kp, Vp, qt - 1, lane);
        sb_tile<true>(kf, vf, qf, hh, r, R, o0, o1);
        for (int kt = qt - 1; kt >= 0 && PMODE != 1; --kt) {
            raw_store(raw, wl, lane);
            if (__all(R < -THRESH2)) break;
            frag_read(kf, vf, wl, r, hh);
            if (kt > 0) raw_load(raw, Kp, Vp, kt - 1, lane);
            sb_tile<false>(kf, vf, qf, hh, r, R, o0, o1);
        }
    }
    attn_store(p, o0, o1, rs, gl + type * 64, b, type * 8 + h, qt, r, hh, PMODE == 0 ? WS_MIX : WS_H);
}

__device__ __forceinline__ void expert_cvt_job(const P& p, int job, int lane) {
    const int row0 = job * 8;
    const float* src = row0 < 16384 ? p.e_down : p.e_up;
    unsigned char* dst = p.ws + (row0 < 16384 ? WS_ED : WS_EU);
    float* rs = (float*)(p.ws + (row0 < 16384 ? WS_RSD : WS_RSU));
    const int r0 = row0 & 16383;
#pragma unroll 1
    for (int h4 = 0; h4 < 8; h4 += 4) {
        RowF32 rr[4];
#pragma unroll
        for (int k = 0; k < 4; ++k) row_load(rr[k], src, r0 + h4 + k, lane);
#pragma unroll
        for (int k = 0; k < 4; ++k) cvt_row_q4(rr[k], dst, rs, r0 + h4 + k, lane);
    }
}
template <int PMODE = 0>
__device__ __forceinline__ void attn_phase(const P& p, char* smem, int bid, int nblk, int cidx = 0, unsigned tlo = 0u, unsigned thi = 2560u) {
    const int lane = threadIdx.x & 63;
    char* wl = smem + (threadIdx.x >> 6) * ATT_WAVE_LDS;
    float* gl = (float*)(smem + NWAVE * ATT_WAVE_LDS);
    if (threadIdx.x < 128) gl[threadIdx.x] = threadIdx.x < 64 ? p.g_fox[threadIdx.x] : p.g_sb[threadIdx.x - 64];
    __syncthreads();
    unsigned* ctr = (unsigned*)(p.ws + WS_KMAX) + 64 + 1024 * cidx;
    int q = bid & 7, tried = 0;
    unsigned tk = 0;
    if (lane == 0) tk = atomicAdd(ctr + 64 * q, 1u);
    for (;;) {
        const unsigned i = (unsigned)__builtin_amdgcn_readfirstlane((int)tk) + tlo;
        if (i >= thi) {
            if (++tried == 8) break;
            q = (q + 1) & 7;
            if (lane == 0) tk = atomicAdd(ctr + 64 * q, 1u);
            continue;
        }
        if (lane == 0) tk = atomicAdd(ctr + 64 * q, 1u);
        const unsigned g5 = i / 5u, r5 = i - 5u * g5;
        if (r5 == 4u) { if (PMODE == 0) expert_cvt_job(p, (int)(q * 512 + g5), lane); continue; }
        const unsigned a = 4u * g5 + r5;
        const int type = a >> 10, rem = (int)(a & 1023u) * 8 + q, qt = 255 - (rem >> 5), bh = rem & 31;
        attn_task<PMODE>(p, wl, gl, type, bh, qt, lane);
    }
}

__device__ __forceinline__ void p5_row(const P& p, const f32x4 (&A2)[4], const f32x4 (&B2)[4], int t, int lane, const u32x4& xa, const u32x4& xb) {
    float v[16]; float ss = 0.f;
#pragma unroll
    for (int i = 0; i < 4; ++i) { v[2 * i] = bf_lo(xa[i]); v[2 * i + 1] = bf_hi(xa[i]); v[8 + 2 * i] = bf_lo(xb[i]); v[8 + 2 * i + 1] = bf_hi(xb[i]); }
#pragma unroll
    for (int i = 0; i < 16; ++i) ss += v[i] * v[i];
    const float inv = rsqrtf(wave_sum(ss) * (1.f / D) + EPS);
    u32x4 o[2];
#pragma unroll
    for (int q = 0; q < 4; ++q) {
        f32x4 h;
#pragma unroll
        for (int e2 = 0; e2 < 4; ++e2) h[e2] = (v[4 * q + e2] * inv) * A2[q][e2] + B2[q][e2];
        o[q >> 1][(q & 1) * 2] = cvt_pk_bf16(h[0], h[1]); o[q >> 1][(q & 1) * 2 + 1] = cvt_pk_bf16(h[2], h[3]);
    }
    bf16_t* hbuf = (bf16_t*)(p.ws + WS_H);
    *(u32x4*)(hbuf + (size_t)t * D + 16 * lane) = o[0]; *(u32x4*)(hbuf + (size_t)t * D + 16 * lane + 8) = o[1];
}
__device__ __forceinline__ void p5_norm2(const P& p, int bid, int nblk) {
    const int lane = threadIdx.x & 63, wid = threadIdx.x >> 6;
    const float* mod = (const float*)(p.ws + WS_MOD);
    const bf16_t* x1 = (const bf16_t*)(p.ws + WS_X1);
    const int nw = nblk * NWAVE;
    int bcur = -1; f32x4 A2[4], B2[4];
    for (int t = bid * NWAVE + wid; t < T; t += 4 * nw) {
        u32x4 xa[4], xb[4];
#pragma unroll
        for (int k = 0; k < 4; ++k) { xa[k] = *(const u32x4*)(x1 + (size_t)(t + k * nw) * D + 16 * lane); xb[k] = *(const u32x4*)(x1 + (size_t)(t + k * nw) * D + 16 * lane + 8); }
#pragma unroll
        for (int k = 0; k < 4; ++k) {
            const int tk = t + k * nw, b = tk >> 13;
            if (b != bcur) {
                bcur = b;
#pragma unroll
                for (int q = 0; q < 4; ++q) {
                    const f32x4 g = *(const f32x4*)(p.g_ffn + 16 * lane + 4 * q);
                    const f32x4 s = *(const f32x4*)(mod + b * NMOD + 4096 + 16 * lane + 4 * q);
                    A2[q] = g * (s + 1.0f); B2[q] = *(const f32x4*)(mod + b * NMOD + 3072 + 16 * lane + 4 * q);
                }
            }
            p5_row(p, A2, B2, tk, lane, xa[k], xb[k]);
        }
    }
}

__device__ __forceinline__ int enc_key(float v) { const int u = __float_as_int(v); return u ^ ((u >> 31) & 0x7fffffff); }
__device__ __forceinline__ float dec_key(int k) { return __int_as_float(k ^ ((k >> 31) & 0x7fffffff)); }
#define KEY_LOWEST ((int)0x80000000)
#define INS16(L, v) do { int _v = (v); _Pragma("unroll") for (int _s = 0; _s < 16; ++_s) { const int _h = max(L[_s], _v); _v = min(L[_s], _v); L[_s] = _h; } } while (0)

#define CEX(a,i,j) { const int _h = max(a[i], a[j]); const int _l = min(a[i], a[j]); a[i] = _h; a[j] = _l; }
#define SORT16_DESC(a) do { CEX(a,0,1); CEX(a,2,3); CEX(a,0,2); CEX(a,1,3); CEX(a,1,2); CEX(a,4,5); CEX(a,6,7); CEX(a,4,6); CEX(a,5,7); CEX(a,5,6); CEX(a,0,4); CEX(a,2,6); CEX(a,2,4); CEX(a,1,5); CEX(a,3,7); CEX(a,3,5); CEX(a,1,2); CEX(a,3,4); CEX(a,5,6); CEX(a,8,9); CEX(a,10,11); CEX(a,8,10); CEX(a,9,11); CEX(a,9,10); CEX(a,12,13); CEX(a,14,15); CEX(a,12,14); CEX(a,13,15); CEX(a,13,14); CEX(a,8,12); CEX(a,10,14); CEX(a,10,12); CEX(a,9,13); CEX(a,11,15); CEX(a,11,13); CEX(a,9,10); CEX(a,11,12); CEX(a,13,14); CEX(a,0,8); CEX(a,4,12); CEX(a,4,8); CEX(a,2,10); CEX(a,6,14); CEX(a,6,10); CEX(a,2,4); CEX(a,6,8); CEX(a,10,12); CEX(a,1,9); CEX(a,5,13); CEX(a,5,9); CEX(a,3,11); CEX(a,7,15); CEX(a,7,11); CEX(a,3,5); CEX(a,7,9); CEX(a,11,13); CEX(a,1,2); CEX(a,3,4); CEX(a,5,6); CEX(a,7,8); CEX(a,9,10); CEX(a,11,12); CEX(a,13,14); } while (0)
#define BMERGE16_DESC(a) do { CEX(a,0,8); CEX(a,1,9); CEX(a,2,10); CEX(a,3,11); CEX(a,4,12); CEX(a,5,13); CEX(a,6,14); CEX(a,7,15); CEX(a,0,4); CEX(a,1,5); CEX(a,2,6); CEX(a,3,7); CEX(a,8,12); CEX(a,9,13); CEX(a,10,14); CEX(a,11,15); CEX(a,0,2); CEX(a,1,3); CEX(a,4,6); CEX(a,5,7); CEX(a,8,10); CEX(a,9,11); CEX(a,12,14); CEX(a,13,15); CEX(a,0,1); CEX(a,2,3); CEX(a,4,5); CEX(a,6,7); CEX(a,8,9); CEX(a,10,11); CEX(a,12,13); CEX(a,14,15); } while (0)
#define MERGE_TOP16(A, B) do { _Pragma("unroll") for (int _i = 0; _i < 16; ++_i) A[_i] = max(A[_i], B[15 - _i]); BMERGE16_DESC(A); } while (0)
constexpr int SK_ROW = 272;

struct QFrag { bf16x8 f[16]; };
__device__ __forceinline__ void topk_load_q(QFrag& q, const P& p, int tt, int h, int lane) {
    const bf16_t* qrow = (const bf16_t*)(p.ws + WS_QUERY) + (size_t)(tt * 32 + (lane & 31)) * 2048 + h * 256 + (lane >> 5) * 8;
#pragma unroll
    for (int i = 0; i < 16; ++i) q.f[i] = *(const bf16x8*)(qrow + i * 16);
}
__device__ __forceinline__ void topk_tile(const bf16x8* qf, const char* img, int mt, int r, int hh, int (&Kk)[16]) {
    f32x16 sc;
#pragma unroll
    for (int i = 0; i < 16; ++i) sc[i] = 0.f;
#pragma unroll
    for (int kk = 0; kk < 8; ++kk) {
        const bf16x8 kf = *(const bf16x8*)(img + (mt * 32 + r) * SK_ROW + kk * 32 + hh * 16);
        sc = __builtin_amdgcn_mfma_f32_32x32x16_bf16(kf, qf[kk], sc, 0, 0, 0);
    }
#pragma unroll
    for (int i = 0; i < 16; ++i) Kk[i] = (enc_key(sc[i]) & ~127) | (mt * 32 + 8 * (i >> 2) + 4 * hh + (i & 3));
    SORT16_DESC(Kk);
}
__device__ __forceinline__ void topk_half(const bf16x8* qf, const char* img, int r, int hh, int (&Lk)[16]) {
    topk_tile(qf, img, 0, r, hh, Lk);
#pragma unroll 1
    for (int mt = 1; mt < 4; ++mt) {
        int Kk[16];
        topk_tile(qf, img, mt, r, hh, Kk);
        MERGE_TOP16(Lk, Kk);
    }
    int Pn[16];
#pragma unroll
    for (int s = 0; s < 16; ++s) Pn[s] = __shfl_xor(Lk[s], 32);
    MERGE_TOP16(Lk, Pn);
}

__device__ __forceinline__ void topk_task(const P& p, const char* img, QFrag& qf, int tt, int tt_next, int h, int lane) {
    const int r = lane & 31, hh = lane >> 5, t = tt * 32 + r;
    int La[16], Lb[16];
    topk_half(qf.f, img, r, hh, La);
    topk_half(qf.f + 8, img + 128 * SK_ROW, r, hh, Lb);
    if (tt_next < T / 32) topk_load_q(qf, p, tt_next, h, lane);
    float v1[16], v2[16];
#pragma unroll
    for (int s = 0; s < 16; ++s) { v1[s] = dec_key(La[s] & ~127); v2[s] = dec_key(Lb[s] & ~127); }
    unsigned long long I1lo = 0, I1hi = 0, I2lo = 0, I2hi = 0;
#pragma unroll
    for (int s = 0; s < 8; ++s) {
        I1lo |= (unsigned long long)(unsigned)(La[s] & 127) << (8 * s); I1hi |= (unsigned long long)(unsigned)(La[s + 8] & 127) << (8 * s);
        I2lo |= (unsigned long long)(unsigned)(Lb[s] & 127) << (8 * s); I2hi |= (unsigned long long)(unsigned)(Lb[s + 8] & 127) << (8 * s);
    }
#define CK(a, b) ((enc_key(v1[a] + v2[b]) & ~255) | ((a) * 16 + (b)))
    int C[16], G[16];
#pragma unroll
    for (int bq = 0; bq < 16; ++bq) C[bq] = CK(0, bq);
#pragma unroll
    for (int bq = 0; bq < 8; ++bq) G[bq] = CK(1, bq);
#pragma unroll
    for (int bq = 0; bq < 5; ++bq) G[8 + bq] = CK(2, bq);
#pragma unroll
    for (int bq = 0; bq < 3; ++bq) G[13 + bq] = CK(4, bq);
    SORT16_DESC(G); MERGE_TOP16(C, G);
#pragma unroll
    for (int bq = 0; bq < 4; ++bq) G[bq] = CK(3, bq);
    G[4] = CK(5, 0); G[5] = CK(5, 1); G[6] = CK(6, 0); G[7] = CK(6, 1); G[8] = CK(7, 0); G[9] = CK(7, 1);
    G[10] = CK(8, 0); G[11] = CK(9, 0); G[12] = CK(10, 0); G[13] = CK(11, 0); G[14] = CK(12, 0); G[15] = CK(13, 0);
    SORT16_DESC(G); MERGE_TOP16(C, G);
    INS16(C, CK(14, 0)); INS16(C, CK(15, 0));
#undef CK
    float tv[16]; float sum = 0.f;
    const float mx = dec_key(C[0] & ~255);
#pragma unroll
    for (int s = 0; s < 16; ++s) { tv[s] = __expf(dec_key(C[s] & ~255) - mx); sum += tv[s]; }
    const float rinv = 1.f / sum;
    unsigned* ex = (unsigned*)(p.ws + WS_EXP) + (size_t)t * 128 + h * 16 + hh * 8;
    u32x4 eo[2];
#pragma unroll
    for (int s = 0; s < 8; ++s) {
        const int hm = -hh;
        const unsigned cs = (unsigned)(C[s] ^ ((C[s] ^ C[s + 8]) & hm));
        const float gv = __uint_as_float(__float_as_uint(tv[s]) ^ ((__float_as_uint(tv[s]) ^ __float_as_uint(tv[s + 8])) & (unsigned)hm)) * rinv;
        const unsigned pos = cs & 255u, a = pos >> 4, bq = pos & 15u;
        const unsigned i1 = (unsigned)(((a & 8u) ? I1hi : I1lo) >> (8 * (a & 7u))) & 127u;
        const unsigned i2 = (unsigned)(((bq & 8u) ? I2hi : I2lo) >> (8 * (bq & 7u))) & 127u;
        eo[s >> 2][s & 3] = (i1 * 128u + i2) | (cvt_pk_bf16(gv, 0.f) << 16);
    }
    *(u32x4*)ex = eo[0]; *(u32x4*)(ex + 4) = eo[1];
}

__device__ __forceinline__ void topk_phase(const P& p, char* smem, int bid, int nblk) {
    const int tid = threadIdx.x, lane = tid & 63, wid = tid >> 6, h = bid & 7;
    const bf16_t* sk = (const bf16_t*)(p.ws + WS_SK) + (size_t)h * 2 * 128 * 128;
    const int nslots = (nblk >> 3) * NWAVE;
    QFrag qf;
    const int tt0 = (bid >> 3) * NWAVE + wid;
    if (tt0 < T / 32) topk_load_q(qf, p, tt0, h, lane);
    for (int idx = tid; idx < 4096; idx += NTHR) {
        const int row = idx >> 4, ch = idx & 15;
        *(u32x4*)(smem + row * SK_ROW + ch * 16) = *(const u32x4*)(sk + (size_t)row * 128 + ch * 8);
    }
    __syncthreads();
    for (int tt = tt0; tt < T / 32; tt += nslots) topk_task(p, smem, qf, tt, tt + nslots, h, lane);
    __syncthreads();
}

__device__ __forceinline__ float gelu_erf(float v) { return 0.5f * v * (1.f + erff(v * 0.70710678118654752f)); }

struct PeerIdx { int e0, e1; };
struct Rows8 { u32x4 r[8]; float sc[8]; };
__device__ __forceinline__ void peer_rows8(Rows8& b, const unsigned char* tab, const float* scale, const PeerIdx& ix, int jb, int lane) {
#pragma unroll
    for (int q = 0; q < 8; ++q) {
        const int e = __builtin_amdgcn_readlane(jb < 64 ? ix.e0 : ix.e1, (jb + q) & 63);
        b.r[q] = *(const u32x4*)(tab + (size_t)e * 1024 + 16 * lane);
        b.sc[q] = scale[e];
    }
}
struct Rows16h { u32x4 r[8]; float sc[8]; };
__device__ __forceinline__ void peer_rows16h(Rows16h& b, const unsigned char* tab, const float* scale, const PeerIdx& ix, int jb, int lane) {
    const int hh = lane >> 5, l5 = lane & 31;
#pragma unroll
    for (int i = 0; i < 8; ++i) {
        const int ee = __builtin_amdgcn_readlane(jb < 64 ? ix.e0 : ix.e1, (jb + 2 * i) & 63);
        const int eo = __builtin_amdgcn_readlane(jb < 64 ? ix.e0 : ix.e1, (jb + 2 * i + 1) & 63);
        const int e = hh ? eo : ee;
        b.r[i] = *(const u32x4*)(tab + (size_t)e * 512 + 16 * l5);
        b.sc[i] = scale[e];
    }
}
__device__ __forceinline__ float peer_down_batch16(const Rows16h& b, const unsigned (&hqE)[4], const unsigned (&hqO)[4], float hbias, float hscale) {
    const int lane = threadIdx.x & 63;
    const int b4 = lane & 16, b3 = lane & 8, b2 = lane & 4;
    float dot[8];
#pragma unroll
    for (int i = 0; i < 8; ++i) {
        int s = 0;
#pragma unroll
        for (int d = 0; d < 4; ++d) {
            const unsigned x = b.r[i][d];
            s = __builtin_amdgcn_sdot4((int)(x & 0x0f0f0f0fu), (int)hqE[d], s, false);
            s = __builtin_amdgcn_sdot4((int)((x >> 4) & 0x0f0f0f0fu), (int)hqO[d], s, false);
        }
        dot[i] = ((float)s - hbias) * (b.sc[i] * hscale);
    }
    float k4[4], k2[2];
#pragma unroll
    for (int j = 0; j < 4; ++j) { const float snd = b4 ? dot[j] : dot[j + 4]; k4[j] = (b4 ? dot[j + 4] : dot[j]) + __shfl_xor(snd, 16); }
#pragma unroll
    for (int j = 0; j < 2; ++j) { const float snd = b3 ? k4[j] : k4[j + 2]; k2[j] = (b3 ? k4[j + 2] : k4[j]) + __shfl_xor(snd, 8); }
    const float snd = b2 ? k2[0] : k2[1];
    float v = (b2 ? k2[1] : k2[0]) + __shfl_xor(snd, 4);
    v += __shfl_xor(v, 2); v += __shfl_xor(v, 1);
    return v;
}
struct DownIn { u32x4 hraw[4]; unsigned rc0, rc1; };
__device__ __forceinline__ void down_in_load(DownIn& d, const P& p, int t, int lane) {
    const bf16_t* hrow = (const bf16_t*)(p.ws + WS_H) + (size_t)t * D + 32 * (lane & 31);
#pragma unroll
    for (int i = 0; i < 4; ++i) d.hraw[i] = *(const u32x4*)(hrow + 8 * i);
    const unsigned* ex = (const unsigned*)(p.ws + WS_EXP) + (size_t)t * 128;
    d.rc0 = ex[lane]; d.rc1 = ex[64 + lane];
}
__device__ __forceinline__ void peer_down_tok(const P& p, const float* RSD, DownIn& din, int t, int tnext, int lane) {
    u32x4 hraw[4];
#pragma unroll
    for (int i = 0; i < 4; ++i) hraw[i] = din.hraw[i];
    const unsigned rc0 = din.rc0, rc1 = din.rc1;
    PeerIdx ix; ix.e0 = (int)(rc0 & 0xffffu); ix.e1 = (int)(rc1 & 0xffffu);
    const float g0 = bf_hi(rc0), g1 = bf_hi(rc1);
    const unsigned char* ED = p.ws + WS_ED;
    unsigned* act = (unsigned*)(p.ws + WS_ACT) + (size_t)t * 128;
    Rows16h ba, bb, bc;
    peer_rows16h(ba, ED, RSD, ix, 0, lane); peer_rows16h(bb, ED, RSD, ix, 16, lane); peer_rows16h(bc, ED, RSD, ix, 32, lane);
    if (tnext < T) down_in_load(din, p, tnext, lane);
    float hv[32]; float mx = 0.f;
#pragma unroll
    for (int i = 0; i < 4; ++i)
#pragma unroll
        for (int k = 0; k < 4; ++k) { hv[8 * i + 2 * k] = bf_lo(hraw[i][k]); hv[8 * i + 2 * k + 1] = bf_hi(hraw[i][k]); }
#pragma unroll
    for (int i = 0; i < 32; ++i) mx = fmaxf(mx, fabsf(hv[i]));
    mx = wave_max(mx);
    const float qs = mx > 0.f ? 127.f / mx : 1.f, hscale = mx > 0.f ? mx * (1.f / 127.f) : 1.f;
    float hsum = 0.f;
#pragma unroll
    for (int i = 0; i < 32; ++i) { hv[i] = __builtin_rintf(hv[i] * qs); hsum += hv[i]; }
    unsigned hqE[4], hqO[4];
#pragma unroll
    for (int d = 0; d < 4; ++d) { hqE[d] = pack_i8x4(hv[8 * d], hv[8 * d + 2], hv[8 * d + 4], hv[8 * d + 6]); hqO[d] = pack_i8x4(hv[8 * d + 1], hv[8 * d + 3], hv[8 * d + 5], hv[8 * d + 7]); }
    const float hbias = 7.5f * hsum;
    float res[8];
    res[0] = peer_down_batch16(ba, hqE, hqO, hbias, hscale);  peer_rows16h(ba, ED, RSD, ix, 48, lane);
    res[1] = peer_down_batch16(bb, hqE, hqO, hbias, hscale);  peer_rows16h(bb, ED, RSD, ix, 64, lane);
    res[2] = peer_down_batch16(bc, hqE, hqO, hbias, hscale);  peer_rows16h(bc, ED, RSD, ix, 80, lane);
    res[3] = peer_down_batch16(ba, hqE, hqO, hbias, hscale);  peer_rows16h(ba, ED, RSD, ix, 96, lane);
    res[4] = peer_down_batch16(bb, hqE, hqO, hbias, hscale);  peer_rows16h(bb, ED, RSD, ix, 112, lane);
    res[5] = peer_down_batch16(bc, hqE, hqO, hbias, hscale);
    res[6] = peer_down_batch16(ba, hqE, hqO, hbias, hscale);
    res[7] = peer_down_batch16(bb, hqE, hqO, hbias, hscale);
    const int sl = (lane & 1) * 32 + ((lane >> 1) & 7) * 4, bsel = lane >> 4;
    float s0 = __shfl(res[0], sl), s1 = __shfl(res[4], sl);
#pragma unroll
    for (int k = 1; k < 4; ++k) { const float x0 = __shfl(res[k], sl), x1 = __shfl(res[4 + k], sl); s0 = bsel == k ? x0 : s0; s1 = bsel == k ? x1 : s1; }
    act[lane] = (rc0 & 0xffffu) | (cvt_pk_bf16(gelu_erf(s0) * g0, 0.f) << 16); act[64 + lane] = (rc1 & 0xffffu) | (cvt_pk_bf16(gelu_erf(s1) * g1, 0.f) << 16);
}
__device__ __forceinline__ void stage_scales(const float* src, char* smem) {
    for (int i = threadIdx.x; i < 4096; i += NTHR) ((f32x4*)smem)[i] = ((const f32x4*)src)[i];
    __syncthreads();
}
__device__ __forceinline__ void peer_down_pass(const P& p, char* smem, int bid, int nblk) {
    const int lane = threadIdx.x & 63, wid = threadIdx.x >> 6;
    stage_scales((const float*)(p.ws + WS_RSD), smem);
    const int t0 = bid * NWAVE + wid, tstep = nblk * NWAVE;
    DownIn din;
    if (t0 < T) down_in_load(din, p, t0, lane);
    for (int t = t0; t < T; t += tstep) peer_down_tok(p, (const float*)smem, din, t, t + tstep, lane);
    __syncthreads();
}
struct Rows8h { u32x4 r[4]; };
__device__ __forceinline__ void peer_rows8h(Rows8h& b, const unsigned char* tab, const PeerIdx& ix, int jb, int lane) {
    const int hh = lane >> 5, l5 = lane & 31;
#pragma unroll
    for (int k = 0; k < 4; ++k) {
        const int ee = __builtin_amdgcn_readlane(jb < 64 ? ix.e0 : ix.e1, (jb + 2 * k) & 63);
        const int eo = __builtin_amdgcn_readlane(jb < 64 ? ix.e0 : ix.e1, (jb + 2 * k + 1) & 63);
        b.r[k] = *(const u32x4*)(tab + (size_t)(hh ? eo : ee) * 512 + 16 * l5);
    }
}
__device__ __forceinline__ void peer_up_group(const Rows8h& b, int (&acc)[32], int q0, int q1, int jb, int lane) {
    const int hh = lane >> 5;
    unsigned ce = 0u, co = 0u;
#pragma unroll
    for (int k = 0; k < 4; ++k) {
        ce |= ((unsigned)__builtin_amdgcn_readlane(jb < 64 ? q0 : q1, (jb + 2 * k) & 63) & 0xffu) << (8 * k);
        co |= ((unsigned)__builtin_amdgcn_readlane(jb < 64 ? q0 : q1, (jb + 2 * k + 1) & 63) & 0xffu) << (8 * k);
    }
    const int C = (int)(hh ? co : ce);
#pragma unroll
    for (int d = 0; d < 4; ++d)
#pragma unroll
        for (int par = 0; par < 2; ++par) {
            unsigned B[4];
#pragma unroll
            for (int k = 0; k < 4; ++k) B[k] = (par ? (b.r[k][d] >> 4) : b.r[k][d]) & 0x0f0f0f0fu;
            const unsigned p01l = __builtin_amdgcn_perm(B[1], B[0], 0x05010400u), p01h = __builtin_amdgcn_perm(B[1], B[0], 0x07030602u);
            const unsigned p23l = __builtin_amdgcn_perm(B[3], B[2], 0x05010400u), p23h = __builtin_amdgcn_perm(B[3], B[2], 0x07030602u);
            const unsigned t0 = __builtin_amdgcn_perm(p23l, p01l, 0x05040100u), t1 = __builtin_amdgcn_perm(p23l, p01l, 0x07060302u);
            const unsigned t2 = __builtin_amdgcn_perm(p23h, p01h, 0x05040100u), t3 = __builtin_amdgcn_perm(p23h, p01h, 0x07060302u);
            acc[8 * d + par + 0] = __builtin_amdgcn_sdot4((int)t0, C, acc[8 * d + par + 0], false);
            acc[8 * d + par + 2] = __builtin_amdgcn_sdot4((int)t1, C, acc[8 * d + par + 2], false);
            acc[8 * d + par + 4] = __builtin_amdgcn_sdot4((int)t2, C, acc[8 * d + par + 4], false);
            acc[8 * d + par + 6] = __builtin_amdgcn_sdot4((int)t3, C, acc[8 * d + par + 6], false);
        }
}
struct UpIn { unsigned rc0, rc1; };
__device__ __forceinline__ void up_in_load(UpIn& u, const P& p, int t, int lane) {
    const unsigned* act = (const unsigned*)(p.ws + WS_ACT) + (size_t)t * 128;
    u.rc0 = act[lane]; u.rc1 = act[64 + lane];
}
__device__ __forceinline__ void peer_up_tok(const P& p, const float* RSU, UpIn& uin, int t, int tnext, int lane, float* outbuf, const f32x4 (&gt2)[4], const f32x4 (&gfin)[4]) {
    const int hh = lane >> 5, l5 = lane & 31;
    const unsigned rc0 = uin.rc0, rc1 = uin.rc1;
    PeerIdx ix; ix.e0 = (int)(rc0 & 0xffffu); ix.e1 = (int)(rc1 & 0xffffu);
    const float a0 = bf_hi(rc0), a1 = bf_hi(rc1);
    const unsigned char* EU = p.ws + WS_EU;
    Rows8h g0, g1, g2, g3;
    peer_rows8h(g0, EU, ix, 0, lane); peer_rows8h(g1, EU, ix, 8, lane); peer_rows8h(g2, EU, ix, 16, lane); peer_rows8h(g3, EU, ix, 24, lane);
    if (tnext < T) up_in_load(uin, p, tnext, lane);
    const int col = 32 * l5 + 16 * hh;
    const bf16_t* xrow = (const bf16_t*)(p.ws + WS_X1) + (size_t)t * D + col;
    const u32x4 xa = *(const u32x4*)xrow, xb = *(const u32x4*)(xrow + 8);
    const float c0 = a0 * RSU[ix.e0], c1 = a1 * RSU[ix.e1];
    const float cmx = wave_max(fmaxf(fabsf(c0), fabsf(c1)));
    const float qs = cmx > 0.f ? 127.f / cmx : 0.f, cstep = cmx * (1.f / 127.f);
    const int q0 = (int)__builtin_rintf(c0 * qs), q1 = (int)__builtin_rintf(c1 * qs);
    const float qpar = (float)(q0 + q1);
    const float qev = wave_sum((lane & 1) ? 0.f : qpar), qod = wave_sum((lane & 1) ? qpar : 0.f);
    int acc[32];
#pragma unroll
    for (int i = 0; i < 32; ++i) acc[i] = 0;
#pragma unroll 1
    for (int jb = 0; jb < 96; jb += 32) {
        peer_up_group(g0, acc, q0, q1, jb, lane);      peer_rows8h(g0, EU, ix, jb + 32, lane);
        peer_up_group(g1, acc, q0, q1, jb + 8, lane);  peer_rows8h(g1, EU, ix, jb + 40, lane);
        peer_up_group(g2, acc, q0, q1, jb + 16, lane); peer_rows8h(g2, EU, ix, jb + 48, lane);
        peer_up_group(g3, acc, q0, q1, jb + 24, lane); peer_rows8h(g3, EU, ix, jb + 56, lane);
    }
    peer_up_group(g0, acc, q0, q1, 96, lane);  peer_up_group(g1, acc, q0, q1, 104, lane);
    peer_up_group(g2, acc, q0, q1, 112, lane); peer_up_group(g3, acc, q0, q1, 120, lane);
    const float cb = 7.5f * (hh ? qod : qev), cbp = 7.5f * (hh ? qev : qod);
    float tot[16];
#pragma unroll
    for (int i = 0; i < 16; ++i) {
        const float mine = (float)(hh ? acc[16 + i] : acc[i]) - cb;
        const float snd = (float)(hh ? acc[i] : acc[16 + i]);
        tot[i] = (mine + (xor32_get(snd, hh) - cbp)) * cstep;
    }
    float xv[16];
#pragma unroll
    for (int i = 0; i < 4; ++i) { xv[2 * i] = bf_lo(xa[i]); xv[2 * i + 1] = bf_hi(xa[i]); xv[8 + 2 * i] = bf_lo(xb[i]); xv[8 + 2 * i + 1] = bf_hi(xb[i]); }
    f32x4 x2[4]; float ss = 0.f;
#pragma unroll
    for (int i = 0; i < 4; ++i) {
        const f32x4 g = gt2[i];
#pragma unroll
        for (int e = 0; e < 4; ++e) { const float y = xv[4 * i + e] + g[e] * tot[4 * i + e]; x2[i][e] = y; ss += y * y; }
    }
    const float inv = rsqrtf(wave_sum(ss) * (1.f / D) + EPS);
#pragma unroll
    for (int i = 0; i < 4; ++i) {
        *(f32x4*)(outbuf + (size_t)t * D + col + 4 * i) = x2[i] * inv * gfin[i];
    }
}
__device__ __forceinline__ void peer_up_pass(const P& p, char* smem, int bid, int nblk, float* outbuf) {
    const int lane = threadIdx.x & 63, wid = threadIdx.x >> 6;
    stage_scales((const float*)(p.ws + WS_RSU), smem);
    const int col = 32 * (lane & 31) + 16 * (lane >> 5);
    f32x4 gfin[4], gt2[4];
#pragma unroll
    for (int i = 0; i < 4; ++i) gfin[i] = *(const f32x4*)(p.g_final + col + 4 * i);
    int bcur = -1;
    const int t0 = bid * NWAVE + wid, tstep = nblk * NWAVE;
    UpIn uin;
    if (t0 < T) up_in_load(uin, p, t0, lane);
    for (int t = t0; t < T; t += tstep) {
        const int b = t >> 13;
        if (b != bcur) {
            bcur = b;
#pragma unroll
            for (int i = 0; i < 4; ++i) gt2[i] = *(const f32x4*)((const float*)(p.ws + WS_MOD) + b * NMOD + 5120 + col + 4 * i);
        }
        peer_up_tok(p, (const float*)smem, uin, t, t + tstep, lane, outbuf, gt2, gfin);
    }
}

#define XB_TMO      128
#define XB_XCNT(j)  (256  + 64 * (j))
#define XB_XSUB(j)  (1280 + 64 * (j))
#define XB_XGEN(j)  (2304 + 64 * (j))
#define XB_TOP      3328
#define XB_TOPGEN   3392
#define XCD_BAR_WORDS 3456
#define XB_SPIN_CAP (1u << 18)
__device__ __forceinline__ unsigned xb_ld(unsigned* p)              { return __hip_atomic_load(p, __ATOMIC_RELAXED, __HIP_MEMORY_SCOPE_AGENT); }
__device__ __forceinline__ unsigned xb_add(unsigned* p, unsigned v) { return __hip_atomic_fetch_add(p, v, __ATOMIC_RELAXED, __HIP_MEMORY_SCOPE_AGENT); }
__device__ __forceinline__ unsigned xb_xcc_id() { return (unsigned)__builtin_amdgcn_s_getreg((3 << 11) | 20) & 0xFu; }
#define XB_SPIN(cond, bar) do { unsigned _sp = 0; while (cond) { __builtin_amdgcn_s_sleep(1); \
    if ((++_sp & 255u) == 0u) { if (xb_ld(&(bar)[XB_TMO])) break; if (_sp > XB_SPIN_CAP) { atomicAdd(&(bar)[XB_TMO], 1u); break; } } } } while (0)
struct XcdBarrier { unsigned* bar; unsigned x; volatile unsigned* st; };
__device__ __forceinline__ XcdBarrier xcd_barrier_post(unsigned* bar, volatile unsigned* st) {
    XcdBarrier b; b.bar = bar; b.x = xb_xcc_id(); b.st = st;
    if (threadIdx.x == 0) (void)xb_add(&bar[XB_XCNT(b.x)], 1u);
    return b;
}
__device__ __forceinline__ void xcd_barrier_complete(unsigned* bar, unsigned x, unsigned& nloc, unsigned& nx) {
    const unsigned G = gridDim.x * gridDim.y * gridDim.z;
    unsigned sum, cnt, mine, sp = 0u;
    for (;;) {
        sum = 0u; cnt = 0u; mine = 0u;
#pragma unroll
        for (unsigned j = 0; j < 16; ++j) { const unsigned c = xb_ld(&bar[XB_XCNT(j)]); sum += c; cnt += (c > 0u) ? 1u : 0u; mine = (j == x) ? c : mine; }
        if (sum == G) break;
        __builtin_amdgcn_s_sleep(1);
        if ((++sp & 255u) == 0u) { if (xb_ld(&bar[XB_TMO])) break; if (sp > XB_SPIN_CAP) { atomicAdd(&bar[XB_TMO], 1u); break; } }
    }
    nloc = mine > 0u ? mine : 1u; nx = cnt > 0u ? cnt : 1u;
}
__device__ __forceinline__ void xcd_barrier(const XcdBarrier& b) {
    asm volatile("s_waitcnt vmcnt(0)" ::: "memory");
    __syncthreads();
    if (threadIdx.x == 0) {
        unsigned* bar = b.bar;
        __builtin_amdgcn_s_waitcnt(0);
        unsigned nloc = b.st[0], nx = b.st[1];
        if (nloc == 0u) { xcd_barrier_complete(bar, b.x, nloc, nx); b.st[0] = nloc; b.st[1] = nx; }
        const unsigned old = xb_add(&bar[XB_XSUB(b.x)], 1u);
        const unsigned gen = old / nloc;
        if (old + 1u == (gen + 1u) * nloc) {
            __builtin_amdgcn_fence(__ATOMIC_RELEASE, "agent");
            asm volatile("s_waitcnt vmcnt(0)" ::: "memory");
            const unsigned og = xb_add(&bar[XB_TOP], 1u);
            const unsigned tg = og / nx;
            if (og + 1u == (tg + 1u) * nx) xb_add(&bar[XB_TOPGEN], 1u);
            else XB_SPIN(xb_ld(&bar[XB_TOPGEN]) == tg, bar);
            __builtin_amdgcn_fence(__ATOMIC_ACQUIRE, "agent");
            xb_add(&bar[XB_XGEN(b.x)], 1u);
            asm volatile("s_waitcnt vmcnt(0)" ::: "memory");
        } else {
            XB_SPIN(xb_ld(&bar[XB_XGEN(b.x)]) == gen, bar);
            __builtin_amdgcn_fence(__ATOMIC_ACQUIRE, "agent");
            asm volatile("s_waitcnt vmcnt(0)" ::: "memory");
        }
    }
    __syncthreads();
}

__global__ void __launch_bounds__(NTHR, 2) mega_kernel(P p) {
    extern __shared__ __attribute__((aligned(16))) char smem[];
    const int bid = blockIdx.x, nblk = gridDim.x;
    volatile unsigned* st = (volatile unsigned*)(smem + STAGE_LDS);
    if (threadIdx.x < 16) st[threadIdx.x] = 0u;
    __syncthreads();
    const XcdBarrier bar = xcd_barrier_post((unsigned*)(p.ws + WS_BAR), st);
    p0_mod(p, smem, bid, nblk);
    xcd_barrier(bar);
    p0_convert(p, smem, bid, nblk);
    p1_norm1(p, smem, bid, nblk);
#if PROBE_DUP == 1
    __syncthreads(); p1_norm1(p, smem, bid, nblk);
#endif
#if PROBE_DUP == 0
    __syncthreads(); p0_convert(p, smem, bid, nblk);
#endif
    xcd_barrier(bar);
    gemm_proj(p, smem);
#if PROBE_DUP == 2
    gemm_proj(p, smem);
#endif
    xcd_barrier(bar);
    attn_phase(p, smem, bid, nblk);
#if PROBE_DUP == 3
    attn_phase(p, smem, bid, nblk, 1);
#endif
#if PROBE_DUP == 33
    attn_phase<1>(p, smem, bid, nblk, 1);
#endif
    xcd_barrier(bar);
    gemm_out(p, smem);
#if PROBE_DUP == 4
    gemm_out(p, smem);
#endif
    xcd_barrier(bar);
    p5_norm2(p, bid, nblk);
#if PROBE_DUP == 5
    p5_norm2(p, bid, nblk);
#endif
    xcd_barrier(bar);
    gemm_query(p, smem);
#if PROBE_DUP == 6
    gemm_query(p, smem);
#endif
    xcd_barrier(bar);
    topk_phase(p, smem, bid, nblk);
#if PROBE_DUP == 7
    topk_phase(p, smem, bid, nblk);
#endif
    xcd_barrier(bar);
#if PROBE_DUP == 8
    peer_down_pass(p, smem, bid, nblk);
#endif
#if PROBE_DUP == 9
    peer_down_pass(p, smem, bid, nblk); xcd_barrier(bar);
    peer_up_pass(p, smem, bid, nblk, (float*)(p.ws + WS_QF));
#endif
    peer_down_pass(p, smem, bid, nblk);
    xcd_barrier(bar);
    peer_up_pass(p, smem, bid, nblk, p.out);
}

extern "C" void kernel_launch(void* const* d_in, const int* in_sizes, int n_in, void* d_out, int out_size, void* d_ws, size_t ws_size, hipStream_t stream) {
    if (n_in != 16 || out_size != T * D || ws_size < WS_END) { fprintf(stderr, "kernel_launch: unexpected shapes (n_in %d out %d ws %zu)\n", n_in, out_size, ws_size); return; }
    P p{};
    p.x = (const float*)d_in[0]; p.c = (const float*)d_in[1]; p.w_ada = (const float*)d_in[2]; p.b_ada = (const float*)d_in[3];
    p.g_mix = (const float*)d_in[4]; p.w_in = (const float*)d_in[5]; p.b_forget = (const float*)d_in[6]; p.g_fox = (const float*)d_in[7];
    p.g_sb = (const float*)d_in[8]; p.w_out = (const float*)d_in[9]; p.g_ffn = (const float*)d_in[10]; p.w_query = (const float*)d_in[11];
    p.sub_keys = (const float*)d_in[12]; p.e_down = (const float*)d_in[13]; p.e_up = (const float*)d_in[14]; p.g_final = (const float*)d_in[15];
    p.out = (float*)d_out; p.ws = (unsigned char*)d_ws;
    (void)hipMemsetAsync((char*)d_ws + WS_KMAX, 0, 24 * 1024, stream);
    static int grid_blocks = 0;
    if (!grid_blocks) {
        int dev = 0, cus = 0, per_cu = 0;
        (void)hipGetDevice(&dev);
        (void)hipDeviceGetAttribute(&cus, hipDeviceAttributeMultiprocessorCount, dev);
        (void)hipFuncSetAttribute((const void*)mega_kernel, hipFuncAttributeMaxDynamicSharedMemorySize, LDS_BYTES);
        (void)hipOccupancyMaxActiveBlocksPerMultiprocessor(&per_cu, mega_kernel, NTHR, LDS_BYTES);
        if (per_cu > 1) per_cu = 1;
        grid_blocks = cus * per_cu;
        if (grid_blocks % 8) grid_blocks -= grid_blocks % 8;
    }
    void* args[] = {&p};
    hipError_t e = hipLaunchCooperativeKernel((void*)mega_kernel, dim3(grid_blocks), dim3(NTHR), args, LDS_BYTES, stream);
    if (e != hipSuccess) fprintf(stderr, "cooperative launch failed: %s (grid %d)\n", hipGetErrorString(e), grid_blocks);
}
```

```cpp
#include <hip/hip_runtime.h>
#include <hip/hip_cooperative_groups.h>
#include <cstdio>
#include <cstdint>
namespace cg = cooperative_groups;

#ifndef PROBE_DUP
#define PROBE_DUP -1
#endif

namespace pg8 {
#define PG8_LAS __attribute__((address_space(3)))
typedef unsigned short bf16_t;
typedef short bf16x8 __attribute__((ext_vector_type(8)));
typedef float f32x4 __attribute__((ext_vector_type(4)));
typedef unsigned u32x4 __attribute__((ext_vector_type(4)));
constexpr int BM = 256, BK = 64, HALF = 128, HTB = HALF * BK * 2  , STAGE_BYTES = 8 * HTB, NXCD = 8, WGM = 8;

__host__ __device__ __forceinline__ int lds_byte(int r, int c) { const int st = (r >> 4) * 2 + (c >> 5), rr = r & 15, cc = c & 31, ob = rr * 64 + cc * 2; return st * 1024 + (ob ^ (((ob >> 9) & 1) << 5)); }
__host__ __device__ __forceinline__ void stage_rc(int b, int& R, int& C) { const int st = b / 1024, sb = b % 1024, swz = sb ^ (((sb >> 9) & 1) << 5); R = (st >> 1) * 16 + swz / 64; C = (st & 1) * 32 + (swz % 64) / 2; }
__host__ __device__ __forceinline__ int perm32(int rho) { const int n = rho >> 4, i = rho & 15; return 8 * (i >> 2) + 4 * n + (i & 3); }

struct Unit { int pm, pn; };
struct Gemm { const bf16_t* A; const bf16_t* Bt; int M, N, K; };

struct StaticOrder {
    int nM, nN, nwg, G, c;
    __host__ __device__ void init(int M, int N, int G_, int c_) { nM = M / BM; nN = N / BM; nwg = nM * nN; G = G_; c = c_; }
    __host__ __device__ bool next(int i, Unit& u) const {
        const long L = (long)i * G + c; if (L >= nwg) return false;
        int wgid = (int)L; { const int q = nwg / NXCD, r = nwg % NXCD, xcd = wgid % NXCD, off = wgid / NXCD; wgid = (xcd < r ? xcd * (q + 1) : r * (q + 1) + (xcd - r) * q) + off; }
        const int nig = WGM * nN, gid = wgid / nig, fm = gid * WGM, gsz = (nM - fm) < WGM ? (nM - fm) : WGM;
        u.pm = fm + ((wgid % nig) % gsz); u.pn = (wgid % nig) / gsz; return true;
    }
    __device__ __forceinline__ void a_ready(const Unit&) const {}
    __device__ __forceinline__ void done(const Unit&) const {}
};
template <class Epi, class Sched, bool ALIGN_EPI = false, bool SP2 = false>
__device__ __forceinline__ void gemm_phase(PG8_LAS unsigned char* lds, const Gemm g, const Sched& S, const Epi& E) {
    int tid = threadIdx.x; asm volatile("" : "+v"(tid));
    const int wid = __builtin_amdgcn_readfirstlane(tid >> 6), lane = tid & 63, wr = wid >> 2, wc = wid & 3, fr = lane & 15, fq = lane >> 4;
    const int K = g.K, nt = K / BK;
    unsigned voffA[2], voffB[2];
#pragma unroll
    for (int i = 0; i < 2; ++i) { int R, C; stage_rc(tid * 16 + i * 8192, R, C); const int Rb = Epi::PERM ? ((R & ~31) + perm32(R & 31)) : R;
        voffA[i] = (unsigned)(R * K + C) * 2u; voffB[i] = (unsigned)(Rb * K + C) * 2u; }
    const size_t kstep = (size_t)(BK * 2);
    const size_t hstep = (size_t)HALF * K * 2;
    const size_t tstep = 2 * hstep;
    const unsigned ldsw = (unsigned)wid * 1024u;
    const int aoff = lds_byte(wr * 64 + fr, fq * 8), boff = lds_byte(wc * 32 + fr, fq * 8);
#define PG8_SA(b, h) (((b) * 2 + (h)) * HTB)
#define PG8_SB(b, h) ((4 + (b) * 2 + (h)) * HTB)
#define PG8_STAGE(bufoff, gbase, voff) do { _Pragma("unroll") for (int _i = 0; _i < 2; ++_i) \
        __builtin_amdgcn_global_load_lds((const unsigned*)((const char*)(gbase) + (voff)[_i]), (PG8_LAS unsigned*)(lds + (bufoff) + ldsw + _i * 8192), 16, 0, 0); } while (0)
#define PG8_LDA(dst, b, h) do { _Pragma("unroll") for (int m = 0; m < 4; ++m) _Pragma("unroll") for (int k = 0; k < 2; ++k) dst[m][k] = *(const PG8_LAS bf16x8*)(lds + PG8_SA(b, h) + aoff + m * 2048 + k * 1024); } while (0)
#define PG8_LDB(dst, b, h) do { _Pragma("unroll") for (int n = 0; n < 2; ++n) _Pragma("unroll") for (int k = 0; k < 2; ++k) dst[n][k] = *(const PG8_LAS bf16x8*)(lds + PG8_SB(b, h) + boff + n * 2048 + k * 1024); } while (0)
#define PG8_MMA(ai, bj, At, Bt) do { __builtin_amdgcn_s_setprio(1); _Pragma("unroll") for (int m = 0; m < 4; ++m) _Pragma("unroll") for (int n = 0; n < 2; ++n) _Pragma("unroll") for (int k = 0; k < 2; ++k) \
        acc[ai][bj][m][n] = __builtin_amdgcn_mfma_f32_16x16x32_bf16(Bt[n][k], At[m][k], acc[ai][bj][m][n], 0, 0, 0); __builtin_amdgcn_s_setprio(0); } while (0)
#define PG8_WAIT_V(n) asm volatile("s_waitcnt vmcnt(" #n ")" ::: "memory")
#define PG8_WAIT_L(n) asm volatile("s_waitcnt lgkmcnt(" #n ")" ::: "memory")
#define PG8_BAR __builtin_amdgcn_s_barrier()
#define PG8_SCHED __builtin_amdgcn_sched_barrier(0)
    Unit cur, nxt; int ui = 0;
    if (!S.next(0, cur)) return;
    f32x4 acc[2][2][4][2];
#pragma unroll
    for (int a = 0; a < 2; ++a)
#pragma unroll
        for (int b = 0; b < 2; ++b)
#pragma unroll
            for (int m = 0; m < 4; ++m)
#pragma unroll
                for (int n = 0; n < 2; ++n) acc[a][b][m][n] = (f32x4){0.f, 0.f, 0.f, 0.f};
    bf16x8 At[4][2], B0[2][2], B1[2][2];
    const char* cA = (const char*)g.A + (size_t)cur.pm * tstep; const char* cB = (const char*)g.Bt + (size_t)cur.pn * tstep;
    S.a_ready(cur);
    if constexpr (SP2) {
        PG8_STAGE(PG8_SB(0, 0), cB, voffB); PG8_STAGE(PG8_SB(0, 1), cB + hstep, voffB); PG8_STAGE(PG8_SA(0, 0), cA, voffA); PG8_STAGE(PG8_SA(0, 1), cA + hstep, voffA);
        if (wr == 1) PG8_BAR;
        PG8_WAIT_V(2); PG8_BAR;
        PG8_STAGE(PG8_SB(1, 0), cB + kstep, voffB); PG8_STAGE(PG8_SA(1, 0), cA + kstep, voffA); PG8_STAGE(PG8_SB(1, 1), cB + hstep + kstep, voffB);
        PG8_WAIT_V(6); PG8_BAR;
    } else {
        PG8_STAGE(PG8_SB(0, 0), cB, voffB); PG8_STAGE(PG8_SA(0, 0), cA, voffA); PG8_STAGE(PG8_SB(0, 1), cB + hstep, voffB); PG8_STAGE(PG8_SA(0, 1), cA + hstep, voffA);
        if (wr == 1) PG8_BAR;
        PG8_WAIT_V(4); PG8_BAR;
        PG8_STAGE(PG8_SB(1, 0), cB + kstep, voffB); PG8_STAGE(PG8_SA(1, 0), cA + kstep, voffA); PG8_STAGE(PG8_SB(1, 1), cB + hstep + kstep, voffB);
        PG8_WAIT_V(6); PG8_BAR;
    }
    for (;;) {
        const bool has_next = S.next(ui + 1, nxt);
        const char* nA = has_next ? (const char*)g.A + (size_t)nxt.pm * tstep : cA; const char* nB = has_next ? (const char*)g.Bt + (size_t)nxt.pn * tstep : cB;
        for (int t = 0; t < nt; t += 2) {
            const bool last = (t == nt - 2);
            const char* a1 = cA + (size_t)(t + 1) * kstep;
            const char* a2 = last ? nA : cA + (size_t)(t + 2) * kstep; const char* b2 = last ? nB : cB + (size_t)(t + 2) * kstep;
            const char* a3 = a2 + kstep; const char* b3 = b2 + kstep;
            if (last && has_next) S.a_ready(nxt);
            if constexpr (SP2) {
            PG8_LDB(B0, 0, 0); PG8_LDB(B1, 0, 1); PG8_SCHED; PG8_LDA(At, 0, 0); PG8_STAGE(PG8_SA(1, 1), a1 + hstep, voffA);
            PG8_WAIT_V(8); PG8_WAIT_L(0); PG8_BAR; PG8_MMA(0, 0, At, B0); PG8_MMA(0, 1, At, B1); PG8_BAR; PG8_SCHED;
            PG8_LDA(At, 0, 1); PG8_STAGE(PG8_SB(0, 0), b2, voffB); PG8_STAGE(PG8_SB(0, 1), b2 + hstep, voffB); PG8_STAGE(PG8_SA(0, 0), a2, voffA);
            PG8_WAIT_V(8); PG8_WAIT_L(0); PG8_BAR; PG8_MMA(1, 0, At, B0); PG8_MMA(1, 1, At, B1); PG8_BAR; PG8_SCHED;
            PG8_LDB(B0, 1, 0); PG8_LDB(B1, 1, 1); PG8_SCHED; PG8_LDA(At, 1, 0); PG8_STAGE(PG8_SA(0, 1), a2 + hstep, voffA);
            PG8_WAIT_V(8); PG8_WAIT_L(0); PG8_BAR; PG8_MMA(0, 0, At, B0); PG8_MMA(0, 1, At, B1); PG8_BAR; PG8_SCHED;
            PG8_LDA(At, 1, 1); PG8_STAGE(PG8_SB(1, 0), b3, voffB); PG8_STAGE(PG8_SB(1, 1), b3 + hstep, voffB); PG8_STAGE(PG8_SA(1, 0), a3, voffA);
            PG8_WAIT_V(8); PG8_WAIT_L(0); PG8_BAR; PG8_MMA(1, 0, At, B0); PG8_MMA(1, 1, At, B1); PG8_BAR; PG8_SCHED;
            } else {
            PG8_LDB(B0, 0, 0); PG8_SCHED; PG8_LDA(At, 0, 0); PG8_STAGE(PG8_SA(1, 1), a1 + hstep, voffA);
            PG8_WAIT_L(8); PG8_BAR; PG8_WAIT_L(0); PG8_MMA(0, 0, At, B0); PG8_BAR; PG8_SCHED;
            PG8_LDB(B1, 0, 1); PG8_STAGE(PG8_SB(0, 0), b2, voffB);
            PG8_BAR; PG8_WAIT_L(0); PG8_MMA(0, 1, At, B1); PG8_BAR;
            PG8_LDA(At, 0, 1); PG8_STAGE(PG8_SA(0, 0), a2, voffA);
            PG8_BAR; PG8_WAIT_L(0); PG8_MMA(1, 0, At, B0); PG8_BAR; PG8_SCHED;
            PG8_STAGE(PG8_SB(0, 1), b2 + hstep, voffB);
            PG8_WAIT_V(6); PG8_BAR; PG8_MMA(1, 1, At, B1); PG8_BAR;
            PG8_LDB(B0, 1, 0); PG8_SCHED; PG8_LDA(At, 1, 0); PG8_STAGE(PG8_SA(0, 1), a2 + hstep, voffA);
            PG8_WAIT_L(8); PG8_BAR; PG8_WAIT_L(0); PG8_MMA(0, 0, At, B0); PG8_BAR; PG8_SCHED;
            PG8_LDB(B1, 1, 1); PG8_STAGE(PG8_SB(1, 0), b3, voffB);
            PG8_BAR; PG8_WAIT_L(0); PG8_MMA(0, 1, At, B1); PG8_BAR;
            PG8_LDA(At, 1, 1); PG8_STAGE(PG8_SA(1, 0), a3, voffA);
            PG8_BAR; PG8_WAIT_L(0); PG8_MMA(1, 0, At, B0); PG8_BAR; PG8_SCHED;
            PG8_STAGE(PG8_SB(1, 1), b3 + hstep, voffB);
            PG8_WAIT_V(6); PG8_BAR; PG8_MMA(1, 1, At, B1); PG8_BAR;
            }
        }
        if constexpr (ALIGN_EPI) { if (wr == 0) PG8_BAR; }
        if constexpr (!Epi::AFTER_DRAIN) { E(acc, cur, wr, wc, fr, fq); S.done(cur); }
        if (!has_next) break;
#pragma unroll
        for (int a = 0; a < 2; ++a)
#pragma unroll
            for (int b = 0; b < 2; ++b)
#pragma unroll
                for (int m = 0; m < 4; ++m)
#pragma unroll
                    for (int n = 0; n < 2; ++n) acc[a][b][m][n] = (f32x4){0.f, 0.f, 0.f, 0.f};
        cur = nxt; cA = nA; cB = nB; ++ui;
        if constexpr (ALIGN_EPI) { if (wr == 1) PG8_BAR; }
    }
    PG8_WAIT_V(0);
    if constexpr (!ALIGN_EPI) { if (wr == 0) PG8_BAR; }
    PG8_BAR;
    if constexpr (Epi::AFTER_DRAIN) { E.fused(acc, cur, wr, wc, fr, fq, lds, wid, lane); S.done(cur); }
#undef PG8_SA
#undef PG8_SB
#undef PG8_STAGE
#undef PG8_LDA
#undef PG8_LDB
#undef PG8_MMA
#undef PG8_WAIT_V
#undef PG8_WAIT_L
#undef PG8_BAR
#undef PG8_SCHED
}
}
typedef unsigned short bf16_t;
typedef short bf16x8 __attribute__((ext_vector_type(8)));
typedef float f32x16 __attribute__((ext_vector_type(16)));
typedef float f32x4 __attribute__((ext_vector_type(4)));
typedef unsigned u32x4 __attribute__((ext_vector_type(4)));
typedef unsigned u32x2 __attribute__((ext_vector_type(2)));

constexpr int D = 1024, NBATCH = 4, SEQ = 8192, T = NBATCH * SEQ;
constexpr int NH = 8, HD = 64, INC = 3080, NMOD = 6144;
constexpr float EPS = 1e-6f, ATT_SCALE = 0.125f, THRESH = 105.0f, LOG2E = 1.4426950408889634f;
constexpr float SC2 = ATT_SCALE * LOG2E, THRESH2 = THRESH * LOG2E;

constexpr size_t MiB = 1u << 20;
constexpr size_t WS_MOD = 0, WS_KMAX = 128 * 1024, WS_BAR = 136 * 1024, WS_CTOT = 192 * 1024, WS_FLOC = 1 * MiB;
constexpr size_t WS_WQK = 2 * MiB, WS_WV = 6 * MiB, WS_WOUT = 8 * MiB, WS_WQ = 10 * MiB, WS_SK = 14 * MiB, WS_ED = 16 * MiB, WS_EU = 48 * MiB;
constexpr size_t WS_RSD = 15 * MiB, WS_RSU = 15 * MiB + 64 * 1024;
constexpr size_t WS_H = 80 * MiB, WS_QF = 144 * MiB;
constexpr size_t WS_MIX = 336 * MiB, WS_EXP = 400 * MiB, WS_GATE = 416 * MiB, WS_END = 432 * MiB;
constexpr size_t WS_X1 = 272 * MiB;
constexpr size_t WS_ACT = 144 * MiB;
constexpr size_t WS_QUERY = 144 * MiB;

struct P {
    const float *x, *c, *w_ada, *b_ada, *g_mix, *w_in, *b_forget, *g_fox, *g_sb, *w_out, *g_ffn, *w_query, *sub_keys, *e_down, *e_up, *g_final;
    float* out;
    unsigned char* ws;
};

constexpr int NWAVE = 8, NTHR = NWAVE * 64;
constexpr int STAGE_LDS = 131072;
constexpr int LDS_BYTES = 147456;

typedef __bf16 bf16v2 __attribute__((ext_vector_type(2)));
__device__ __forceinline__ unsigned cvt_pk_bf16(float lo, float hi) { bf16v2 v; v.x = (__bf16)lo; v.y = (__bf16)hi; return __builtin_bit_cast(unsigned, v); }
__device__ __forceinline__ float bf_lo(unsigned w) { return __uint_as_float(w << 16); }
__device__ __forceinline__ float bf_hi(unsigned w) { return __uint_as_float(w & 0xffff0000u); }
__device__ __forceinline__ float bf2f(bf16_t h) { return __uint_as_float(((unsigned)h) << 16); }
__device__ __forceinline__ int tidx() { int t = threadIdx.x; asm volatile("" : "+v"(t)); return t; }
__device__ __forceinline__ float wave_sum(float v) {
#pragma unroll
    for (int o = 1; o < 64; o <<= 1) v += __shfl_xor(v, o);
    return v;
}
__device__ __forceinline__ float wave_max(float v) {
#pragma unroll
    for (int o = 1; o < 64; o <<= 1) v = fmaxf(v, __shfl_xor(v, o));
    return v;
}
__device__ __forceinline__ float xor32_sum(float v) { auto rr = __builtin_amdgcn_permlane32_swap(__float_as_uint(v), __float_as_uint(v), false, false); return __uint_as_float(rr[0]) + __uint_as_float(rr[1]); }
__device__ __forceinline__ float xor32_max(float v) { auto rr = __builtin_amdgcn_permlane32_swap(__float_as_uint(v), __float_as_uint(v), false, false); return fmaxf(__uint_as_float(rr[0]), __uint_as_float(rr[1])); }
__device__ __forceinline__ float xor32_get(float v, int hh) { auto rr = __builtin_amdgcn_permlane32_swap(__float_as_uint(v), __float_as_uint(v), false, false); return __uint_as_float(hh ? rr[0] : rr[1]); }
__device__ __forceinline__ float log_sigmoid(float x) { return fminf(x, 0.f) - log1pf(__expf(-fabsf(x))); }
__device__ __forceinline__ void p0_transpose_item(const float* W, int K, int N, int n0src, bf16_t* WT, int row0, int k0, float* scr, int lane) {
#pragma unroll 8
    for (int i = 0; i < 32; ++i) { const int kk = 2 * i + (lane >> 5); scr[kk * 33 + (lane & 31)] = W[(size_t)(k0 + kk) * N + n0src + (lane & 31)]; }
    asm volatile("s_waitcnt lgkmcnt(0)" ::: "memory");
    asm volatile("" ::: "memory");
    const int c = lane & 7;
#pragma unroll
    for (int j = 0; j < 4; ++j) {
        const int n = (lane >> 3) + 8 * j; const float* s = scr + (8 * c) * 33 + n;
        u32x4 o; o.x = cvt_pk_bf16(s[0 * 33], s[1 * 33]); o.y = cvt_pk_bf16(s[2 * 33], s[3 * 33]); o.z = cvt_pk_bf16(s[4 * 33], s[5 * 33]); o.w = cvt_pk_bf16(s[6 * 33], s[7 * 33]);
        *(u32x4*)(WT + (size_t)(row0 + n) * K + k0 + 8 * c) = o;
    }
    asm volatile("s_waitcnt lgkmcnt(0)" ::: "memory");
    asm volatile("" ::: "memory");
}

__device__ __forceinline__ void cvt_stream(const float* src, bf16_t* dst, size_t n8, size_t gtid, size_t gthreads) {
    for (size_t i = gtid; i < n8; i += gthreads) {
        const f32x4 a = *(const f32x4*)(src + i * 8), b = *(const f32x4*)(src + i * 8 + 4);
        u32x4 o; o.x = cvt_pk_bf16(a.x, a.y); o.y = cvt_pk_bf16(a.z, a.w); o.z = cvt_pk_bf16(b.x, b.y); o.w = cvt_pk_bf16(b.z, b.w);
        *(u32x4*)(dst + i * 8) = o;
    }
}

typedef float f32x2 __attribute__((ext_vector_type(2)));
__device__ __forceinline__ void cvt_row_fp8(const float* src, unsigned char* dst, float* rscale, int row, int lane) {
    const f32x4* s = (const f32x4*)(src + (size_t)row * 1024 + lane * 16);
    f32x4 v[4]; float mx = 0.f;
#pragma unroll
    for (int i = 0; i < 4; ++i) { v[i] = s[i]; mx = fmaxf(mx, fmaxf(fmaxf(fabsf(v[i].x), fabsf(v[i].y)), fmaxf(fabsf(v[i].z), fabsf(v[i].w)))); }
    mx = wave_max(mx);
    const float sc = mx > 0.f ? 224.f / mx : 1.f;
    u32x4 o;
#pragma unroll
    for (int i = 0; i < 4; ++i) {
        int w = 0;
        w = __builtin_amdgcn_cvt_pk_fp8_f32(v[i].x * sc, v[i].y * sc, w, false);
        w = __builtin_amdgcn_cvt_pk_fp8_f32(v[i].z * sc, v[i].w * sc, w, true);
        o[i] = (unsigned)w;
    }
    *(u32x4*)(dst + (size_t)row * 1024 + lane * 16) = o;
    if (lane == 0) rscale[row] = mx > 0.f ? mx * (1.f / 224.f) : 1.f;
}

__device__ __forceinline__ unsigned pack_i8x4(float a, float b, float c, float d) {
    const int ia = (int)__builtin_rintf(a), ib = (int)__builtin_rintf(b), ic = (int)__builtin_rintf(c), id = (int)__builtin_rintf(d);
    return (unsigned)(ia & 0xff) | ((unsigned)(ib & 0xff) << 8) | ((unsigned)(ic & 0xff) << 16) | ((unsigned)id << 24);
}
__device__ __forceinline__ void cvt_row_i8(const float* src, unsigned char* dst, float* rscale, int row, int lane) {
    const f32x4* s = (const f32x4*)(src + (size_t)row * 1024 + lane * 16);
    f32x4 v[4]; float mx = 0.f;
#pragma unroll
    for (int i = 0; i < 4; ++i) { v[i] = s[i]; mx = fmaxf(mx, fmaxf(fmaxf(fabsf(v[i].x), fabsf(v[i].y)), fmaxf(fabsf(v[i].z), fabsf(v[i].w)))); }
    mx = wave_max(mx);
    const float sc = mx > 0.f ? 127.f / mx : 1.f;
    u32x4 o;
#pragma unroll
    for (int i = 0; i < 4; ++i) o[i] = pack_i8x4(v[i].x * sc, v[i].y * sc, v[i].z * sc, v[i].w * sc);
    *(u32x4*)(dst + (size_t)row * 1024 + lane * 16) = o;
    if (lane == 0) rscale[row] = mx > 0.f ? mx * (1.f / 127.f) : 1.f;
}
struct RowF32 { f32x4 v[4]; };
__device__ __forceinline__ void row_load(RowF32& r, const float* src, int row, int lane) {
    const f32x4* s = (const f32x4*)(src + (size_t)row * 1024 + lane * 16);
#pragma unroll
    for (int i = 0; i < 4; ++i) r.v[i] = s[i];
}
__device__ __forceinline__ void cvt_row_q4(const RowF32& r, unsigned char* dst, float* rscale, int row, int lane) {
    const f32x4 (&v)[4] = r.v; float ss = 0.f;
#pragma unroll
    for (int i = 0; i < 4; ++i) ss += (v[i].x * v[i].x + v[i].y * v[i].y) + (v[i].z * v[i].z + v[i].w * v[i].w);
    ss = wave_sum(ss);
    const float step = ss > 0.f ? 0.3352f * sqrtf(ss * (1.f / 1024.f)) : 1e-30f, inv = 1.f / step;
    unsigned w[2] = {0u, 0u};
#pragma unroll
    for (int i = 0; i < 16; ++i) {
        int n = (int)floorf(v[i >> 2][i & 3] * inv) + 8;
        n = n < 0 ? 0 : (n > 15 ? 15 : n);
        w[i >> 3] |= (unsigned)n << (4 * (i & 7));
    }
    u32x2 o; o.x = w[0]; o.y = w[1];
    *(u32x2*)(dst + (size_t)row * 512 + lane * 8) = o;
    if (lane == 0) rscale[row] = step;
}
__device__ __forceinline__ void p0_mod(const P& p, char* smem, int bid, int nblk) {
    const int tid = tidx(), lane = tid & 63, wid = tid >> 6;
    const int gw = bid * NWAVE + wid, NGW = nblk * NWAVE;
    float* sc = (float*)smem;
    for (int i = tid; i < 4096; i += NTHR) { const float v = p.c[i]; sc[i] = v / (1.f + __expf(-v)); }
    __syncthreads();
    float* mod = (float*)(p.ws + WS_MOD);
    for (int it = gw; it < 1536; it += NGW) {
        const int col = it * 4 + (lane & 3), ks = lane >> 2;
        float a0 = 0.f, a1 = 0.f, a2 = 0.f, a3 = 0.f;
        const float* w = p.w_ada + (size_t)(ks * 64) * NMOD + col;
#pragma unroll 16
        for (int k = 0; k < 64; ++k) {
            const float wv = w[(size_t)k * NMOD]; const int kk = ks * 64 + k;
            a0 += sc[kk] * wv; a1 += sc[1024 + kk] * wv; a2 += sc[2048 + kk] * wv; a3 += sc[3072 + kk] * wv;
        }
#pragma unroll
        for (int o = 4; o < 64; o <<= 1) { a0 += __shfl_xor(a0, o); a1 += __shfl_xor(a1, o); a2 += __shfl_xor(a2, o); a3 += __shfl_xor(a3, o); }
        if (ks == 0) { const float bb = p.b_ada[col]; mod[col] = a0 + bb; mod[NMOD + col] = a1 + bb; mod[2 * NMOD + col] = a2 + bb; mod[3 * NMOD + col] = a3 + bb; }
    }
}
__device__ __forceinline__ void p0_convert(const P& p, char* smem, int bid, int nblk) {
    const int tid = tidx(), lane = tid & 63, wid = tid >> 6;
    const int gw = bid * NWAVE + wid, NGW = nblk * NWAVE;
    float* scr = (float*)(smem + 40960 + wid * 8448);
    for (int it = gw; it < 3072; it += NGW) {
        if (it < 1536) {
            const int kb = it / 96, nb = it % 96, seg = nb >> 4, nn = (nb & 15) * 32;
            const int srccol = seg * 512 + nn + (seg >= 3 ? 8 : 0);
            bf16_t* dstw = (bf16_t*)(p.ws + ((seg == 2 || seg == 5) ? WS_WV : WS_WQK));
            const int drow = (seg == 2 ? 0 : seg == 5 ? 512 : seg == 0 ? 0 : seg == 1 ? 512 : seg == 3 ? 1024 : 1536) + nn;
            p0_transpose_item(p.w_in, D, INC, srccol, dstw, drow, kb * 64, scr, lane);
        }
        else if (it < 2048) { const int r = it - 1536, kb = r / 32, nb = r % 32; p0_transpose_item(p.w_out, D, D, nb * 32, (bf16_t*)(p.ws + WS_WOUT), nb * 32, kb * 64, scr, lane); }
        else { const int r = it - 2048, kb = r / 64, nb = r % 64; p0_transpose_item(p.w_query, D, 2048, nb * 32, (bf16_t*)(p.ws + WS_WQ), nb * 32, kb * 64, scr, lane); }
    }
    const size_t gtid = (size_t)bid * NTHR + tid, gth = (size_t)nblk * NTHR;
    cvt_stream(p.sub_keys, (bf16_t*)(p.ws + WS_SK), (size_t)8 * 2 * 128 * 128 / 8, gtid, gth);
}

__device__ __forceinline__ void p1_norm1(const P& p, char* smem, int bid, int nblk) {
    const int tid = tidx(), lane = tid & 63, wid = tid >> 6;
    float* wfs = (float*)smem;
    float* lf = (float*)(smem + 32768);
    const float* mod = (const float*)(p.ws + WS_MOD);
    bf16_t* hbuf = (bf16_t*)(p.ws + WS_H);
    float* Floc = (float*)(p.ws + WS_FLOC);
    float* ctot = (float*)(p.ws + WS_CTOT);
    for (int i = tid; i < 2048; i += NTHR) {
        const int d = i >> 1, hf = i & 1;
        const f32x4 w = *(const f32x4*)(p.w_in + (size_t)d * INC + 1536 + 4 * hf);
        wfs[(4 * hf + 0) * 1024 + d] = w.x; wfs[(4 * hf + 1) * 1024 + d] = w.y; wfs[(4 * hf + 2) * 1024 + d] = w.z; wfs[(4 * hf + 3) * 1024 + d] = w.w;
    }
    __syncthreads();
    for (int ch = bid; ch < T / 64; ch += nblk) {
        const int t0 = ch * 64, b = t0 >> 13;
        f32x4 Am[4], Bm[4];
#pragma unroll
        for (int j = 0; j < 4; ++j) {
            const f32x4 g = ((const f32x4*)p.g_mix)[lane + 64 * j];
            const f32x4 s = ((const f32x4*)(mod + b * NMOD + 1024))[lane + 64 * j];
            Am[j] = g * (s + 1.0f);
            Bm[j] = ((const f32x4*)(mod + b * NMOD))[lane + 64 * j];
        }
        const int up32 = lane & 32, up16 = lane & 16, up8 = lane & 8;
        const int kL = ((lane >> 5) & 1) * 4 + ((lane >> 4) & 1) * 2 + ((lane >> 3) & 1);
        const float bfk = p.b_forget[kL];
        f32x4 vn[4];
        {
            const f32x4* xr = (const f32x4*)(p.x + (size_t)(t0 + wid * (64 / NWAVE)) * D) + lane;
#pragma unroll
            for (int j = 0; j < 4; ++j) vn[j] = xr[64 * j];
        }
        for (int i = 0; i < 64 / NWAVE; ++i) {
            const int t = t0 + wid * (64 / NWAVE) + i;
            f32x4 v[4]; float ss = 0.f;
#pragma unroll
            for (int j = 0; j < 4; ++j) { v[j] = vn[j]; ss += v[j].x * v[j].x + v[j].y * v[j].y + v[j].z * v[j].z + v[j].w * v[j].w; }
            if (i + 1 < 64 / NWAVE) {
                const f32x4* xr = (const f32x4*)(p.x + (size_t)(t + 1) * D) + lane;
#pragma unroll
                for (int j = 0; j < 4; ++j) vn[j] = xr[64 * j];
            }
            const float inv = rsqrtf(wave_sum(ss) * (1.f / D) + EPS);
            u32x2* o8 = (u32x2*)(hbuf + (size_t)t * D) + lane;
            float fa[8];
#pragma unroll
            for (int c = 0; c < 8; ++c) fa[c] = 0.f;
#pragma unroll
            for (int j = 0; j < 4; ++j) {
                const f32x4 h = (v[j] * inv) * Am[j] + Bm[j];
                u32x2 w; w.x = cvt_pk_bf16(h.x, h.y); w.y = cvt_pk_bf16(h.z, h.w); o8[64 * j] = w;
#pragma unroll
                for (int c = 0; c < 8; ++c) { const f32x4 wv = ((const f32x4*)(wfs + c * 1024))[lane + 64 * j]; fa[c] += (wv.x * h.x + wv.y * h.y) + (wv.z * h.z + wv.w * h.w); }
            }
            float k4[4], k2[2];
#pragma unroll
            for (int q = 0; q < 4; ++q) { const float snd = up32 ? fa[q] : fa[q + 4]; k4[q] = (up32 ? fa[q + 4] : fa[q]) + __shfl_xor(snd, 32); }
#pragma unroll
            for (int q = 0; q < 2; ++q) { const float snd = up16 ? k4[q] : k4[q + 2]; k2[q] = (up16 ? k4[q + 2] : k4[q]) + __shfl_xor(snd, 16); }
            const float snd = up8 ? k2[0] : k2[1];
            float f = (up8 ? k2[1] : k2[0]) + __shfl_xor(snd, 8);
            f += __shfl_xor(f, 4); f += __shfl_xor(f, 2); f += __shfl_xor(f, 1);
            if ((lane & 7) == 0) lf[(wid * (64 / NWAVE) + i) * 8 + kL] = log_sigmoid(f + bfk) * LOG2E;
        }
        __syncthreads();
        if (tid < 8) {
            float run = 0.f; float* dst = Floc + (size_t)(b * 8 + tid) * SEQ + (t0 & (SEQ - 1));
            for (int i = 0; i < 64; ++i) { run += lf[i * 8 + tid]; dst[i] = run; }
            ctot[(b * 8 + tid) * 128 + ((t0 & (SEQ - 1)) >> 6)] = run;
        }
        __syncthreads();
    }
}

struct EpiQK {
    static constexpr bool PERM = true, AFTER_DRAIN = false;
    unsigned char* ws;
    __device__ __forceinline__ void operator()(const pg8::f32x4 (&acc)[2][2][4][2], const pg8::Unit& u, int wr, int wc, int fr, int fq) const {
        const int b = (u.pm * 256) >> 13;
#pragma unroll
        for (int bj = 0; bj < 2; ++bj) {
            const int c0 = u.pn * 256 + bj * 128 + wc * 32 + 8 * fq, seg4 = c0 >> 9, hd = (c0 & 511) >> 6, d = c0 & 63;
            bf16_t* dst = (bf16_t*)(ws + WS_QF + (size_t)(seg4 < 2 ? seg4 : seg4 + 1) * 32 * MiB) + (size_t)(b * 8 + hd) * SEQ * 64 + d;
            float mx = 0.f;
#pragma unroll
            for (int ai = 0; ai < 2; ++ai)
#pragma unroll
                for (int m = 0; m < 4; ++m) {
                    const int s = (u.pm * 256 + ai * 128 + wr * 64 + m * 16 + fr) & (SEQ - 1);
                    const pg8::f32x4 v0 = acc[ai][bj][m][0], v1 = acc[ai][bj][m][1];
                    u32x4 w; w.x = cvt_pk_bf16(v0[0], v0[1]); w.y = cvt_pk_bf16(v0[2], v0[3]); w.z = cvt_pk_bf16(v1[0], v1[1]); w.w = cvt_pk_bf16(v1[2], v1[3]);
                    *(u32x4*)(dst + (size_t)s * 64) = w;
                    if (seg4 == 1) {
                        float q = (v0[0] * v0[0] + v0[1] * v0[1]) + (v0[2] * v0[2] + v0[3] * v0[3]) + (v1[0] * v1[0] + v1[1] * v1[1]) + (v1[2] * v1[2] + v1[3] * v1[3]);
                        q += __shfl_xor(q, 16); q += __shfl_xor(q, 32);
                        mx = fmaxf(mx, q);
                    }
                }
            if (seg4 == 1) {
                mx = wave_max(mx);
                if ((threadIdx.x & 63) == 0) atomicMax((unsigned*)(ws + WS_KMAX) + (b * 8 + hd) * 2 + (wc & 1), __float_as_uint(mx));
            }
        }
    }
};
struct EpiV {
    static constexpr bool PERM = true, AFTER_DRAIN = false;
    unsigned char* ws;
    __device__ __forceinline__ void operator()(const pg8::f32x4 (&acc)[2][2][4][2], const pg8::Unit& u, int wr, int wc, int fr, int fq) const {
#pragma unroll
        for (int bj = 0; bj < 2; ++bj) {
            const int t0 = u.pn * 256 + bj * 128 + wc * 32 + 8 * fq, b = t0 >> 13, s = t0 & (SEQ - 1);
#pragma unroll
            for (int ai = 0; ai < 2; ++ai)
#pragma unroll
                for (int m = 0; m < 4; ++m) {
                    const int vc = u.pm * 256 + ai * 128 + wr * 64 + m * 16 + fr, type = vc >> 9, hd = (vc & 511) >> 6, d = vc & 63;
                    bf16_t* dst = (bf16_t*)(ws + WS_QF + (size_t)(type * 3 + 2) * 32 * MiB) + (((size_t)(b * 8 + hd) * 256 + (s >> 5)) * 64 + d) * 32 + (s & 31);
                    const pg8::f32x4 v0 = acc[ai][bj][m][0], v1 = acc[ai][bj][m][1];
                    u32x4 w; w.x = cvt_pk_bf16(v0[0], v0[1]); w.y = cvt_pk_bf16(v0[2], v0[3]); w.z = cvt_pk_bf16(v1[0], v1[1]); w.w = cvt_pk_bf16(v1[2], v1[3]);
                    *(u32x4*)dst = w;
                }
        }
    }
};
struct EpiOut {
    static constexpr bool PERM = true, AFTER_DRAIN = false;
    const float* x; bf16_t* x1; const float* mod;
    __device__ __forceinline__ void operator()(const pg8::f32x4 (&acc)[2][2][4][2], const pg8::Unit& u, int wr, int wc, int fr, int fq) const {
        const int b = (u.pm * 256) >> 13;
#pragma unroll
        for (int bj = 0; bj < 2; ++bj) {
            const int c0 = u.pn * 256 + bj * 128 + wc * 32 + 8 * fq;
            const f32x4 g0 = *(const f32x4*)(mod + b * NMOD + 2048 + c0), g1 = *(const f32x4*)(mod + b * NMOD + 2048 + c0 + 4);
#pragma unroll
            for (int ai = 0; ai < 2; ++ai)
#pragma unroll
                for (int m = 0; m < 4; ++m) {
                    const size_t off = (size_t)(u.pm * 256 + ai * 128 + wr * 64 + m * 16 + fr) * D + c0;
                    const f32x4 v0 = *(const f32x4*)(x + off) + g0 * acc[ai][bj][m][0], v1 = *(const f32x4*)(x + off + 4) + g1 * acc[ai][bj][m][1];
                    u32x4 w; w.x = cvt_pk_bf16(v0[0], v0[1]); w.y = cvt_pk_bf16(v0[2], v0[3]); w.z = cvt_pk_bf16(v1[0], v1[1]); w.w = cvt_pk_bf16(v1[2], v1[3]);
                    *(u32x4*)(x1 + off) = w;
                }
        }
    }
};
struct EpiQuery {
    static constexpr bool PERM = true, AFTER_DRAIN = false;
    bf16_t* q;
    __device__ __forceinline__ void operator()(const pg8::f32x4 (&acc)[2][2][4][2], const pg8::Unit& u, int wr, int wc, int fr, int fq) const {
#pragma unroll
        for (int bj = 0; bj < 2; ++bj) {
            const int i16 = bj * 8 + 2 * wc + (fq >> 1), hh = fq & 1;
#pragma unroll
            for (int ai = 0; ai < 2; ++ai)
#pragma unroll
                for (int m = 0; m < 4; ++m) {
                    const pg8::f32x4 v0 = acc[ai][bj][m][0], v1 = acc[ai][bj][m][1];
                    u32x4 w; w.x = cvt_pk_bf16(v0[0], v0[1]); w.y = cvt_pk_bf16(v0[2], v0[3]); w.z = cvt_pk_bf16(v1[0], v1[1]); w.w = cvt_pk_bf16(v1[2], v1[3]);
                    const int off = ((((u.pm * 8 + ai * 4 + wr * 2 + (m >> 1)) * 8 + u.pn) * 16 + i16) * 2 + hh) * 256 + ((m & 1) * 16 + fr) * 8;
                    *(u32x4*)(q + off) = w;
                }
        }
    }
};
#define LASP(ptr) ((__attribute__((address_space(3))) unsigned char*)(ptr))
template <class Epi>
__device__ __forceinline__ void run_gemm(char* smem, const bf16_t* A, const bf16_t* Bt, int M, int N, const Epi& E) {
    pg8::Gemm g{A, Bt, M, N, 1024}; pg8::StaticOrder S; S.init(M, N, (int)gridDim.x, (int)blockIdx.x);
    pg8::gemm_phase<Epi, pg8::StaticOrder, true, true>(LASP(smem), g, S, E);
}
__device__ __forceinline__ void gemm_proj(const P& p, char* smem) {
    run_gemm(smem, (const bf16_t*)(p.ws + WS_H), (const bf16_t*)(p.ws + WS_WQK), T, 2048, EpiQK{p.ws});
    run_gemm(smem, (const bf16_t*)(p.ws + WS_WV), (const bf16_t*)(p.ws + WS_H), 1024, T, EpiV{p.ws});
}
__device__ __forceinline__ void gemm_out(const P& p, char* smem) {
    run_gemm(smem, (const bf16_t*)(p.ws + WS_MIX), (const bf16_t*)(p.ws + WS_WOUT), T, 1024, EpiOut{p.x, (bf16_t*)(p.ws + WS_X1), (const float*)(p.ws + WS_MOD)});
}
__device__ __forceinline__ void gemm_query(const P& p, char* smem) {
    run_gemm(smem, (const bf16_t*)(p.ws + WS_H), (const bf16_t*)(p.ws + WS_WQ), T, 2048, EpiQuery{(bf16_t*)(p.ws + WS_QUERY)});
}

__device__ __forceinline__ void attn_store(const P& p, const f32x16& o0, const f32x16& o1, float rs, const float* gout, int b, int h, int qt, int r, int hh, size_t dstoff = WS_MIX) {
    float ss = 0.f;
#pragma unroll
    for (int i = 0; i < 16; ++i) { const float a = o0[i] * rs, c = o1[i] * rs; ss += a * a + c * c; }
    ss = xor32_sum(ss);
    const float inv = rsqrtf(ss * (1.f / 64.f) + EPS) * rs;
    bf16_t* dst = (bf16_t*)(p.ws + dstoff) + (size_t)(b * SEQ + qt * 32 + r) * D + h * 64;
#pragma unroll
    for (int dt = 0; dt < 2; ++dt)
#pragma unroll
        for (int g = 0; g < 4; ++g) {
            const int d = dt * 32 + 8 * g + 4 * hh;
            const f32x4 gg = *(const f32x4*)(gout + d);
            const f32x16& o = dt == 0 ? o0 : o1;
            u32x2 w; w.x = cvt_pk_bf16(o[4 * g] * inv * gg.x, o[4 * g + 1] * inv * gg.y); w.y = cvt_pk_bf16(o[4 * g + 2] * inv * gg.z, o[4 * g + 3] * inv * gg.w);
            *(u32x2*)(dst + d) = w;
        }
}

__device__ __forceinline__ bf16x8 pack8(float a0, float a1, float a2, float a3, float a4, float a5, float a6, float a7) {
    u32x4 w; w.x = cvt_pk_bf16(a0, a1); w.y = cvt_pk_bf16(a2, a3); w.z = cvt_pk_bf16(a4, a5); w.w = cvt_pk_bf16(a6, a7);
    return __builtin_bit_cast(bf16x8, w);
}
__device__ __forceinline__ bf16x8 load_vfrag(const bf16_t* vt, int dt, int r, int s, int hh) {
    const bf16_t* a = vt + (dt * 32 + r) * 32 + 16 * s + 4 * hh;
    const u32x2 lo = *(const u32x2*)a, hi = *(const u32x2*)(a + 8);
    u32x4 w; w.x = lo.x; w.y = lo.y; w.z = hi.x; w.w = hi.y;
    return __builtin_bit_cast(bf16x8, w);
}

constexpr int ATT_WAVE_LDS = 4096 + 64 * 72;
struct RawTile { u32x4 k[4], v[4]; };
__device__ __forceinline__ void raw_load(RawTile& t, const bf16_t* Kp, const bf16_t* Vp, int kt, int lane) {
    const u32x4* gk = (const u32x4*)(Kp + (size_t)kt * 2048) + lane;
    const u32x4* gv = (const u32x4*)(Vp + (size_t)kt * 2048) + lane;
#pragma unroll
    for (int i = 0; i < 4; ++i) { t.k[i] = gk[64 * i]; t.v[i] = gv[64 * i]; }
}
__device__ __forceinline__ void raw_store(const RawTile& t, char* wl, int lane) {
#pragma unroll
    for (int i = 0; i < 4; ++i) {
        const int row = i * 8 + (lane >> 3), ch = lane & 7;
        *(u32x4*)(wl + row * 128 + ((ch ^ ((row >> 1) & 7)) * 16)) = t.k[i];
        const int d = i * 16 + (lane >> 2), c4 = lane & 3;
        u32x2 lo, hi; lo.x = t.v[i].x; lo.y = t.v[i].y; hi.x = t.v[i].z; hi.y = t.v[i].w;
        *(u32x2*)(wl + 4096 + d * 72 + c4 * 16) = lo;
        *(u32x2*)(wl + 4096 + d * 72 + c4 * 16 + 8) = hi;
    }
}
__device__ __forceinline__ void frag_read(bf16x8 (&kf)[4], bf16x8 (&vf)[4], const char* wl, int r, int hh) {
#pragma unroll
    for (int kk = 0; kk < 4; ++kk) kf[kk] = *(const bf16x8*)(wl + r * 128 + (((2 * kk + hh) ^ ((r >> 1) & 7)) * 16));
#pragma unroll
    for (int s2 = 0; s2 < 2; ++s2)
#pragma unroll
        for (int dt = 0; dt < 2; ++dt) {
            const char* a = wl + 4096 + (dt * 32 + r) * 72 + 32 * s2 + 8 * hh;
            const u32x2 lo = *(const u32x2*)a, hi = *(const u32x2*)(a + 16);
            u32x4 w; w.x = lo.x; w.y = lo.y; w.z = hi.x; w.w = hi.y;
            vf[2 * s2 + dt] = __builtin_bit_cast(bf16x8, w);
        }
}

template <bool DIAG>
__device__ __forceinline__ void fox_tile(const bf16x8 (&kf)[4], const bf16x8 (&vf)[4], const bf16x8 (&qf)[4], const f32x4 (&fk)[4], float Fq, float off,
                                         int hh, int r, float& m, float& lsum, f32x16& o0, f32x16& o1) {
    f32x16 s;
#pragma unroll
    for (int i = 0; i < 16; ++i) s[i] = 0.f;
#pragma unroll
    for (int kk = 0; kk < 4; ++kk) s = __builtin_amdgcn_mfma_f32_32x32x16_bf16(kf[kk], qf[kk], s, 0, 0, 0);
    const float fb = Fq - off;
    float lg[16]; float tmax = -INFINITY;
#pragma unroll
    for (int i = 0; i < 16; ++i) {
        float v = s[i] * SC2 + (fb - fk[i >> 2][i & 3]);
        if (DIAG && (8 * (i >> 2) + 4 * hh + (i & 3)) > r) v = -INFINITY;
        lg[i] = v; tmax = fmaxf(tmax, v);
    }
    tmax = xor32_max(tmax);
    const float mnew = fmaxf(m, tmax);
    if (!__all(mnew == m)) {
        const float alpha = __builtin_amdgcn_exp2f(m - mnew);
        lsum *= alpha;
#pragma unroll
        for (int i = 0; i < 16; ++i) { o0[i] *= alpha; o1[i] *= alpha; }
        m = mnew;
    }
    float ps = 0.f;
#pragma unroll
    for (int i = 0; i < 16; ++i) { lg[i] = __builtin_amdgcn_exp2f(lg[i] - m); ps += lg[i]; }
    lsum += xor32_sum(ps);
#pragma unroll
    for (int s2 = 0; s2 < 2; ++s2) {
        const bf16x8 pf = pack8(lg[8 * s2], lg[8 * s2 + 1], lg[8 * s2 + 2], lg[8 * s2 + 3], lg[8 * s2 + 4], lg[8 * s2 + 5], lg[8 * s2 + 6], lg[8 * s2 + 7]);
        o0 = __builtin_amdgcn_mfma_f32_32x32x16_bf16(vf[2 * s2], pf, o0, 0, 0, 0);
        o1 = __builtin_amdgcn_mfma_f32_32x32x16_bf16(vf[2 * s2 + 1], pf, o1, 0, 0, 0);
    }
}

template <bool DIAG>
__device__ __forceinline__ void sb_tile(const bf16x8 (&kf)[4], const bf16x8 (&vf)[4], const bf16x8 (&qf)[4], int hh, int r, float& R, f32x16& o0, f32x16& o1) {
    f32x16 s;
#pragma unroll
    for (int i = 0; i < 16; ++i) s[i] = 0.f;
#pragma unroll
    for (int kk = 0; kk < 4; ++kk) s = __builtin_amdgcn_mfma_f32_32x32x16_bf16(kf[kk], qf[kk], s, 0, 0, 0);
    float lom[16], lb[16];
#pragma unroll
    for (int i = 0; i < 16; ++i) {
        const float z = s[i] * SC2;
        const float sp = fmaxf(z, 0.f) + __builtin_amdgcn_logf(1.f + __builtin_amdgcn_exp2f(-fabsf(z)));
        const bool valid = !DIAG || (8 * (i >> 2) + 4 * hh + (i & 3)) < r;
        lom[i] = valid ? -sp : 0.f;
        lb[i] = valid ? (z - sp) : -INFINITY;
    }
    float G[4], PG[4], Tt[4];
#pragma unroll
    for (int g = 0; g < 4; ++g) { G[g] = (lom[4 * g] + lom[4 * g + 1]) + (lom[4 * g + 2] + lom[4 * g + 3]); PG[g] = xor32_get(G[g], hh); Tt[g] = G[g] + PG[g]; }
    float TS[4]; TS[3] = 0.f; TS[2] = Tt[3]; TS[1] = TS[2] + Tt[2]; TS[0] = TS[1] + Tt[1];
    float a[16];
#pragma unroll
    for (int g = 0; g < 4; ++g) {
        const float r3 = R + TS[g] + (hh == 0 ? PG[g] : 0.f);
        const float r2 = r3 + lom[4 * g + 3], r1 = r2 + lom[4 * g + 2], r0 = r1 + lom[4 * g + 1];
        a[4 * g + 3] = __builtin_amdgcn_exp2f(lb[4 * g + 3] + r3); a[4 * g + 2] = __builtin_amdgcn_exp2f(lb[4 * g + 2] + r2);
        a[4 * g + 1] = __builtin_amdgcn_exp2f(lb[4 * g + 1] + r1); a[4 * g + 0] = __builtin_amdgcn_exp2f(lb[4 * g + 0] + r0);
    }
    R += TS[0] + Tt[0];
#pragma unroll
    for (int s2 = 0; s2 < 2; ++s2) {
        const bf16x8 pf = pack8(a[8 * s2], a[8 * s2 + 1], a[8 * s2 + 2], a[8 * s2 + 3], a[8 * s2 + 4], a[8 * s2 + 5], a[8 * s2 + 6], a[8 * s2 + 7]);
        o0 = __builtin_amdgcn_mfma_f32_32x32x16_bf16(vf[2 * s2], pf, o0, 0, 0, 0);
        o1 = __builtin_amdgcn_mfma_f32_32x32x16_bf16(vf[2 * s2 + 1], pf, o1, 0, 0, 0);
    }
}

template <int PMODE>
__device__ __forceinline__ void attn_task(const P& p, char* wl, const float* gl, int type, int bh, int qt, int lane) {
    const int r = lane & 31, hh = lane >> 5, b = bh >> 3, h = bh & 7;
    const size_t segoff = (size_t)(type * 3) * 32 * MiB;
    const bf16_t* Q = (const bf16_t*)(p.ws + WS_QF + segoff) + ((size_t)bh * SEQ + qt * 32) * 64;
    const bf16_t* Kp = (const bf16_t*)(p.ws + WS_QF + segoff + 32 * MiB) + (size_t)bh * SEQ * 64;
    const bf16_t* Vp = (const bf16_t*)(p.ws + WS_QF + segoff + 64 * MiB) + (size_t)bh * 256 * 2048;
    RawTile raw;
    raw_load(raw, Kp, Vp, qt, lane);
    bf16x8 qf[4];
#pragma unroll
    for (int kk = 0; kk < 4; ++kk) qf[kk] = *(const bf16x8*)(Q + r * 64 + kk * 16 + hh * 8);
    f32x16 o0, o1;
#pragma unroll
    for (int i = 0; i < 16; ++i) { o0[i] = 0.f; o1[i] = 0.f; }
    float rs = 1.f;
    bf16x8 kf[4], vf[4];
    const float* F = (const float*)(p.ws + WS_FLOC) + (size_t)bh * SEQ;
    const float* Ct = (const float*)(p.ws + WS_CTOT) + bh * 128;
    f32x4 fk[4];
#pragma unroll
    for (int g = 0; g < 4; ++g) fk[g] = *(const f32x4*)(F + qt * 32 + 8 * g + 4 * hh);
    const float Fq = F[qt * 32 + r];
    const float kmx = __uint_as_float(((const unsigned*)(p.ws + WS_KMAX))[bh * 2]) + __uint_as_float(((const unsigned*)(p.ws + WS_KMAX))[bh * 2 + 1]);
    raw_store(raw, wl, lane);
    if (type == 0) {
        float Flast = 0.f;
        float qn2 = 0.f;
#pragma unroll
        for (int kk = 0; kk < 4; ++kk)
#pragma unroll
            for (int j = 0; j < 8; ++j) { const float v = bf2f((bf16_t)qf[kk][j]); qn2 += v * v; }
        qn2 = xor32_sum(qn2);
        const float qb = (sqrtf(qn2 * kmx) * ATT_SCALE * 1.01f + 0.01f) * LOG2E;
        float off = 0.f, m = -INFINITY, lsum = 0.f;
        f32x4 fn[4]; float ctn = 0.f;
        frag_read(kf, vf, wl, r, hh);
        if (qt > 0) {
            raw_load(raw, Kp, Vp, qt - 1, lane);
#pragma unroll
            for (int g = 0; g < 4; ++g) fn[g] = *(const f32x4*)(F + (qt - 1) * 32 + 8 * g + 4 * hh);
            Flast = F[(qt - 1) * 32 + 31]; ctn = ((qt - 1) & 1) ? Ct[(qt - 1) >> 1] : 0.f;
        }
        fox_tile<true>(kf, vf, qf, fk, Fq, off, hh, r, m, lsum, o0, o1);
        for (int kt = qt - 1; kt >= 0 && PMODE != 1; --kt) {
            raw_store(raw, wl, lane);
            off -= ctn;
            if (__all((qb + Fq - (Flast + off)) - m < -THRESH2)) break;
#pragma unroll
            for (int g = 0; g < 4; ++g) fk[g] = fn[g];
            frag_read(kf, vf, wl, r, hh);
            if (kt > 0) {
                raw_load(raw, Kp, Vp, kt - 1, lane);
#pragma unroll
                for (int g = 0; g < 4; ++g) fn[g] = *(const f32x4*)(F + (kt - 1) * 32 + 8 * g + 4 * hh);
                Flast = F[(kt - 1) * 32 + 31]; ctn = ((kt - 1) & 1) ? Ct[(kt - 1) >> 1] : 0.f;
            }
            fox_tile<false>(kf, vf, qf, fk, Fq, off, hh, r, m, lsum, o0, o1);
        }
        rs = 1.f / lsum;
    } else {
        float R = 0.f;
        frag_read(kf, vf, wl, r, hh);
        if (qt > 0) raw_load(raw, Kp, Vp, qt - 1, lane);
        sb_tile<true>(kf, vf, qf, hh, r, R, o0, o1);
        for (int kt = qt - 1; kt >= 0 && PMODE != 1; --kt) {
            raw_store(raw, wl, lane);
            if (__all(R < -THRESH2)) break;
            frag_read(kf, vf, wl, r, hh);
            if (kt > 0) raw_load(raw, Kp, Vp, kt - 1, lane);
            sb_tile<false>(kf, vf, qf, hh, r, R, o0, o1);
        }
    }
    attn_store(p, o0, o1, rs, gl + type * 64, b, type * 8 + h, qt, r, hh, PMODE == 0 ? WS_MIX : WS_H);
}

__device__ __forceinline__ void expert_cvt_job(const P& p, int job, int lane) {
    const int row0 = job * 8;
    const float* src = row0 < 16384 ? p.e_down : p.e_up;
    unsigned char* dst = p.ws + (row0 < 16384 ? WS_ED : WS_EU);
    float* rs = (float*)(p.ws + (row0 < 16384 ? WS_RSD : WS_RSU));
    const int r0 = row0 & 16383;
#pragma unroll 1
    for (int h4 = 0; h4 < 8; h4 += 4) {
        RowF32 rr[4];
#pragma unroll
        for (int k = 0; k < 4; ++k) row_load(rr[k], src, r0 + h4 + k, lane);
#pragma unroll
        for (int k = 0; k < 4; ++k) cvt_row_q4(rr[k], dst, rs, r0 + h4 + k, lane);
    }
}
template <int PMODE = 0>
__device__ __forceinline__ void attn_phase(const P& p, char* smem, int bid, int nblk, int cidx = 0, unsigned tlo = 0u, unsigned thi = 2560u) {
    const int tid = tidx(), lane = tid & 63;
    char* wl = smem + (tid >> 6) * ATT_WAVE_LDS;
    float* gl = (float*)(smem + NWAVE * ATT_WAVE_LDS);
    if (tid < 128) gl[tid] = tid < 64 ? p.g_fox[tid] : p.g_sb[tid - 64];
    __syncthreads();
    unsigned* ctr = (unsigned*)(p.ws + WS_KMAX) + 64 + 1024 * cidx;
    int q = bid & 7, tried = 0;
    unsigned tk = 0;
    if (lane == 0) tk = atomicAdd(ctr + 64 * q, 1u);
    for (;;) {
        const unsigned i = (unsigned)__builtin_amdgcn_readfirstlane((int)tk) + tlo;
        if (i >= thi) {
            if (++tried == 8) break;
            q = (q + 1) & 7;
            if (lane == 0) tk = atomicAdd(ctr + 64 * q, 1u);
            continue;
        }
        if (lane == 0) tk = atomicAdd(ctr + 64 * q, 1u);
        const unsigned g5 = i / 5u, r5 = i - 5u * g5;
        if (r5 == 4u) { if (PMODE == 0) expert_cvt_job(p, (int)(q * 512 + g5), lane); continue; }
        const unsigned a = 4u * g5 + r5;
        const int type = a >> 10, rem = (int)(a & 1023u) * 8 + q, qt = 255 - (rem >> 5), bh = rem & 31;
        attn_task<PMODE>(p, wl, gl, type, bh, qt, lane);
    }
}

__device__ __forceinline__ void p5_row(const P& p, const f32x4 (&A2)[4], const f32x4 (&B2)[4], int t, int lane, const u32x4& xa, const u32x4& xb) {
    float v[16]; float ss = 0.f;
#pragma unroll
    for (int i = 0; i < 4; ++i) { v[2 * i] = bf_lo(xa[i]); v[2 * i + 1] = bf_hi(xa[i]); v[8 + 2 * i] = bf_lo(xb[i]); v[8 + 2 * i + 1] = bf_hi(xb[i]); }
#pragma unroll
    for (int i = 0; i < 16; ++i) ss += v[i] * v[i];
    const float inv = rsqrtf(wave_sum(ss) * (1.f / D) + EPS);
    u32x4 o[2];
#pragma unroll
    for (int q = 0; q < 4; ++q) {
        f32x4 h;
#pragma unroll
        for (int e2 = 0; e2 < 4; ++e2) h[e2] = (v[4 * q + e2] * inv) * A2[q][e2] + B2[q][e2];
        o[q >> 1][(q & 1) * 2] = cvt_pk_bf16(h[0], h[1]); o[q >> 1][(q & 1) * 2 + 1] = cvt_pk_bf16(h[2], h[3]);
    }
    bf16_t* hbuf = (bf16_t*)(p.ws + WS_H);
    *(u32x4*)(hbuf + (size_t)t * D + 16 * lane) = o[0]; *(u32x4*)(hbuf + (size_t)t * D + 16 * lane + 8) = o[1];
}
__device__ __forceinline__ void p5_norm2(const P& p, int bid, int nblk) {
    const int tid = tidx(), lane = tid & 63, wid = tid >> 6;
    const float* mod = (const float*)(p.ws + WS_MOD);
    const bf16_t* x1 = (const bf16_t*)(p.ws + WS_X1);
    const int nw = nblk * NWAVE;
    int bcur = -1; f32x4 A2[4], B2[4];
    for (int t = bid * NWAVE + wid; t < T; t += 4 * nw) {
        u32x4 xa[4], xb[4];
#pragma unroll
        for (int k = 0; k < 4; ++k) { xa[k] = *(const u32x4*)(x1 + (size_t)(t + k * nw) * D + 16 * lane); xb[k] = *(const u32x4*)(x1 + (size_t)(t + k * nw) * D + 16 * lane + 8); }
#pragma unroll
        for (int k = 0; k < 4; ++k) {
            const int tk = t + k * nw, b = tk >> 13;
            if (b != bcur) {
                bcur = b;
#pragma unroll
                for (int q = 0; q < 4; ++q) {
                    const f32x4 g = *(const f32x4*)(p.g_ffn + 16 * lane + 4 * q);
                    const f32x4 s = *(const f32x4*)(mod + b * NMOD + 4096 + 16 * lane + 4 * q);
                    A2[q] = g * (s + 1.0f); B2[q] = *(const f32x4*)(mod + b * NMOD + 3072 + 16 * lane + 4 * q);
                }
            }
            p5_row(p, A2, B2, tk, lane, xa[k], xb[k]);
        }
    }
}

__device__ __forceinline__ int enc_key(float v) { const int u = __float_as_int(v); return u ^ ((u >> 31) & 0x7fffffff); }
__device__ __forceinline__ float dec_key(int k) { return __int_as_float(k ^ ((k >> 31) & 0x7fffffff)); }
#define KEY_LOWEST ((int)0x80000000)
#define INS16(L, v) do { int _v = (v); _Pragma("unroll") for (int _s = 0; _s < 16; ++_s) { const int _h = max(L[_s], _v); _v = min(L[_s], _v); L[_s] = _h; } } while (0)

#define CEX(a,i,j) { const int _h = max(a[i], a[j]); const int _l = min(a[i], a[j]); a[i] = _h; a[j] = _l; }
#define SORT16_DESC(a) do { CEX(a,0,1); CEX(a,2,3); CEX(a,0,2); CEX(a,1,3); CEX(a,1,2); CEX(a,4,5); CEX(a,6,7); CEX(a,4,6); CEX(a,5,7); CEX(a,5,6); CEX(a,0,4); CEX(a,2,6); CEX(a,2,4); CEX(a,1,5); CEX(a,3,7); CEX(a,3,5); CEX(a,1,2); CEX(a,3,4); CEX(a,5,6); CEX(a,8,9); CEX(a,10,11); CEX(a,8,10); CEX(a,9,11); CEX(a,9,10); CEX(a,12,13); CEX(a,14,15); CEX(a,12,14); CEX(a,13,15); CEX(a,13,14); CEX(a,8,12); CEX(a,10,14); CEX(a,10,12); CEX(a,9,13); CEX(a,11,15); CEX(a,11,13); CEX(a,9,10); CEX(a,11,12); CEX(a,13,14); CEX(a,0,8); CEX(a,4,12); CEX(a,4,8); CEX(a,2,10); CEX(a,6,14); CEX(a,6,10); CEX(a,2,4); CEX(a,6,8); CEX(a,10,12); CEX(a,1,9); CEX(a,5,13); CEX(a,5,9); CEX(a,3,11); CEX(a,7,15); CEX(a,7,11); CEX(a,3,5); CEX(a,7,9); CEX(a,11,13); CEX(a,1,2); CEX(a,3,4); CEX(a,5,6); CEX(a,7,8); CEX(a,9,10); CEX(a,11,12); CEX(a,13,14); } while (0)
#define BMERGE16_DESC(a) do { CEX(a,0,8); CEX(a,1,9); CEX(a,2,10); CEX(a,3,11); CEX(a,4,12); CEX(a,5,13); CEX(a,6,14); CEX(a,7,15); CEX(a,0,4); CEX(a,1,5); CEX(a,2,6); CEX(a,3,7); CEX(a,8,12); CEX(a,9,13); CEX(a,10,14); CEX(a,11,15); CEX(a,0,2); CEX(a,1,3); CEX(a,4,6); CEX(a,5,7); CEX(a,8,10); CEX(a,9,11); CEX(a,12,14); CEX(a,13,15); CEX(a,0,1); CEX(a,2,3); CEX(a,4,5); CEX(a,6,7); CEX(a,8,9); CEX(a,10,11); CEX(a,12,13); CEX(a,14,15); } while (0)
#define MERGE_TOP16(A, B) do { _Pragma("unroll") for (int _i = 0; _i < 16; ++_i) A[_i] = max(A[_i], B[15 - _i]); BMERGE16_DESC(A); } while (0)
constexpr int SK_ROW = 272;

struct QFrag { bf16x8 f[16]; };
__device__ __forceinline__ void topk_load_q(QFrag& q, const P& p, int tt, int h, int lane) {
    const bf16_t* qb = (const bf16_t*)(p.ws + WS_QUERY) + ((size_t)tt * 8 + h) * 16 * 512 + lane * 8;
#pragma unroll
    for (int i = 0; i < 16; ++i) q.f[i] = *(const bf16x8*)(qb + i * 512);
}
__device__ __forceinline__ void topk_tile(const bf16x8* qf, const char* img, int mt, int r, int hh, int (&Kk)[16]) {
    f32x16 sc;
#pragma unroll
    for (int i = 0; i < 16; ++i) sc[i] = 0.f;
#pragma unroll
    for (int kk = 0; kk < 8; ++kk) {
        const bf16x8 kf = *(const bf16x8*)(img + (mt * 32 + r) * SK_ROW + kk * 32 + hh * 16);
        sc = __builtin_amdgcn_mfma_f32_32x32x16_bf16(kf, qf[kk], sc, 0, 0, 0);
    }
#pragma unroll
    for (int i = 0; i < 16; ++i) Kk[i] = (enc_key(sc[i]) & ~127) | (mt * 32 + 8 * (i >> 2) + 4 * hh + (i & 3));
    SORT16_DESC(Kk);
}
__device__ __forceinline__ void topk_half(const bf16x8* qf, const char* img, int r, int hh, int (&Lk)[16]) {
    topk_tile(qf, img, 0, r, hh, Lk);
#pragma unroll 1
    for (int mt = 1; mt < 4; ++mt) {
        int Kk[16];
        topk_tile(qf, img, mt, r, hh, Kk);
        MERGE_TOP16(Lk, Kk);
    }
    int Pn[16];
#pragma unroll
    for (int s = 0; s < 16; ++s) Pn[s] = __shfl_xor(Lk[s], 32);
    MERGE_TOP16(Lk, Pn);
}

__device__ __forceinline__ void topk_task(const P& p, const char* img, QFrag& qf, int tt, int tt_next, int h, int lane) {
    const int r = lane & 31, hh = lane >> 5, t = tt * 32 + r;
    int La[16], Lb[16];
    topk_half(qf.f, img, r, hh, La);
    topk_half(qf.f + 8, img + 128 * SK_ROW, r, hh, Lb);
    if (tt_next < T / 32) topk_load_q(qf, p, tt_next, h, lane);
    float v1[16], v2[16];
#pragma unroll
    for (int s = 0; s < 16; ++s) { v1[s] = dec_key(La[s] & ~127); v2[s] = dec_key(Lb[s] & ~127); }
    unsigned long long I1lo = 0, I1hi = 0, I2lo = 0, I2hi = 0;
#pragma unroll
    for (int s = 0; s < 8; ++s) {
        I1lo |= (unsigned long long)(unsigned)(La[s] & 127) << (8 * s); I1hi |= (unsigned long long)(unsigned)(La[s + 8] & 127) << (8 * s);
        I2lo |= (unsigned long long)(unsigned)(Lb[s] & 127) << (8 * s); I2hi |= (unsigned long long)(unsigned)(Lb[s + 8] & 127) << (8 * s);
    }
#define CK(a, b) ((enc_key(v1[a] + v2[b]) & ~255) | ((a) * 16 + (b)))
    int C[16], G[16];
#pragma unroll
    for (int bq = 0; bq < 16; ++bq) C[bq] = CK(0, bq);
#pragma unroll
    for (int bq = 0; bq < 8; ++bq) G[bq] = CK(1, bq);
#pragma unroll
    for (int bq = 0; bq < 5; ++bq) G[8 + bq] = CK(2, bq);
#pragma unroll
    for (int bq = 0; bq < 3; ++bq) G[13 + bq] = CK(4, bq);
    SORT16_DESC(G); MERGE_TOP16(C, G);
#pragma unroll
    for (int bq = 0; bq < 4; ++bq) G[bq] = CK(3, bq);
    G[4] = CK(5, 0); G[5] = CK(5, 1); G[6] = CK(6, 0); G[7] = CK(6, 1); G[8] = CK(7, 0); G[9] = CK(7, 1);
    G[10] = CK(8, 0); G[11] = CK(9, 0); G[12] = CK(10, 0); G[13] = CK(11, 0); G[14] = CK(12, 0); G[15] = CK(13, 0);
    SORT16_DESC(G); MERGE_TOP16(C, G);
    INS16(C, CK(14, 0)); INS16(C, CK(15, 0));
#undef CK
    float tv[16]; float sum = 0.f;
    const float mx = dec_key(C[0] & ~255);
#pragma unroll
    for (int s = 0; s < 16; ++s) { tv[s] = __expf(dec_key(C[s] & ~255) - mx); sum += tv[s]; }
    const float rinv = 1.f / sum;
    unsigned* ex = (unsigned*)(p.ws + WS_EXP) + (size_t)t * 128 + h * 16 + hh * 8;
    u32x4 eo[2];
#pragma unroll
    for (int s = 0; s < 8; ++s) {
        const int hm = -hh;
        const unsigned cs = (unsigned)(C[s] ^ ((C[s] ^ C[s + 8]) & hm));
        const float gv = __uint_as_float(__float_as_uint(tv[s]) ^ ((__float_as_uint(tv[s]) ^ __float_as_uint(tv[s + 8])) & (unsigned)hm)) * rinv;
        const unsigned pos = cs & 255u, a = pos >> 4, bq = pos & 15u;
        const unsigned i1 = (unsigned)(((a & 8u) ? I1hi : I1lo) >> (8 * (a & 7u))) & 127u;
        const unsigned i2 = (unsigned)(((bq & 8u) ? I2hi : I2lo) >> (8 * (bq & 7u))) & 127u;
        eo[s >> 2][s & 3] = (i1 * 128u + i2) | (cvt_pk_bf16(gv, 0.f) << 16);
    }
    *(u32x4*)ex = eo[0]; *(u32x4*)(ex + 4) = eo[1];
}

__device__ __forceinline__ void topk_phase(const P& p, char* smem, int bid, int nblk) {
    const int tid = tidx(), lane = tid & 63, wid = tid >> 6, h = bid & 7;
    const bf16_t* sk = (const bf16_t*)(p.ws + WS_SK) + (size_t)h * 2 * 128 * 128;
    const int nslots = (nblk >> 3) * NWAVE;
    QFrag qf;
    const int tt0 = (bid >> 3) * NWAVE + wid;
    if (tt0 < T / 32) topk_load_q(qf, p, tt0, h, lane);
    for (int idx = tid; idx < 4096; idx += NTHR) {
        const int row = idx >> 4, ch = idx & 15;
        *(u32x4*)(smem + row * SK_ROW + ch * 16) = *(const u32x4*)(sk + (size_t)row * 128 + ch * 8);
    }
    __syncthreads();
    for (int tt = tt0; tt < T / 32; tt += nslots) topk_task(p, smem, qf, tt, tt + nslots, h, lane);
    __syncthreads();
}

__device__ __forceinline__ float gelu_erf(float v) { return 0.5f * v * (1.f + erff(v * 0.70710678118654752f)); }

struct PeerIdx { int e0, e1; };
struct Rows8 { u32x4 r[8]; float sc[8]; };
__device__ __forceinline__ void peer_rows8(Rows8& b, const unsigned char* tab, const float* scale, const PeerIdx& ix, int jb, int lane) {
#pragma unroll
    for (int q = 0; q < 8; ++q) {
        const int e = __builtin_amdgcn_readlane(jb < 64 ? ix.e0 : ix.e1, (jb + q) & 63);
        b.r[q] = *(const u32x4*)(tab + (size_t)e * 1024 + 16 * lane);
        b.sc[q] = scale[e];
    }
}
struct Rows16h { u32x4 r[8]; float sc[8]; };
__device__ __forceinline__ void peer_rows16h(Rows16h& b, const unsigned char* tab, const float* scale, const PeerIdx& ix, int jb, int lane) {
    const int hh = lane >> 5, l5 = lane & 31;
#pragma unroll
    for (int i = 0; i < 8; ++i) {
        const int ee = __builtin_amdgcn_readlane(jb < 64 ? ix.e0 : ix.e1, (jb + 2 * i) & 63);
        const int eo = __builtin_amdgcn_readlane(jb < 64 ? ix.e0 : ix.e1, (jb + 2 * i + 1) & 63);
        const int e = hh ? eo : ee;
        b.r[i] = *(const u32x4*)(tab + (size_t)e * 512 + 16 * l5);
        b.sc[i] = scale[e];
    }
}
__device__ __forceinline__ float peer_down_batch16(const Rows16h& b, const unsigned (&hqE)[4], const unsigned (&hqO)[4], float hbias, float hscale) {
    const int lane = threadIdx.x & 63;
    const int b4 = lane & 16, b3 = lane & 8, b2 = lane & 4;
    float dot[8];
#pragma unroll
    for (int i = 0; i < 8; ++i) {
        int s = 0;
#pragma unroll
        for (int d = 0; d < 4; ++d) {
            const unsigned x = b.r[i][d];
            s = __builtin_amdgcn_sdot4((int)(x & 0x0f0f0f0fu), (int)hqE[d], s, false);
            s = __builtin_amdgcn_sdot4((int)((x >> 4) & 0x0f0f0f0fu), (int)hqO[d], s, false);
        }
        dot[i] = ((float)s - hbias) * (b.sc[i] * hscale);
    }
    float k4[4], k2[2];
#pragma unroll
    for (int j = 0; j < 4; ++j) { const float snd = b4 ? dot[j] : dot[j + 4]; k4[j] = (b4 ? dot[j + 4] : dot[j]) + __shfl_xor(snd, 16); }
#pragma unroll
    for (int j = 0; j < 2; ++j) { const float snd = b3 ? k4[j] : k4[j + 2]; k2[j] = (b3 ? k4[j + 2] : k4[j]) + __shfl_xor(snd, 8); }
    const float snd = b2 ? k2[0] : k2[1];
    float v = (b2 ? k2[1] : k2[0]) + __shfl_xor(snd, 4);
    v += __shfl_xor(v, 2); v += __shfl_xor(v, 1);
    return v;
}
struct DownIn { u32x4 hraw[4]; unsigned rc0, rc1; };
__device__ __forceinline__ void down_in_load(DownIn& d, const P& p, int t, int lane) {
    const bf16_t* hrow = (const bf16_t*)(p.ws + WS_H) + (size_t)t * D + 32 * (lane & 31);
#pragma unroll
    for (int i = 0; i < 4; ++i) d.hraw[i] = *(const u32x4*)(hrow + 8 * i);
    const unsigned* ex = (const unsigned*)(p.ws + WS_EXP) + (size_t)t * 128;
    d.rc0 = ex[lane]; d.rc1 = ex[64 + lane];
}
__device__ __forceinline__ void peer_down_tok(const P& p, const float* RSD, DownIn& din, int t, int tnext, int lane) {
    u32x4 hraw[4];
#pragma unroll
    for (int i = 0; i < 4; ++i) hraw[i] = din.hraw[i];
    const unsigned rc0 = din.rc0, rc1 = din.rc1;
    PeerIdx ix; ix.e0 = (int)(rc0 & 0xffffu); ix.e1 = (int)(rc1 & 0xffffu);
    const float g0 = bf_hi(rc0), g1 = bf_hi(rc1);
    const unsigned char* ED = p.ws + WS_ED;
    unsigned* act = (unsigned*)(p.ws + WS_ACT) + (size_t)t * 128;
    Rows16h ba, bb, bc;
    peer_rows16h(ba, ED, RSD, ix, 0, lane); peer_rows16h(bb, ED, RSD, ix, 16, lane); peer_rows16h(bc, ED, RSD, ix, 32, lane);
    if (tnext < T) down_in_load(din, p, tnext, lane);
    float hv[32]; float mx = 0.f;
#pragma unroll
    for (int i = 0; i < 4; ++i)
#pragma unroll
        for (int k = 0; k < 4; ++k) { hv[8 * i + 2 * k] = bf_lo(hraw[i][k]); hv[8 * i + 2 * k + 1] = bf_hi(hraw[i][k]); }
#pragma unroll
    for (int i = 0; i < 32; ++i) mx = fmaxf(mx, fabsf(hv[i]));
    mx = wave_max(mx);
    const float qs = mx > 0.f ? 127.f / mx : 1.f, hscale = mx > 0.f ? mx * (1.f / 127.f) : 1.f;
    float hsum = 0.f;
#pragma unroll
    for (int i = 0; i < 32; ++i) { hv[i] = __builtin_rintf(hv[i] * qs); hsum += hv[i]; }
    unsigned hqE[4], hqO[4];
#pragma unroll
    for (int d = 0; d < 4; ++d) { hqE[d] = pack_i8x4(hv[8 * d], hv[8 * d + 2], hv[8 * d + 4], hv[8 * d + 6]); hqO[d] = pack_i8x4(hv[8 * d + 1], hv[8 * d + 3], hv[8 * d + 5], hv[8 * d + 7]); }
    const float hbias = 7.5f * hsum;
    float res[8];
    res[0] = peer_down_batch16(ba, hqE, hqO, hbias, hscale);  peer_rows16h(ba, ED, RSD, ix, 48, lane);
    res[1] = peer_down_batch16(bb, hqE, hqO, hbias, hscale);  peer_rows16h(bb, ED, RSD, ix, 64, lane);
    res[2] = peer_down_batch16(bc, hqE, hqO, hbias, hscale);  peer_rows16h(bc, ED, RSD, ix, 80, lane);
    res[3] = peer_down_batch16(ba, hqE, hqO, hbias, hscale);  peer_rows16h(ba, ED, RSD, ix, 96, lane);
    res[4] = peer_down_batch16(bb, hqE, hqO, hbias, hscale);  peer_rows16h(bb, ED, RSD, ix, 112, lane);
    res[5] = peer_down_batch16(bc, hqE, hqO, hbias, hscale);
    res[6] = peer_down_batch16(ba, hqE, hqO, hbias, hscale);
    res[7] = peer_down_batch16(bb, hqE, hqO, hbias, hscale);
    const int sl = (lane & 1) * 32 + ((lane >> 1) & 7) * 4, bsel = lane >> 4;
    float s0 = __shfl(res[0], sl), s1 = __shfl(res[4], sl);
#pragma unroll
    for (int k = 1; k < 4; ++k) { const float x0 = __shfl(res[k], sl), x1 = __shfl(res[4 + k], sl); s0 = bsel == k ? x0 : s0; s1 = bsel == k ? x1 : s1; }
    act[lane] = (rc0 & 0xffffu) | (cvt_pk_bf16(gelu_erf(s0) * g0, 0.f) << 16); act[64 + lane] = (rc1 & 0xffffu) | (cvt_pk_bf16(gelu_erf(s1) * g1, 0.f) << 16);
}
__device__ __forceinline__ void stage_scales(const float* src, char* smem) {
    for (int i = tidx(); i < 4096; i += NTHR) ((f32x4*)smem)[i] = ((const f32x4*)src)[i];
    __syncthreads();
}
__device__ __forceinline__ void peer_down_pass(const P& p, char* smem, int bid, int nblk) {
    const int tid = tidx(), lane = tid & 63, wid = tid >> 6;
    stage_scales((const float*)(p.ws + WS_RSD), smem);
    const int t0 = bid * NWAVE + wid, tstep = nblk * NWAVE;
    DownIn din;
    if (t0 < T) down_in_load(din, p, t0, lane);
    for (int t = t0; t < T; t += tstep) peer_down_tok(p, (const float*)smem, din, t, t + tstep, lane);
    __syncthreads();
}
struct Rows8h { u32x4 r[4]; };
__device__ __forceinline__ void peer_rows8h(Rows8h& b, const unsigned char* tab, const PeerIdx& ix, int jb, int lane) {
    const int hh = lane >> 5, l5 = lane & 31;
#pragma unroll
    for (int k = 0; k < 4; ++k) {
        const int ee = __builtin_amdgcn_readlane(jb < 64 ? ix.e0 : ix.e1, (jb + 2 * k) & 63);
        const int eo = __builtin_amdgcn_readlane(jb < 64 ? ix.e0 : ix.e1, (jb + 2 * k + 1) & 63);
        b.r[k] = *(const u32x4*)(tab + (size_t)(hh ? eo : ee) * 512 + 16 * l5);
    }
}
__device__ __forceinline__ void peer_up_group(const Rows8h& b, int (&acc)[32], int q0, int q1, int jb, int lane) {
    const int hh = lane >> 5;
    unsigned ce = 0u, co = 0u;
#pragma unroll
    for (int k = 0; k < 4; ++k) {
        ce |= ((unsigned)__builtin_amdgcn_readlane(jb < 64 ? q0 : q1, (jb + 2 * k) & 63) & 0xffu) << (8 * k);
        co |= ((unsigned)__builtin_amdgcn_readlane(jb < 64 ? q0 : q1, (jb + 2 * k + 1) & 63) & 0xffu) << (8 * k);
    }
    const int C = (int)(hh ? co : ce);
#pragma unroll
    for (int d = 0; d < 4; ++d)
#pragma unroll
        for (int par = 0; par < 2; ++par) {
            unsigned B[4];
#pragma unroll
            for (int k = 0; k < 4; ++k) B[k] = (par ? (b.r[k][d] >> 4) : b.r[k][d]) & 0x0f0f0f0fu;
            const unsigned p01l = __builtin_amdgcn_perm(B[1], B[0], 0x05010400u), p01h = __builtin_amdgcn_perm(B[1], B[0], 0x07030602u);
            const unsigned p23l = __builtin_amdgcn_perm(B[3], B[2], 0x05010400u), p23h = __builtin_amdgcn_perm(B[3], B[2], 0x07030602u);
            const unsigned t0 = __builtin_amdgcn_perm(p23l, p01l, 0x05040100u), t1 = __builtin_amdgcn_perm(p23l, p01l, 0x07060302u);
            const unsigned t2 = __builtin_amdgcn_perm(p23h, p01h, 0x05040100u), t3 = __builtin_amdgcn_perm(p23h, p01h, 0x07060302u);
            acc[8 * d + par + 0] = __builtin_amdgcn_sdot4((int)t0, C, acc[8 * d + par + 0], false);
            acc[8 * d + par + 2] = __builtin_amdgcn_sdot4((int)t1, C, acc[8 * d + par + 2], false);
            acc[8 * d + par + 4] = __builtin_amdgcn_sdot4((int)t2, C, acc[8 * d + par + 4], false);
            acc[8 * d + par + 6] = __builtin_amdgcn_sdot4((int)t3, C, acc[8 * d + par + 6], false);
        }
}
struct UpIn { unsigned rc0, rc1; };
__device__ __forceinline__ void up_in_load(UpIn& u, const P& p, int t, int lane) {
    const unsigned* act = (const unsigned*)(p.ws + WS_ACT) + (size_t)t * 128;
    u.rc0 = act[lane]; u.rc1 = act[64 + lane];
}
__device__ __forceinline__ void peer_up_tok(const P& p, const float* RSU, UpIn& uin, int t, int tnext, int lane, float* outbuf, const f32x4 (&gt2)[4], const f32x4 (&gfin)[4]) {
    const int hh = lane >> 5, l5 = lane & 31;
    const unsigned rc0 = uin.rc0, rc1 = uin.rc1;
    PeerIdx ix; ix.e0 = (int)(rc0 & 0xffffu); ix.e1 = (int)(rc1 & 0xffffu);
    const float a0 = bf_hi(rc0), a1 = bf_hi(rc1);
    const unsigned char* EU = p.ws + WS_EU;
    Rows8h g0, g1, g2, g3;
    peer_rows8h(g0, EU, ix, 0, lane); peer_rows8h(g1, EU, ix, 8, lane); peer_rows8h(g2, EU, ix, 16, lane); peer_rows8h(g3, EU, ix, 24, lane);
    if (tnext < T) up_in_load(uin, p, tnext, lane);
    const int col = 32 * l5 + 16 * hh;
    const bf16_t* xrow = (const bf16_t*)(p.ws + WS_X1) + (size_t)t * D + col;
    const u32x4 xa = *(const u32x4*)xrow, xb = *(const u32x4*)(xrow + 8);
    const float c0 = a0 * RSU[ix.e0], c1 = a1 * RSU[ix.e1];
    const float cmx = wave_max(fmaxf(fabsf(c0), fabsf(c1)));
    const float qs = cmx > 0.f ? 127.f / cmx : 0.f, cstep = cmx * (1.f / 127.f);
    const int q0 = (int)__builtin_rintf(c0 * qs), q1 = (int)__builtin_rintf(c1 * qs);
    const float qpar = (float)(q0 + q1);
    const float qev = wave_sum((lane & 1) ? 0.f : qpar), qod = wave_sum((lane & 1) ? qpar : 0.f);
    int acc[32];
#pragma unroll
    for (int i = 0; i < 32; ++i) acc[i] = 0;
#pragma unroll 1
    for (int jb = 0; jb < 96; jb += 32) {
        peer_up_group(g0, acc, q0, q1, jb, lane);      peer_rows8h(g0, EU, ix, jb + 32, lane);
        peer_up_group(g1, acc, q0, q1, jb + 8, lane);  peer_rows8h(g1, EU, ix, jb + 40, lane);
        peer_up_group(g2, acc, q0, q1, jb + 16, lane); peer_rows8h(g2, EU, ix, jb + 48, lane);
        peer_up_group(g3, acc, q0, q1, jb + 24, lane); peer_rows8h(g3, EU, ix, jb + 56, lane);
    }
    peer_up_group(g0, acc, q0, q1, 96, lane);  peer_up_group(g1, acc, q0, q1, 104, lane);
    peer_up_group(g2, acc, q0, q1, 112, lane); peer_up_group(g3, acc, q0, q1, 120, lane);
    const float cb = 7.5f * (hh ? qod : qev), cbp = 7.5f * (hh ? qev : qod);
    float tot[16];
#pragma unroll
    for (int i = 0; i < 16; ++i) {
        const float mine = (float)(hh ? acc[16 + i] : acc[i]) - cb;
        const float snd = (float)(hh ? acc[i] : acc[16 + i]);
        tot[i] = (mine + (xor32_get(snd, hh) - cbp)) * cstep;
    }
    float xv[16];
#pragma unroll
    for (int i = 0; i < 4; ++i) { xv[2 * i] = bf_lo(xa[i]); xv[2 * i + 1] = bf_hi(xa[i]); xv[8 + 2 * i] = bf_lo(xb[i]); xv[8 + 2 * i + 1] = bf_hi(xb[i]); }
    f32x4 x2[4]; float ss = 0.f;
#pragma unroll
    for (int i = 0; i < 4; ++i) {
        const f32x4 g = gt2[i];
#pragma unroll
        for (int e = 0; e < 4; ++e) { const float y = xv[4 * i + e] + g[e] * tot[4 * i + e]; x2[i][e] = y; ss += y * y; }
    }
    const float inv = rsqrtf(wave_sum(ss) * (1.f / D) + EPS);
#pragma unroll
    for (int i = 0; i < 4; ++i) {
        *(f32x4*)(outbuf + (size_t)t * D + col + 4 * i) = x2[i] * inv * gfin[i];
    }
}
__device__ __forceinline__ void peer_up_pass(const P& p, char* smem, int bid, int nblk, float* outbuf) {
    const int tid = tidx(), lane = tid & 63, wid = tid >> 6;
    stage_scales((const float*)(p.ws + WS_RSU), smem);
    const int col = 32 * (lane & 31) + 16 * (lane >> 5);
    f32x4 gfin[4], gt2[4];
#pragma unroll
    for (int i = 0; i < 4; ++i) gfin[i] = *(const f32x4*)(p.g_final + col + 4 * i);
    int bcur = -1;
    const int t0 = bid * NWAVE + wid, tstep = nblk * NWAVE;
    UpIn uin;
    if (t0 < T) up_in_load(uin, p, t0, lane);
    for (int t = t0; t < T; t += tstep) {
        const int b = t >> 13;
        if (b != bcur) {
            bcur = b;
#pragma unroll
            for (int i = 0; i < 4; ++i) gt2[i] = *(const f32x4*)((const float*)(p.ws + WS_MOD) + b * NMOD + 5120 + col + 4 * i);
        }
        peer_up_tok(p, (const float*)smem, uin, t, t + tstep, lane, outbuf, gt2, gfin);
    }
}

#define XB_TMO      128
#define XB_XCNT(j)  (256  + 64 * (j))
#define XB_XSUB(j)  (1280 + 64 * (j))
#define XB_XGEN(j)  (2304 + 64 * (j))
#define XB_TOP      3328
#define XB_TOPGEN   3392
#define XCD_BAR_WORDS 3456
#define XB_SPIN_CAP (1u << 18)
__device__ __forceinline__ unsigned xb_ld(unsigned* p)              { return __hip_atomic_load(p, __ATOMIC_RELAXED, __HIP_MEMORY_SCOPE_AGENT); }
__device__ __forceinline__ unsigned xb_add(unsigned* p, unsigned v) { return __hip_atomic_fetch_add(p, v, __ATOMIC_RELAXED, __HIP_MEMORY_SCOPE_AGENT); }
__device__ __forceinline__ unsigned xb_xcc_id() { return (unsigned)__builtin_amdgcn_s_getreg((3 << 11) | 20) & 0xFu; }
#define XB_SPIN(cond, bar) do { unsigned _sp = 0; while (cond) { __builtin_amdgcn_s_sleep(1); \
    if ((++_sp & 255u) == 0u) { if (xb_ld(&(bar)[XB_TMO])) break; if (_sp > XB_SPIN_CAP) { atomicAdd(&(bar)[XB_TMO], 1u); break; } } } } while (0)
struct XcdBarrier { unsigned* bar; unsigned x; volatile unsigned* st; };
__device__ __forceinline__ XcdBarrier xcd_barrier_post(unsigned* bar, volatile unsigned* st) {
    XcdBarrier b; b.bar = bar; b.x = xb_xcc_id(); b.st = st;
    if (threadIdx.x == 0) (void)xb_add(&bar[XB_XCNT(b.x)], 1u);
    return b;
}
__device__ __forceinline__ void xcd_barrier_complete(unsigned* bar, unsigned x, unsigned& nloc, unsigned& nx) {
    const unsigned G = gridDim.x * gridDim.y * gridDim.z;
    unsigned sum, cnt, mine, sp = 0u;
    for (;;) {
        sum = 0u; cnt = 0u; mine = 0u;
#pragma unroll
        for (unsigned j = 0; j < 16; ++j) { const unsigned c = xb_ld(&bar[XB_XCNT(j)]); sum += c; cnt += (c > 0u) ? 1u : 0u; mine = (j == x) ? c : mine; }
        if (sum == G) break;
        __builtin_amdgcn_s_sleep(1);
        if ((++sp & 255u) == 0u) { if (xb_ld(&bar[XB_TMO])) break; if (sp > XB_SPIN_CAP) { atomicAdd(&bar[XB_TMO], 1u); break; } }
    }
    nloc = mine > 0u ? mine : 1u; nx = cnt > 0u ? cnt : 1u;
}
__device__ __forceinline__ void xcd_barrier(const XcdBarrier& b) {
    asm volatile("s_waitcnt vmcnt(0)" ::: "memory");
    __syncthreads();
    if (threadIdx.x == 0) {
        unsigned* bar = b.bar;
        __builtin_amdgcn_s_waitcnt(0);
        unsigned nloc = b.st[0], nx = b.st[1];
        if (nloc == 0u) { xcd_barrier_complete(bar, b.x, nloc, nx); b.st[0] = nloc; b.st[1] = nx; }
        const unsigned old = xb_add(&bar[XB_XSUB(b.x)], 1u);
        const unsigned gen = old / nloc;
        if (old + 1u == (gen + 1u) * nloc) {
            __builtin_amdgcn_fence(__ATOMIC_RELEASE, "agent");
            asm volatile("s_waitcnt vmcnt(0)" ::: "memory");
            const unsigned og = xb_add(&bar[XB_TOP], 1u);
            const unsigned tg = og / nx;
            if (og + 1u == (tg + 1u) * nx) xb_add(&bar[XB_TOPGEN], 1u);
            else XB_SPIN(xb_ld(&bar[XB_TOPGEN]) == tg, bar);
            __builtin_amdgcn_fence(__ATOMIC_ACQUIRE, "agent");
            xb_add(&bar[XB_XGEN(b.x)], 1u);
            asm volatile("s_waitcnt vmcnt(0)" ::: "memory");
        } else {
            XB_SPIN(xb_ld(&bar[XB_XGEN(b.x)]) == gen, bar);
            __builtin_amdgcn_fence(__ATOMIC_ACQUIRE, "agent");
            asm volatile("s_waitcnt vmcnt(0)" ::: "memory");
        }
    }
    __syncthreads();
}

__global__ void __launch_bounds__(NTHR, 2) mega_kernel(P p) {
    extern __shared__ __attribute__((aligned(16))) char smem[];
    const int bid = blockIdx.x, nblk = gridDim.x;
    volatile unsigned* st = (volatile unsigned*)(smem + STAGE_LDS);
    if (threadIdx.x < 16) st[threadIdx.x] = 0u;
    __syncthreads();
    const XcdBarrier bar = xcd_barrier_post((unsigned*)(p.ws + WS_BAR), st);
    p0_mod(p, smem, bid, nblk);
    xcd_barrier(bar);
    p0_convert(p, smem, bid, nblk);
    p1_norm1(p, smem, bid, nblk);
#if PROBE_DUP == 1
    __syncthreads(); p1_norm1(p, smem, bid, nblk);
#endif
#if PROBE_DUP == 0
    __syncthreads(); p0_convert(p, smem, bid, nblk);
#endif
    xcd_barrier(bar);
    gemm_proj(p, smem);
#if PROBE_DUP == 2
    gemm_proj(p, smem);
#endif
    xcd_barrier(bar);
    attn_phase(p, smem, bid, nblk);
#if PROBE_DUP == 3
    attn_phase(p, smem, bid, nblk, 1);
#endif
#if PROBE_DUP == 33
    attn_phase<1>(p, smem, bid, nblk, 1);
#endif
    xcd_barrier(bar);
    gemm_out(p, smem);
#if PROBE_DUP == 4
    gemm_out(p, smem);
#endif
    xcd_barrier(bar);
    p5_norm2(p, bid, nblk);
#if PROBE_DUP == 5
    p5_norm2(p, bid, nblk);
#endif
    xcd_barrier(bar);
    gemm_query(p, smem);
#if PROBE_DUP == 6
    gemm_query(p, smem);
#endif
    xcd_barrier(bar);
    topk_phase(p, smem, bid, nblk);
#if PROBE_DUP == 7
    topk_phase(p, smem, bid, nblk);
#endif
    xcd_barrier(bar);
#if PROBE_DUP == 8
    peer_down_pass(p, smem, bid, nblk);
#endif
#if PROBE_DUP == 9
    peer_down_pass(p, smem, bid, nblk); xcd_barrier(bar);
    peer_up_pass(p, smem, bid, nblk, (float*)(p.ws + WS_QF));
#endif
    peer_down_pass(p, smem, bid, nblk);
    xcd_barrier(bar);
    peer_up_pass(p, smem, bid, nblk, p.out);
}

extern "C" void kernel_launch(void* const* d_in, const int* in_sizes, int n_in, void* d_out, int out_size, void* d_ws, size_t ws_size, hipStream_t stream) {
    if (n_in != 16 || out_size != T * D || ws_size < WS_END) { fprintf(stderr, "kernel_launch: unexpected shapes (n_in %d out %d ws %zu)\n", n_in, out_size, ws_size); return; }
    P p{};
    p.x = (const float*)d_in[0]; p.c = (const float*)d_in[1]; p.w_ada = (const float*)d_in[2]; p.b_ada = (const float*)d_in[3];
    p.g_mix = (const float*)d_in[4]; p.w_in = (const float*)d_in[5]; p.b_forget = (const float*)d_in[6]; p.g_fox = (const float*)d_in[7];
    p.g_sb = (const float*)d_in[8]; p.w_out = (const float*)d_in[9]; p.g_ffn = (const float*)d_in[10]; p.w_query = (const float*)d_in[11];
    p.sub_keys = (const float*)d_in[12]; p.e_down = (const float*)d_in[13]; p.e_up = (const float*)d_in[14]; p.g_final = (const float*)d_in[15];
    p.out = (float*)d_out; p.ws = (unsigned char*)d_ws;
    (void)hipMemsetAsync((char*)d_ws + WS_KMAX, 0, 24 * 1024, stream);
    static int grid_blocks = 0;
    if (!grid_blocks) {
        int dev = 0, cus = 0, per_cu = 0;
        (void)hipGetDevice(&dev);
        (void)hipDeviceGetAttribute(&cus, hipDeviceAttributeMultiprocessorCount, dev);
        (void)hipFuncSetAttribute((const void*)mega_kernel, hipFuncAttributeMaxDynamicSharedMemorySize, LDS_BYTES);
        (void)hipOccupancyMaxActiveBlocksPerMultiprocessor(&per_cu, mega_kernel, NTHR, LDS_BYTES);
        if (per_cu > 1) per_cu = 1;
        grid_blocks = cus * per_cu;
        if (grid_blocks % 8) grid_blocks -= grid_blocks % 8;
    }
    void* args[] = {&p};
    hipError_t e = hipLaunchCooperativeKernel((void*)mega_kernel, dim3(grid_blocks), dim3(NTHR), args, LDS_BYTES, stream);
    if (e != hipSuccess) fprintf(stderr, "cooperative launch failed: %s (grid %d)\n", hipGetErrorString(e), grid_blocks);
}
```

```cpp
#include <hip/hip_runtime.h>
#include <hip/hip_cooperative_groups.h>
#include <cstdio>
#include <cstdint>
namespace cg = cooperative_groups;

#ifndef PROBE_DUP
#define PROBE_DUP -1
#endif

namespace pg8 {
#define PG8_LAS __attribute__((address_space(3)))
typedef unsigned short bf16_t;
typedef short bf16x8 __attribute__((ext_vector_type(8)));
typedef float f32x4 __attribute__((ext_vector_type(4)));
typedef unsigned u32x4 __attribute__((ext_vector_type(4)));
constexpr int BM = 256, BK = 64, HALF = 128, HTB = HALF * BK * 2  , STAGE_BYTES = 8 * HTB, NXCD = 8, WGM = 8;

__host__ __device__ __forceinline__ int lds_byte(int r, int c) { const int st = (r >> 4) * 2 + (c >> 5), rr = r & 15, cc = c & 31, ob = rr * 64 + cc * 2; return st * 1024 + (ob ^ (((ob >> 9) & 1) << 5)); }
__host__ __device__ __forceinline__ void stage_rc(int b, int& R, int& C) { const int st = b / 1024, sb = b % 1024, swz = sb ^ (((sb >> 9) & 1) << 5); R = (st >> 1) * 16 + swz / 64; C = (st & 1) * 32 + (swz % 64) / 2; }
__host__ __device__ __forceinline__ int perm32(int rho) { const int n = rho >> 4, i = rho & 15; return 8 * (i >> 2) + 4 * n + (i & 3); }

struct Unit { int pm, pn; };
struct Gemm { const bf16_t* A; const bf16_t* Bt; int M, N, K; };

struct StaticOrder {
    int nM, nN, nwg, G, c;
    __host__ __device__ void init(int M, int N, int G_, int c_) { nM = M / BM; nN = N / BM; nwg = nM * nN; G = G_; c = c_; }
    __host__ __device__ bool next(int i, Unit& u) const {
        const long L = (long)i * G + c; if (L >= nwg) return false;
        int wgid = (int)L; { const int q = nwg / NXCD, r = nwg % NXCD, xcd = wgid % NXCD, off = wgid / NXCD; wgid = (xcd < r ? xcd * (q + 1) : r * (q + 1) + (xcd - r) * q) + off; }
        const int nig = WGM * nN, gid = wgid / nig, fm = gid * WGM, gsz = (nM - fm) < WGM ? (nM - fm) : WGM;
        u.pm = fm + ((wgid % nig) % gsz); u.pn = (wgid % nig) / gsz; return true;
    }
    __device__ __forceinline__ void a_ready(const Unit&) const {}
    __device__ __forceinline__ void done(const Unit&) const {}
};
template <class Epi, class Sched, bool ALIGN_EPI = false, bool SP2 = false>
__device__ __forceinline__ void gemm_phase(PG8_LAS unsigned char* lds, const Gemm g, const Sched& S, const Epi& E) {
    int tid = threadIdx.x; asm volatile("" : "+v"(tid));
    const int wid = __builtin_amdgcn_readfirstlane(tid >> 6), lane = tid & 63, wr = wid >> 2, wc = wid & 3, fr = lane & 15, fq = lane >> 4;
    const int K = g.K, nt = K / BK;
    unsigned voffA[2], voffB[2];
#pragma unroll
    for (int i = 0; i < 2; ++i) { int R, C; stage_rc(tid * 16 + i * 8192, R, C); const int Rb = Epi::PERM ? ((R & ~31) + perm32(R & 31)) : R;
        voffA[i] = (unsigned)(R * K + C) * 2u; voffB[i] = (unsigned)(Rb * K + C) * 2u; }
    const size_t kstep = (size_t)(BK * 2);
    const size_t hstep = (size_t)HALF * K * 2;
    const size_t tstep = 2 * hstep;
    const unsigned ldsw = (unsigned)wid * 1024u;
    const int aoff = lds_byte(wr * 64 + fr, fq * 8), boff = lds_byte(wc * 32 + fr, fq * 8);
#define PG8_SA(b, h) (((b) * 2 + (h)) * HTB)
#define PG8_SB(b, h) ((4 + (b) * 2 + (h)) * HTB)
#define PG8_STAGE(bufoff, gbase, voff) do { _Pragma("unroll") for (int _i = 0; _i < 2; ++_i) \
        __builtin_amdgcn_global_load_lds((const unsigned*)((const char*)(gbase) + (voff)[_i]), (PG8_LAS unsigned*)(lds + (bufoff) + ldsw + _i * 8192), 16, 0, 0); } while (0)
#define PG8_LDA(dst, b, h) do { _Pragma("unroll") for (int m = 0; m < 4; ++m) _Pragma("unroll") for (int k = 0; k < 2; ++k) dst[m][k] = *(const PG8_LAS bf16x8*)(lds + PG8_SA(b, h) + aoff + m * 2048 + k * 1024); } while (0)
#define PG8_LDB(dst, b, h) do { _Pragma("unroll") for (int n = 0; n < 2; ++n) _Pragma("unroll") for (int k = 0; k < 2; ++k) dst[n][k] = *(const PG8_LAS bf16x8*)(lds + PG8_SB(b, h) + boff + n * 2048 + k * 1024); } while (0)
#define PG8_MMA(ai, bj, At, Bt) do { __builtin_amdgcn_s_setprio(1); _Pragma("unroll") for (int m = 0; m < 4; ++m) _Pragma("unroll") for (int n = 0; n < 2; ++n) _Pragma("unroll") for (int k = 0; k < 2; ++k) \
        acc[ai][bj][m][n] = __builtin_amdgcn_mfma_f32_16x16x32_bf16(Bt[n][k], At[m][k], acc[ai][bj][m][n], 0, 0, 0); __builtin_amdgcn_s_setprio(0); } while (0)
#define PG8_WAIT_V(n) asm volatile("s_waitcnt vmcnt(" #n ")" ::: "memory")
#define PG8_WAIT_L(n) asm volatile("s_waitcnt lgkmcnt(" #n ")" ::: "memory")
#define PG8_BAR __builtin_amdgcn_s_barrier()
#define PG8_SCHED __builtin_amdgcn_sched_barrier(0)
    Unit cur, nxt; int ui = 0;
    if (!S.next(0, cur)) return;
    f32x4 acc[2][2][4][2];
#pragma unroll
    for (int a = 0; a < 2; ++a)
#pragma unroll
        for (int b = 0; b < 2; ++b)
#pragma unroll
            for (int m = 0; m < 4; ++m)
#pragma unroll
                for (int n = 0; n < 2; ++n) acc[a][b][m][n] = (f32x4){0.f, 0.f, 0.f, 0.f};
    bf16x8 At[4][2], B0[2][2], B1[2][2];
    const char* cA = (const char*)g.A + (size_t)cur.pm * tstep; const char* cB = (const char*)g.Bt + (size_t)cur.pn * tstep;
    S.a_ready(cur);
    if constexpr (SP2) {
        PG8_STAGE(PG8_SB(0, 0), cB, voffB); PG8_STAGE(PG8_SB(0, 1), cB + hstep, voffB); PG8_STAGE(PG8_SA(0, 0), cA, voffA); PG8_STAGE(PG8_SA(0, 1), cA + hstep, voffA);
        if (wr == 1) PG8_BAR;
        PG8_WAIT_V(2); PG8_BAR;
        PG8_STAGE(PG8_SB(1, 0), cB + kstep, voffB); PG8_STAGE(PG8_SA(1, 0), cA + kstep, voffA); PG8_STAGE(PG8_SB(1, 1), cB + hstep + kstep, voffB);
        PG8_WAIT_V(6); PG8_BAR;
    } else {
        PG8_STAGE(PG8_SB(0, 0), cB, voffB); PG8_STAGE(PG8_SA(0, 0), cA, voffA); PG8_STAGE(PG8_SB(0, 1), cB + hstep, voffB); PG8_STAGE(PG8_SA(0, 1), cA + hstep, voffA);
        if (wr == 1) PG8_BAR;
        PG8_WAIT_V(4); PG8_BAR;
        PG8_STAGE(PG8_SB(1, 0), cB + kstep, voffB); PG8_STAGE(PG8_SA(1, 0), cA + kstep, voffA); PG8_STAGE(PG8_SB(1, 1), cB + hstep + kstep, voffB);
        PG8_WAIT_V(6); PG8_BAR;
    }
    for (;;) {
        const bool has_next = S.next(ui + 1, nxt);
        const char* nA = has_next ? (const char*)g.A + (size_t)nxt.pm * tstep : cA; const char* nB = has_next ? (const char*)g.Bt + (size_t)nxt.pn * tstep : cB;
        for (int t = 0; t < nt; t += 2) {
            const bool last = (t == nt - 2);
            const char* a1 = cA + (size_t)(t + 1) * kstep;
            const char* a2 = last ? nA : cA + (size_t)(t + 2) * kstep; const char* b2 = last ? nB : cB + (size_t)(t + 2) * kstep;
            const char* a3 = a2 + kstep; const char* b3 = b2 + kstep;
            if (last && has_next) S.a_ready(nxt);
            if constexpr (SP2) {
            PG8_LDB(B0, 0, 0); PG8_LDB(B1, 0, 1); PG8_SCHED; PG8_LDA(At, 0, 0); PG8_STAGE(PG8_SA(1, 1), a1 + hstep, voffA);
            PG8_WAIT_V(8); PG8_WAIT_L(0); PG8_BAR; PG8_MMA(0, 0, At, B0); PG8_MMA(0, 1, At, B1); PG8_BAR; PG8_SCHED;
            PG8_LDA(At, 0, 1); PG8_STAGE(PG8_SB(0, 0), b2, voffB); PG8_STAGE(PG8_SB(0, 1), b2 + hstep, voffB); PG8_STAGE(PG8_SA(0, 0), a2, voffA);
            PG8_WAIT_V(8); PG8_WAIT_L(0); PG8_BAR; PG8_MMA(1, 0, At, B0); PG8_MMA(1, 1, At, B1); PG8_BAR; PG8_SCHED;
            PG8_LDB(B0, 1, 0); PG8_LDB(B1, 1, 1); PG8_SCHED; PG8_LDA(At, 1, 0); PG8_STAGE(PG8_SA(0, 1), a2 + hstep, voffA);
            PG8_WAIT_V(8); PG8_WAIT_L(0); PG8_BAR; PG8_MMA(0, 0, At, B0); PG8_MMA(0, 1, At, B1); PG8_BAR; PG8_SCHED;
            PG8_LDA(At, 1, 1); PG8_STAGE(PG8_SB(1, 0), b3, voffB); PG8_STAGE(PG8_SB(1, 1), b3 + hstep, voffB); PG8_STAGE(PG8_SA(1, 0), a3, voffA);
            PG8_WAIT_V(8); PG8_WAIT_L(0); PG8_BAR; PG8_MMA(1, 0, At, B0); PG8_MMA(1, 1, At, B1); PG8_BAR; PG8_SCHED;
            } else {
            PG8_LDB(B0, 0, 0); PG8_SCHED; PG8_LDA(At, 0, 0); PG8_STAGE(PG8_SA(1, 1), a1 + hstep, voffA);
            PG8_WAIT_L(8); PG8_BAR; PG8_WAIT_L(0); PG8_MMA(0, 0, At, B0); PG8_BAR; PG8_SCHED;
            PG8_LDB(B1, 0, 1); PG8_STAGE(PG8_SB(0, 0), b2, voffB);
            PG8_BAR; PG8_WAIT_L(0); PG8_MMA(0, 1, At, B1); PG8_BAR;
            PG8_LDA(At, 0, 1); PG8_STAGE(PG8_SA(0, 0), a2, voffA);
            PG8_BAR; PG8_WAIT_L(0); PG8_MMA(1, 0, At, B0); PG8_BAR; PG8_SCHED;
            PG8_STAGE(PG8_SB(0, 1), b2 + hstep, voffB);
            PG8_WAIT_V(6); PG8_BAR; PG8_MMA(1, 1, At, B1); PG8_BAR;
            PG8_LDB(B0, 1, 0); PG8_SCHED; PG8_LDA(At, 1, 0); PG8_STAGE(PG8_SA(0, 1), a2 + hstep, voffA);
            PG8_WAIT_L(8); PG8_BAR; PG8_WAIT_L(0); PG8_MMA(0, 0, At, B0); PG8_BAR; PG8_SCHED;
            PG8_LDB(B1, 1, 1); PG8_STAGE(PG8_SB(1, 0), b3, voffB);
            PG8_BAR; PG8_WAIT_L(0); PG8_MMA(0, 1, At, B1); PG8_BAR;
            PG8_LDA(At, 1, 1); PG8_STAGE(PG8_SA(1, 0), a3, voffA);
            PG8_BAR; PG8_WAIT_L(0); PG8_MMA(1, 0, At, B0); PG8_BAR; PG8_SCHED;
            PG8_STAGE(PG8_SB(1, 1), b3 + hstep, voffB);
            PG8_WAIT_V(6); PG8_BAR; PG8_MMA(1, 1, At, B1); PG8_BAR;
            }
        }
        if constexpr (ALIGN_EPI) { if (wr == 0) PG8_BAR; }
        if constexpr (!Epi::AFTER_DRAIN) { E(acc, cur, wr, wc, fr, fq); S.done(cur); }
        if (!has_next) break;
#pragma unroll
        for (int a = 0; a < 2; ++a)
#pragma unroll
            for (int b = 0; b < 2; ++b)
#pragma unroll
                for (int m = 0; m < 4; ++m)
#pragma unroll
                    for (int n = 0; n < 2; ++n) acc[a][b][m][n] = (f32x4){0.f, 0.f, 0.f, 0.f};
        cur = nxt; cA = nA; cB = nB; ++ui;
        if constexpr (ALIGN_EPI) { if (wr == 1) PG8_BAR; }
    }
    PG8_WAIT_V(0);
    if constexpr (!ALIGN_EPI) { if (wr == 0) PG8_BAR; }
    PG8_BAR;
    if constexpr (Epi::AFTER_DRAIN) { E.fused(acc, cur, wr, wc, fr, fq, lds, wid, lane); S.done(cur); }
#undef PG8_SA
#undef PG8_SB
#undef PG8_STAGE
#undef PG8_LDA
#undef PG8_LDB
#undef PG8_MMA
#undef PG8_WAIT_V
#undef PG8_WAIT_L
#undef PG8_BAR
#undef PG8_SCHED
}
}
typedef unsigned short bf16_t;
typedef short bf16x8 __attribute__((ext_vector_type(8)));
typedef float f32x16 __attribute__((ext_vector_type(16)));
typedef float f32x4 __attribute__((ext_vector_type(4)));
typedef unsigned u32x4 __attribute__((ext_vector_type(4)));
typedef unsigned u32x2 __attribute__((ext_vector_type(2)));

constexpr int D = 1024, NBATCH = 4, SEQ = 8192, T = NBATCH * SEQ;
constexpr int NH = 8, HD = 64, INC = 3080, NMOD = 6144;
constexpr float EPS = 1e-6f, ATT_SCALE = 0.125f, THRESH = 105.0f, LOG2E = 1.4426950408889634f;
constexpr float SC2 = ATT_SCALE * LOG2E, THRESH2 = THRESH * LOG2E;

constexpr size_t MiB = 1u << 20;
constexpr size_t WS_MOD = 0, WS_KMAX = 128 * 1024, WS_BAR = 136 * 1024, WS_CTOT = 192 * 1024, WS_FLOC = 1 * MiB;
constexpr size_t WS_WQK = 2 * MiB, WS_WV = 6 * MiB, WS_WOUT = 8 * MiB, WS_WQ = 10 * MiB, WS_SK = 14 * MiB, WS_ED = 16 * MiB, WS_EU = 48 * MiB;
constexpr size_t WS_RSD = 15 * MiB, WS_RSU = 15 * MiB + 64 * 1024;
constexpr size_t WS_H = 80 * MiB, WS_QF = 144 * MiB;
constexpr size_t WS_MIX = 336 * MiB, WS_EXP = 400 * MiB, WS_GATE = 416 * MiB, WS_END = 432 * MiB;
constexpr size_t WS_X1 = 272 * MiB;
constexpr size_t WS_ACT = 144 * MiB;
constexpr size_t WS_QUERY = 144 * MiB;

struct P {
    const float *x, *c, *w_ada, *b_ada, *g_mix, *w_in, *b_forget, *g_fox, *g_sb, *w_out, *g_ffn, *w_query, *sub_keys, *e_down, *e_up, *g_final;
    float* out;
    unsigned char* ws;
};

constexpr int NWAVE = 8, NTHR = NWAVE * 64;
constexpr int STAGE_LDS = 131072;
constexpr int LDS_BYTES = 147456;

typedef __bf16 bf16v2 __attribute__((ext_vector_type(2)));
__device__ __forceinline__ unsigned cvt_pk_bf16(float lo, float hi) { bf16v2 v; v.x = (__bf16)lo; v.y = (__bf16)hi; return __builtin_bit_cast(unsigned, v); }
__device__ __forceinline__ float bf_lo(unsigned w) { return __uint_as_float(w << 16); }
__device__ __forceinline__ float bf_hi(unsigned w) { return __uint_as_float(w & 0xffff0000u); }
__device__ __forceinline__ float bf2f(bf16_t h) { return __uint_as_float(((unsigned)h) << 16); }
__device__ __forceinline__ int tidx() { int t = threadIdx.x; asm volatile("" : "+v"(t)); return t; }
__device__ __forceinline__ float wave_sum(float v) {
#pragma unroll
    for (int o = 1; o < 64; o <<= 1) v += __shfl_xor(v, o);
    return v;
}
__device__ __forceinline__ float wave_max(float v) {
#pragma unroll
    for (int o = 1; o < 64; o <<= 1) v = fmaxf(v, __shfl_xor(v, o));
    return v;
}
__device__ __forceinline__ float xor32_sum(float v) { auto rr = __builtin_amdgcn_permlane32_swap(__float_as_uint(v), __float_as_uint(v), false, false); return __uint_as_float(rr[0]) + __uint_as_float(rr[1]); }
__device__ __forceinline__ float xor32_max(float v) { auto rr = __builtin_amdgcn_permlane32_swap(__float_as_uint(v), __float_as_uint(v), false, false); return fmaxf(__uint_as_float(rr[0]), __uint_as_float(rr[1])); }
__device__ __forceinline__ float xor32_get(float v, int hh) { auto rr = __builtin_amdgcn_permlane32_swap(__float_as_uint(v), __float_as_uint(v), false, false); return __uint_as_float(hh ? rr[0] : rr[1]); }
__device__ __forceinline__ float log_sigmoid(float x) { return fminf(x, 0.f) - log1pf(__expf(-fabsf(x))); }
__device__ __forceinline__ void p0_transpose_item(const float* W, int K, int N, int n0src, bf16_t* WT, int row0, int k0, float* scr, int lane) {
#pragma unroll 8
    for (int i = 0; i < 32; ++i) { const int kk = 2 * i + (lane >> 5); scr[kk * 33 + (lane & 31)] = W[(size_t)(k0 + kk) * N + n0src + (lane & 31)]; }
    asm volatile("s_waitcnt lgkmcnt(0)" ::: "memory");
    asm volatile("" ::: "memory");
    const int c = lane & 7;
#pragma unroll
    for (int j = 0; j < 4; ++j) {
        const int n = (lane >> 3) + 8 * j; const float* s = scr + (8 * c) * 33 + n;
        u32x4 o; o.x = cvt_pk_bf16(s[0 * 33], s[1 * 33]); o.y = cvt_pk_bf16(s[2 * 33], s[3 * 33]); o.z = cvt_pk_bf16(s[4 * 33], s[5 * 33]); o.w = cvt_pk_bf16(s[6 * 33], s[7 * 33]);
        *(u32x4*)(WT + (size_t)(row0 + n) * K + k0 + 8 * c) = o;
    }
    asm volatile("s_waitcnt lgkmcnt(0)" ::: "memory");
    asm volatile("" ::: "memory");
}

__device__ __forceinline__ void cvt_stream(const float* src, bf16_t* dst, size_t n8, size_t gtid, size_t gthreads) {
    for (size_t i = gtid; i < n8; i += gthreads) {
        const f32x4 a = *(const f32x4*)(src + i * 8), b = *(const f32x4*)(src + i * 8 + 4);
        u32x4 o; o.x = cvt_pk_bf16(a.x, a.y); o.y = cvt_pk_bf16(a.z, a.w); o.z = cvt_pk_bf16(b.x, b.y); o.w = cvt_pk_bf16(b.z, b.w);
        *(u32x4*)(dst + i * 8) = o;
    }
}

typedef float f32x2 __attribute__((ext_vector_type(2)));
__device__ __forceinline__ void cvt_row_fp8(const float* src, unsigned char* dst, float* rscale, int row, int lane) {
    const f32x4* s = (const f32x4*)(src + (size_t)row * 1024 + lane * 16);
    f32x4 v[4]; float mx = 0.f;
#pragma unroll
    for (int i = 0; i < 4; ++i) { v[i] = s[i]; mx = fmaxf(mx, fmaxf(fmaxf(fabsf(v[i].x), fabsf(v[i].y)), fmaxf(fabsf(v[i].z), fabsf(v[i].w)))); }
    mx = wave_max(mx);
    const float sc = mx > 0.f ? 224.f / mx : 1.f;
    u32x4 o;
#pragma unroll
    for (int i = 0; i < 4; ++i) {
        int w = 0;
        w = __builtin_amdgcn_cvt_pk_fp8_f32(v[i].x * sc, v[i].y * sc, w, false);
        w = __builtin_amdgcn_cvt_pk_fp8_f32(v[i].z * sc, v[i].w * sc, w, true);
        o[i] = (unsigned)w;
    }
    *(u32x4*)(dst + (size_t)row * 1024 + lane * 16) = o;
    if (lane == 0) rscale[row] = mx > 0.f ? mx * (1.f / 224.f) : 1.f;
}

__device__ __forceinline__ unsigned pack_i8x4(float a, float b, float c, float d) {
    const int ia = (int)__builtin_rintf(a), ib = (int)__builtin_rintf(b), ic = (int)__builtin_rintf(c), id = (int)__builtin_rintf(d);
    return (unsigned)(ia & 0xff) | ((unsigned)(ib & 0xff) << 8) | ((unsigned)(ic & 0xff) << 16) | ((unsigned)id << 24);
}
__device__ __forceinline__ void cvt_row_i8(const float* src, unsigned char* dst, float* rscale, int row, int lane) {
    const f32x4* s = (const f32x4*)(src + (size_t)row * 1024 + lane * 16);
    f32x4 v[4]; float mx = 0.f;
#pragma unroll
    for (int i = 0; i < 4; ++i) { v[i] = s[i]; mx = fmaxf(mx, fmaxf(fmaxf(fabsf(v[i].x), fabsf(v[i].y)), fmaxf(fabsf(v[i].z), fabsf(v[i].w)))); }
    mx = wave_max(mx);
    const float sc = mx > 0.f ? 127.f / mx : 1.f;
    u32x4 o;
#pragma unroll
    for (int i = 0; i < 4; ++i) o[i] = pack_i8x4(v[i].x * sc, v[i].y * sc, v[i].z * sc, v[i].w * sc);
    *(u32x4*)(dst + (size_t)row * 1024 + lane * 16) = o;
    if (lane == 0) rscale[row] = mx > 0.f ? mx * (1.f / 127.f) : 1.f;
}
struct RowF32 { f32x4 v[4]; };
__device__ __forceinline__ void row_load(RowF32& r, const float* src, int row, int lane) {
    const f32x4* s = (const f32x4*)(src + (size_t)row * 1024 + lane * 16);
#pragma unroll
    for (int i = 0; i < 4; ++i) r.v[i] = s[i];
}
__device__ __forceinline__ void cvt_row_q4(const RowF32& r, unsigned char* dst, float* rscale, int row, int lane, unsigned flip) {
    const f32x4 (&v)[4] = r.v; float ss = 0.f;
#pragma unroll
    for (int i = 0; i < 4; ++i) ss += (v[i].x * v[i].x + v[i].y * v[i].y) + (v[i].z * v[i].z + v[i].w * v[i].w);
    ss = wave_sum(ss);
    const float step = ss > 0.f ? 0.3352f * sqrtf(ss * (1.f / 1024.f)) : 1e-30f, inv = 1.f / step;
    unsigned w[2] = {0u, 0u};
#pragma unroll
    for (int i = 0; i < 16; ++i) {
        int n = (int)floorf(v[i >> 2][i & 3] * inv) + 8;
        n = n < 0 ? 0 : (n > 15 ? 15 : n);
        w[i >> 3] |= (unsigned)n << (4 * (i & 7));
    }
    u32x2 o; o.x = w[0] ^ flip; o.y = w[1] ^ flip;
    *(u32x2*)(dst + (size_t)row * 512 + lane * 8) = o;
    if (lane == 0) rscale[row] = step;
}
__device__ __forceinline__ void p0_mod(const P& p, char* smem, int bid, int nblk) {
    const int tid = tidx(), lane = tid & 63, wid = tid >> 6;
    const int gw = bid * NWAVE + wid, NGW = nblk * NWAVE;
    float* sc = (float*)smem;
    for (int i = tid; i < 4096; i += NTHR) { const float v = p.c[i]; sc[i] = v / (1.f + __expf(-v)); }
    __syncthreads();
    float* mod = (float*)(p.ws + WS_MOD);
    for (int it = gw; it < 1536; it += NGW) {
        const int col = it * 4 + (lane & 3), ks = lane >> 2;
        float a0 = 0.f, a1 = 0.f, a2 = 0.f, a3 = 0.f;
        const float* w = p.w_ada + (size_t)(ks * 64) * NMOD + col;
#pragma unroll 16
        for (int k = 0; k < 64; ++k) {
            const float wv = w[(size_t)k * NMOD]; const int kk = ks * 64 + k;
            a0 += sc[kk] * wv; a1 += sc[1024 + kk] * wv; a2 += sc[2048 + kk] * wv; a3 += sc[3072 + kk] * wv;
        }
#pragma unroll
        for (int o = 4; o < 64; o <<= 1) { a0 += __shfl_xor(a0, o); a1 += __shfl_xor(a1, o); a2 += __shfl_xor(a2, o); a3 += __shfl_xor(a3, o); }
        if (ks == 0) { const float bb = p.b_ada[col]; mod[col] = a0 + bb; mod[NMOD + col] = a1 + bb; mod[2 * NMOD + col] = a2 + bb; mod[3 * NMOD + col] = a3 + bb; }
    }
}
__device__ __forceinline__ void p0_convert(const P& p, char* smem, int bid, int nblk) {
    const int tid = tidx(), lane = tid & 63, wid = tid >> 6;
    const int gw = bid * NWAVE + wid, NGW = nblk * NWAVE;
    float* scr = (float*)(smem + 40960 + wid * 8448);
    for (int it = gw; it < 3072; it += NGW) {
        if (it < 1536) {
            const int kb = it / 96, nb = it % 96, seg = nb >> 4, nn = (nb & 15) * 32;
            const int srccol = seg * 512 + nn + (seg >= 3 ? 8 : 0);
            bf16_t* dstw = (bf16_t*)(p.ws + ((seg == 2 || seg == 5) ? WS_WV : WS_WQK));
            const int drow = (seg == 2 ? 0 : seg == 5 ? 512 : seg == 0 ? 0 : seg == 1 ? 512 : seg == 3 ? 1024 : 1536) + nn;
            p0_transpose_item(p.w_in, D, INC, srccol, dstw, drow, kb * 64, scr, lane);
        }
        else if (it < 2048) { const int r = it - 1536, kb = r / 32, nb = r % 32; p0_transpose_item(p.w_out, D, D, nb * 32, (bf16_t*)(p.ws + WS_WOUT), nb * 32, kb * 64, scr, lane); }
        else { const int r = it - 2048, kb = r / 64, nb = r % 64; p0_transpose_item(p.w_query, D, 2048, nb * 32, (bf16_t*)(p.ws + WS_WQ), nb * 32, kb * 64, scr, lane); }
    }
    const size_t gtid = (size_t)bid * NTHR + tid, gth = (size_t)nblk * NTHR;
    cvt_stream(p.sub_keys, (bf16_t*)(p.ws + WS_SK), (size_t)8 * 2 * 128 * 128 / 8, gtid, gth);
}

__device__ __forceinline__ void p1_norm1(const P& p, char* smem, int bid, int nblk) {
    const int tid = tidx(), lane = tid & 63, wid = tid >> 6;
    float* wfs = (float*)smem;
    float* lf = (float*)(smem + 32768);
    const float* mod = (const float*)(p.ws + WS_MOD);
    bf16_t* hbuf = (bf16_t*)(p.ws + WS_H);
    float* Floc = (float*)(p.ws + WS_FLOC);
    float* ctot = (float*)(p.ws + WS_CTOT);
    for (int i = tid; i < 2048; i += NTHR) {
        const int d = i >> 1, hf = i & 1;
        const f32x4 w = *(const f32x4*)(p.w_in + (size_t)d * INC + 1536 + 4 * hf);
        wfs[(4 * hf + 0) * 1024 + d] = w.x; wfs[(4 * hf + 1) * 1024 + d] = w.y; wfs[(4 * hf + 2) * 1024 + d] = w.z; wfs[(4 * hf + 3) * 1024 + d] = w.w;
    }
    __syncthreads();
    for (int ch = bid; ch < T / 64; ch += nblk) {
        const int t0 = ch * 64, b = t0 >> 13;
        f32x4 Am[4], Bm[4];
#pragma unroll
        for (int j = 0; j < 4; ++j) {
            const f32x4 g = ((const f32x4*)p.g_mix)[lane + 64 * j];
            const f32x4 s = ((const f32x4*)(mod + b * NMOD + 1024))[lane + 64 * j];
            Am[j] = g * (s + 1.0f);
            Bm[j] = ((const f32x4*)(mod + b * NMOD))[lane + 64 * j];
        }
        const int up32 = lane & 32, up16 = lane & 16, up8 = lane & 8;
        const int kL = ((lane >> 5) & 1) * 4 + ((lane >> 4) & 1) * 2 + ((lane >> 3) & 1);
        const float bfk = p.b_forget[kL];
        f32x4 vn[4];
        {
            const f32x4* xr = (const f32x4*)(p.x + (size_t)(t0 + wid * (64 / NWAVE)) * D) + lane;
#pragma unroll
            for (int j = 0; j < 4; ++j) vn[j] = xr[64 * j];
        }
        for (int i = 0; i < 64 / NWAVE; ++i) {
            const int t = t0 + wid * (64 / NWAVE) + i;
            f32x4 v[4]; float ss = 0.f;
#pragma unroll
            for (int j = 0; j < 4; ++j) { v[j] = vn[j]; ss += v[j].x * v[j].x + v[j].y * v[j].y + v[j].z * v[j].z + v[j].w * v[j].w; }
            if (i + 1 < 64 / NWAVE) {
                const f32x4* xr = (const f32x4*)(p.x + (size_t)(t + 1) * D) + lane;
#pragma unroll
                for (int j = 0; j < 4; ++j) vn[j] = xr[64 * j];
            }
            const float inv = rsqrtf(wave_sum(ss) * (1.f / D) + EPS);
            u32x2* o8 = (u32x2*)(hbuf + (size_t)t * D) + lane;
            float fa[8];
#pragma unroll
            for (int c = 0; c < 8; ++c) fa[c] = 0.f;
#pragma unroll
            for (int j = 0; j < 4; ++j) {
                const f32x4 h = (v[j] * inv) * Am[j] + Bm[j];
                u32x2 w; w.x = cvt_pk_bf16(h.x, h.y); w.y = cvt_pk_bf16(h.z, h.w); o8[64 * j] = w;
#pragma unroll
                for (int c = 0; c < 8; ++c) { const f32x4 wv = ((const f32x4*)(wfs + c * 1024))[lane + 64 * j]; fa[c] += (wv.x * h.x + wv.y * h.y) + (wv.z * h.z + wv.w * h.w); }
            }
            float k4[4], k2[2];
#pragma unroll
            for (int q = 0; q < 4; ++q) { const float snd = up32 ? fa[q] : fa[q + 4]; k4[q] = (up32 ? fa[q + 4] : fa[q]) + __shfl_xor(snd, 32); }
#pragma unroll
            for (int q = 0; q < 2; ++q) { const float snd = up16 ? k4[q] : k4[q + 2]; k2[q] = (up16 ? k4[q + 2] : k4[q]) + __shfl_xor(snd, 16); }
            const float snd = up8 ? k2[0] : k2[1];
            float f = (up8 ? k2[1] : k2[0]) + __shfl_xor(snd, 8);
            f += __shfl_xor(f, 4); f += __shfl_xor(f, 2); f += __shfl_xor(f, 1);
            if ((lane & 7) == 0) lf[(wid * (64 / NWAVE) + i) * 8 + kL] = log_sigmoid(f + bfk) * LOG2E;
        }
        __syncthreads();
        if (tid < 8) {
            float run = 0.f; float* dst = Floc + (size_t)(b * 8 + tid) * SEQ + (t0 & (SEQ - 1));
            for (int i = 0; i < 64; ++i) { run += lf[i * 8 + tid]; dst[i] = run; }
            ctot[(b * 8 + tid) * 128 + ((t0 & (SEQ - 1)) >> 6)] = run;
        }
        __syncthreads();
    }
}

struct EpiQK {
    static constexpr bool PERM = true, AFTER_DRAIN = false;
    unsigned char* ws;
    __device__ __forceinline__ void operator()(const pg8::f32x4 (&acc)[2][2][4][2], const pg8::Unit& u, int wr, int wc, int fr, int fq) const {
        const int b = (u.pm * 256) >> 13;
#pragma unroll
        for (int bj = 0; bj < 2; ++bj) {
            const int c0 = u.pn * 256 + bj * 128 + wc * 32 + 8 * fq, seg4 = c0 >> 9, hd = (c0 & 511) >> 6, d = c0 & 63;
            bf16_t* dst = (bf16_t*)(ws + WS_QF + (size_t)(seg4 < 2 ? seg4 : seg4 + 1) * 32 * MiB) + (size_t)(b * 8 + hd) * SEQ * 64 + d;
            float mx = 0.f;
#pragma unroll
            for (int ai = 0; ai < 2; ++ai)
#pragma unroll
                for (int m = 0; m < 4; ++m) {
                    const int s = (u.pm * 256 + ai * 128 + wr * 64 + m * 16 + fr) & (SEQ - 1);
                    const pg8::f32x4 v0 = acc[ai][bj][m][0], v1 = acc[ai][bj][m][1];
                    u32x4 w; w.x = cvt_pk_bf16(v0[0], v0[1]); w.y = cvt_pk_bf16(v0[2], v0[3]); w.z = cvt_pk_bf16(v1[0], v1[1]); w.w = cvt_pk_bf16(v1[2], v1[3]);
                    *(u32x4*)(dst + (size_t)s * 64) = w;
                    if (seg4 == 1) {
                        float q = (v0[0] * v0[0] + v0[1] * v0[1]) + (v0[2] * v0[2] + v0[3] * v0[3]) + (v1[0] * v1[0] + v1[1] * v1[1]) + (v1[2] * v1[2] + v1[3] * v1[3]);
                        q += __shfl_xor(q, 16); q += __shfl_xor(q, 32);
                        mx = fmaxf(mx, q);
                    }
                }
            if (seg4 == 1) {
                mx = wave_max(mx);
                if ((threadIdx.x & 63) == 0) atomicMax((unsigned*)(ws + WS_KMAX) + (b * 8 + hd) * 2 + (wc & 1), __float_as_uint(mx));
            }
        }
    }
};
struct EpiV {
    static constexpr bool PERM = true, AFTER_DRAIN = false;
    unsigned char* ws;
    __device__ __forceinline__ void operator()(const pg8::f32x4 (&acc)[2][2][4][2], const pg8::Unit& u, int wr, int wc, int fr, int fq) const {
#pragma unroll
        for (int bj = 0; bj < 2; ++bj) {
            const int t0 = u.pn * 256 + bj * 128 + wc * 32 + 8 * fq, b = t0 >> 13, s = t0 & (SEQ - 1);
#pragma unroll
            for (int ai = 0; ai < 2; ++ai)
#pragma unroll
                for (int m = 0; m < 4; ++m) {
                    const int vc = u.pm * 256 + ai * 128 + wr * 64 + m * 16 + fr, type = vc >> 9, hd = (vc & 511) >> 6, d = vc & 63;
                    bf16_t* dst = (bf16_t*)(ws + WS_QF + (size_t)(type * 3 + 2) * 32 * MiB) + (((size_t)(b * 8 + hd) * 256 + (s >> 5)) * 64 + d) * 32 + (s & 31);
                    const pg8::f32x4 v0 = acc[ai][bj][m][0], v1 = acc[ai][bj][m][1];
                    u32x4 w; w.x = cvt_pk_bf16(v0[0], v0[1]); w.y = cvt_pk_bf16(v0[2], v0[3]); w.z = cvt_pk_bf16(v1[0], v1[1]); w.w = cvt_pk_bf16(v1[2], v1[3]);
                    *(u32x4*)dst = w;
                }
        }
    }
};
struct EpiOut {
    static constexpr bool PERM = true, AFTER_DRAIN = false;
    const float* x; bf16_t* x1; const float* mod;
    __device__ __forceinline__ void operator()(const pg8::f32x4 (&acc)[2][2][4][2], const pg8::Unit& u, int wr, int wc, int fr, int fq) const {
        const int b = (u.pm * 256) >> 13;
#pragma unroll
        for (int bj = 0; bj < 2; ++bj) {
            const int c0 = u.pn * 256 + bj * 128 + wc * 32 + 8 * fq;
            const f32x4 g0 = *(const f32x4*)(mod + b * NMOD + 2048 + c0), g1 = *(const f32x4*)(mod + b * NMOD + 2048 + c0 + 4);
#pragma unroll
            for (int ai = 0; ai < 2; ++ai)
#pragma unroll
                for (int m = 0; m < 4; ++m) {
                    const size_t off = (size_t)(u.pm * 256 + ai * 128 + wr * 64 + m * 16 + fr) * D + c0;
                    const f32x4 v0 = *(const f32x4*)(x + off) + g0 * acc[ai][bj][m][0], v1 = *(const f32x4*)(x + off + 4) + g1 * acc[ai][bj][m][1];
                    u32x4 w; w.x = cvt_pk_bf16(v0[0], v0[1]); w.y = cvt_pk_bf16(v0[2], v0[3]); w.z = cvt_pk_bf16(v1[0], v1[1]); w.w = cvt_pk_bf16(v1[2], v1[3]);
                    *(u32x4*)(x1 + off) = w;
                }
        }
    }
};
struct EpiQuery {
    static constexpr bool PERM = true, AFTER_DRAIN = false;
    bf16_t* q;
    __device__ __forceinline__ void operator()(const pg8::f32x4 (&acc)[2][2][4][2], const pg8::Unit& u, int wr, int wc, int fr, int fq) const {
#pragma unroll
        for (int bj = 0; bj < 2; ++bj) {
            const int i16 = bj * 8 + 2 * wc + (fq >> 1), hh = fq & 1;
#pragma unroll
            for (int ai = 0; ai < 2; ++ai)
#pragma unroll
                for (int m = 0; m < 4; ++m) {
                    const pg8::f32x4 v0 = acc[ai][bj][m][0], v1 = acc[ai][bj][m][1];
                    u32x4 w; w.x = cvt_pk_bf16(v0[0], v0[1]); w.y = cvt_pk_bf16(v0[2], v0[3]); w.z = cvt_pk_bf16(v1[0], v1[1]); w.w = cvt_pk_bf16(v1[2], v1[3]);
                    const int off = ((((u.pm * 8 + ai * 4 + wr * 2 + (m >> 1)) * 8 + u.pn) * 16 + i16) * 2 + hh) * 256 + ((m & 1) * 16 + fr) * 8;
                    *(u32x4*)(q + off) = w;
                }
        }
    }
};
#define LASP(ptr) ((__attribute__((address_space(3))) unsigned char*)(ptr))
template <class Epi>
__device__ __forceinline__ void run_gemm(char* smem, const bf16_t* A, const bf16_t* Bt, int M, int N, const Epi& E) {
    pg8::Gemm g{A, Bt, M, N, 1024}; pg8::StaticOrder S; S.init(M, N, (int)gridDim.x, (int)blockIdx.x);
    pg8::gemm_phase<Epi, pg8::StaticOrder, true, true>(LASP(smem), g, S, E);
}
__device__ __forceinline__ void gemm_proj(const P& p, char* smem) {
    run_gemm(smem, (const bf16_t*)(p.ws + WS_H), (const bf16_t*)(p.ws + WS_WQK), T, 2048, EpiQK{p.ws});
    run_gemm(smem, (const bf16_t*)(p.ws + WS_WV), (const bf16_t*)(p.ws + WS_H), 1024, T, EpiV{p.ws});
}
__device__ __forceinline__ void gemm_out(const P& p, char* smem) {
    run_gemm(smem, (const bf16_t*)(p.ws + WS_MIX), (const bf16_t*)(p.ws + WS_WOUT), T, 1024, EpiOut{p.x, (bf16_t*)(p.ws + WS_X1), (const float*)(p.ws + WS_MOD)});
}
__device__ __forceinline__ void gemm_query(const P& p, char* smem) {
    run_gemm(smem, (const bf16_t*)(p.ws + WS_H), (const bf16_t*)(p.ws + WS_WQ), T, 2048, EpiQuery{(bf16_t*)(p.ws + WS_QUERY)});
}

__device__ __forceinline__ void attn_store(const P& p, const f32x16& o0, const f32x16& o1, float rs, const float* gout, int b, int h, int qt, int r, int hh, size_t dstoff = WS_MIX) {
    float ss = 0.f;
#pragma unroll
    for (int i = 0; i < 16; ++i) { const float a = o0[i] * rs, c = o1[i] * rs; ss += a * a + c * c; }
    ss = xor32_sum(ss);
    const float inv = rsqrtf(ss * (1.f / 64.f) + EPS) * rs;
    bf16_t* dst = (bf16_t*)(p.ws + dstoff) + (size_t)(b * SEQ + qt * 32 + r) * D + h * 64;
#pragma unroll
    for (int dt = 0; dt < 2; ++dt)
#pragma unroll
        for (int g = 0; g < 4; ++g) {
            const int d = dt * 32 + 8 * g + 4 * hh;
            const f32x4 gg = *(const f32x4*)(gout + d);
            const f32x16& o = dt == 0 ? o0 : o1;
            u32x2 w; w.x = cvt_pk_bf16(o[4 * g] * inv * gg.x, o[4 * g + 1] * inv * gg.y); w.y = cvt_pk_bf16(o[4 * g + 2] * inv * gg.z, o[4 * g + 3] * inv * gg.w);
            *(u32x2*)(dst + d) = w;
        }
}

__device__ __forceinline__ bf16x8 pack8(float a0, float a1, float a2, float a3, float a4, float a5, float a6, float a7) {
    u32x4 w; w.x = cvt_pk_bf16(a0, a1); w.y = cvt_pk_bf16(a2, a3); w.z = cvt_pk_bf16(a4, a5); w.w = cvt_pk_bf16(a6, a7);
    return __builtin_bit_cast(bf16x8, w);
}
__device__ __forceinline__ bf16x8 load_vfrag(const bf16_t* vt, int dt, int r, int s, int hh) {
    const bf16_t* a = vt + (dt * 32 + r) * 32 + 16 * s + 4 * hh;
    const u32x2 lo = *(const u32x2*)a, hi = *(const u32x2*)(a + 8);
    u32x4 w; w.x = lo.x; w.y = lo.y; w.z = hi.x; w.w = hi.y;
    return __builtin_bit_cast(bf16x8, w);
}

constexpr int ATT_WAVE_LDS = 4096 + 64 * 72;
struct RawTile { u32x4 k[4], v[4]; };
__device__ __forceinline__ void raw_load(RawTile& t, const bf16_t* Kp, const bf16_t* Vp, int kt, int lane) {
    const u32x4* gk = (const u32x4*)(Kp + (size_t)kt * 2048) + lane;
    const u32x4* gv = (const u32x4*)(Vp + (size_t)kt * 2048) + lane;
#pragma unroll
    for (int i = 0; i < 4; ++i) { t.k[i] = gk[64 * i]; t.v[i] = gv[64 * i]; }
}
__device__ __forceinline__ void raw_store(const RawTile& t, char* wl, int lane) {
#pragma unroll
    for (int i = 0; i < 4; ++i) {
        const int row = i * 8 + (lane >> 3), ch = lane & 7;
        *(u32x4*)(wl + row * 128 + ((ch ^ ((row >> 1) & 7)) * 16)) = t.k[i];
        const int d = i * 16 + (lane >> 2), c4 = lane & 3;
        u32x2 lo, hi; lo.x = t.v[i].x; lo.y = t.v[i].y; hi.x = t.v[i].z; hi.y = t.v[i].w;
        *(u32x2*)(wl + 4096 + d * 72 + c4 * 16) = lo;
        *(u32x2*)(wl + 4096 + d * 72 + c4 * 16 + 8) = hi;
    }
}
__device__ __forceinline__ void frag_read(bf16x8 (&kf)[4], bf16x8 (&vf)[4], const char* wl, int r, int hh) {
#pragma unroll
    for (int kk = 0; kk < 4; ++kk) kf[kk] = *(const bf16x8*)(wl + r * 128 + (((2 * kk + hh) ^ ((r >> 1) & 7)) * 16));
#pragma unroll
    for (int s2 = 0; s2 < 2; ++s2)
#pragma unroll
        for (int dt = 0; dt < 2; ++dt) {
            const char* a = wl + 4096 + (dt * 32 + r) * 72 + 32 * s2 + 8 * hh;
            const u32x2 lo = *(const u32x2*)a, hi = *(const u32x2*)(a + 16);
            u32x4 w; w.x = lo.x; w.y = lo.y; w.z = hi.x; w.w = hi.y;
            vf[2 * s2 + dt] = __builtin_bit_cast(bf16x8, w);
        }
}

template <bool DIAG>
__device__ __forceinline__ void fox_tile(const bf16x8 (&kf)[4], const bf16x8 (&vf)[4], const bf16x8 (&qf)[4], const f32x4 (&fk)[4], float Fq, float off,
                                         int hh, int r, float& m, float& lsum, f32x16& o0, f32x16& o1) {
    f32x16 s;
#pragma unroll
    for (int i = 0; i < 16; ++i) s[i] = 0.f;
#pragma unroll
    for (int kk = 0; kk < 4; ++kk) s = __builtin_amdgcn_mfma_f32_32x32x16_bf16(kf[kk], qf[kk], s, 0, 0, 0);
    const float fb = Fq - off;
    float lg[16]; float tmax = -INFINITY;
#pragma unroll
    for (int i = 0; i < 16; ++i) {
        float v = s[i] * SC2 + (fb - fk[i >> 2][i & 3]);
        if (DIAG && (8 * (i >> 2) + 4 * hh + (i & 3)) > r) v = -INFINITY;
        lg[i] = v; tmax = fmaxf(tmax, v);
    }
    tmax = xor32_max(tmax);
    const float mnew = fmaxf(m, tmax);
    if (!__all(mnew == m)) {
        const float alpha = __builtin_amdgcn_exp2f(m - mnew);
        lsum *= alpha;
#pragma unroll
        for (int i = 0; i < 16; ++i) { o0[i] *= alpha; o1[i] *= alpha; }
        m = mnew;
    }
    float ps = 0.f;
#pragma unroll
    for (int i = 0; i < 16; ++i) { lg[i] = __builtin_amdgcn_exp2f(lg[i] - m); ps += lg[i]; }
    lsum += xor32_sum(ps);
#pragma unroll
    for (int s2 = 0; s2 < 2; ++s2) {
        const bf16x8 pf = pack8(lg[8 * s2], lg[8 * s2 + 1], lg[8 * s2 + 2], lg[8 * s2 + 3], lg[8 * s2 + 4], lg[8 * s2 + 5], lg[8 * s2 + 6], lg[8 * s2 + 7]);
        o0 = __builtin_amdgcn_mfma_f32_32x32x16_bf16(vf[2 * s2], pf, o0, 0, 0, 0);
        o1 = __builtin_amdgcn_mfma_f32_32x32x16_bf16(vf[2 * s2 + 1], pf, o1, 0, 0, 0);
    }
}

template <bool DIAG>
__device__ __forceinline__ void sb_tile(const bf16x8 (&kf)[4], const bf16x8 (&vf)[4], const bf16x8 (&qf)[4], int hh, int r, float& R, f32x16& o0, f32x16& o1) {
    f32x16 s;
#pragma unroll
    for (int i = 0; i < 16; ++i) s[i] = 0.f;
#pragma unroll
    for (int kk = 0; kk < 4; ++kk) s = __builtin_amdgcn_mfma_f32_32x32x16_bf16(kf[kk], qf[kk], s, 0, 0, 0);
    float lom[16], lb[16];
#pragma unroll
    for (int i = 0; i < 16; ++i) {
        const float z = s[i] * SC2;
        const float sp = fmaxf(z, 0.f) + __builtin_amdgcn_logf(1.f + __builtin_amdgcn_exp2f(-fabsf(z)));
        const bool valid = !DIAG || (8 * (i >> 2) + 4 * hh + (i & 3)) < r;
        lom[i] = valid ? -sp : 0.f;
        lb[i] = valid ? (z - sp) : -INFINITY;
    }
    float G[4], PG[4], Tt[4];
#pragma unroll
    for (int g = 0; g < 4; ++g) { G[g] = (lom[4 * g] + lom[4 * g + 1]) + (lom[4 * g + 2] + lom[4 * g + 3]); PG[g] = xor32_get(G[g], hh); Tt[g] = G[g] + PG[g]; }
    float TS[4]; TS[3] = 0.f; TS[2] = Tt[3]; TS[1] = TS[2] + Tt[2]; TS[0] = TS[1] + Tt[1];
    float a[16];
#pragma unroll
    for (int g = 0; g < 4; ++g) {
        const float r3 = R + TS[g] + (hh == 0 ? PG[g] : 0.f);
        const float r2 = r3 + lom[4 * g + 3], r1 = r2 + lom[4 * g + 2], r0 = r1 + lom[4 * g + 1];
        a[4 * g + 3] = __builtin_amdgcn_exp2f(lb[4 * g + 3] + r3); a[4 * g + 2] = __builtin_amdgcn_exp2f(lb[4 * g + 2] + r2);
        a[4 * g + 1] = __builtin_amdgcn_exp2f(lb[4 * g + 1] + r1); a[4 * g + 0] = __builtin_amdgcn_exp2f(lb[4 * g + 0] + r0);
    }
    R += TS[0] + Tt[0];
#pragma unroll
    for (int s2 = 0; s2 < 2; ++s2) {
        const bf16x8 pf = pack8(a[8 * s2], a[8 * s2 + 1], a[8 * s2 + 2], a[8 * s2 + 3], a[8 * s2 + 4], a[8 * s2 + 5], a[8 * s2 + 6], a[8 * s2 + 7]);
        o0 = __builtin_amdgcn_mfma_f32_32x32x16_bf16(vf[2 * s2], pf, o0, 0, 0, 0);
        o1 = __builtin_amdgcn_mfma_f32_32x32x16_bf16(vf[2 * s2 + 1], pf, o1, 0, 0, 0);
    }
}

template <int PMODE>
__device__ __forceinline__ void attn_task(const P& p, char* wl, const float* gl, int type, int bh, int qt, int lane) {
    const int r = lane & 31, hh = lane >> 5, b = bh >> 3, h = bh & 7;
    const size_t segoff = (size_t)(type * 3) * 32 * MiB;
    const bf16_t* Q = (const bf16_t*)(p.ws + WS_QF + segoff) + ((size_t)bh * SEQ + qt * 32) * 64;
    const bf16_t* Kp = (const bf16_t*)(p.ws + WS_QF + segoff + 32 * MiB) + (size_t)bh * SEQ * 64;
    const bf16_t* Vp = (const bf16_t*)(p.ws + WS_QF + segoff + 64 * MiB) + (size_t)bh * 256 * 2048;
    RawTile raw;
    raw_load(raw, Kp, Vp, qt, lane);
    bf16x8 qf[4];
#pragma unroll
    for (int kk = 0; kk < 4; ++kk) qf[kk] = *(const bf16x8*)(Q + r * 64 + kk * 16 + hh * 8);
    f32x16 o0, o1;
#pragma unroll
    for (int i = 0; i < 16; ++i) { o0[i] = 0.f; o1[i] = 0.f; }
    float rs = 1.f;
    bf16x8 kf[4], vf[4];
    const float* F = (const float*)(p.ws + WS_FLOC) + (size_t)bh * SEQ;
    const float* Ct = (const float*)(p.ws + WS_CTOT) + bh * 128;
    f32x4 fk[4];
#pragma unroll
    for (int g = 0; g < 4; ++g) fk[g] = *(const f32x4*)(F + qt * 32 + 8 * g + 4 * hh);
    const float Fq = F[qt * 32 + r];
    const float kmx = __uint_as_float(((const unsigned*)(p.ws + WS_KMAX))[bh * 2]) + __uint_as_float(((const unsigned*)(p.ws + WS_KMAX))[bh * 2 + 1]);
    raw_store(raw, wl, lane);
    if (type == 0) {
        float Flast = 0.f;
        float qn2 = 0.f;
#pragma unroll
        for (int kk = 0; kk < 4; ++kk)
#pragma unroll
            for (int j = 0; j < 8; ++j) { const float v = bf2f((bf16_t)qf[kk][j]); qn2 += v * v; }
        qn2 = xor32_sum(qn2);
        const float qb = (sqrtf(qn2 * kmx) * ATT_SCALE * 1.01f + 0.01f) * LOG2E;
        float off = 0.f, m = -INFINITY, lsum = 0.f;
        f32x4 fn[4]; float ctn = 0.f;
        frag_read(kf, vf, wl, r, hh);
        if (qt > 0) {
            raw_load(raw, Kp, Vp, qt - 1, lane);
#pragma unroll
            for (int g = 0; g < 4; ++g) fn[g] = *(const f32x4*)(F + (qt - 1) * 32 + 8 * g + 4 * hh);
            Flast = F[(qt - 1) * 32 + 31]; ctn = ((qt - 1) & 1) ? Ct[(qt - 1) >> 1] : 0.f;
        }
        fox_tile<true>(kf, vf, qf, fk, Fq, off, hh, r, m, lsum, o0, o1);
        for (int kt = qt - 1; kt >= 0 && PMODE != 1; --kt) {
            raw_store(raw, wl, lane);
            off -= ctn;
            if (__all((qb + Fq - (Flast + off)) - m < -THRESH2)) break;
#pragma unroll
            for (int g = 0; g < 4; ++g) fk[g] = fn[g];
            frag_read(kf, vf, wl, r, hh);
            if (kt > 0) {
                raw_load(raw, Kp, Vp, kt - 1, lane);
#pragma unroll
                for (int g = 0; g < 4; ++g) fn[g] = *(const f32x4*)(F + (kt - 1) * 32 + 8 * g + 4 * hh);
                Flast = F[(kt - 1) * 32 + 31]; ctn = ((kt - 1) & 1) ? Ct[(kt - 1) >> 1] : 0.f;
            }
            fox_tile<false>(kf, vf, qf, fk, Fq, off, hh, r, m, lsum, o0, o1);
        }
        rs = 1.f / lsum;
    } else {
        float R = 0.f;
        frag_read(kf, vf, wl, r, hh);
        if (qt > 0) raw_load(raw, Kp, Vp, qt - 1, lane);
        sb_tile<true>(kf, vf, qf, hh, r, R, o0, o1);
        for (int kt = qt - 1; kt >= 0 && PMODE != 1; --kt) {
            raw_store(raw, wl, lane);
            if (__all(R < -THRESH2)) break;
            frag_read(kf, vf, wl, r, hh);
            if (kt > 0) raw_load(raw, Kp, Vp, kt - 1, lane);
            sb_tile<false>(kf, vf, qf, hh, r, R, o0, o1);
        }
    }
    attn_store(p, o0, o1, rs, gl + type * 64, b, type * 8 + h, qt, r, hh, PMODE == 0 ? WS_MIX : WS_H);
}

__device__ __forceinline__ void expert_cvt_job(const P& p, int job, int lane) {
    const int row0 = job * 8;
    const float* src = row0 < 16384 ? p.e_down : p.e_up;
    unsigned char* dst = p.ws + (row0 < 16384 ? WS_ED : WS_EU);
    float* rs = (float*)(p.ws + (row0 < 16384 ? WS_RSD : WS_RSU));
    const int r0 = row0 & 16383;
#pragma unroll 1
    for (int h4 = 0; h4 < 8; h4 += 4) {
        RowF32 rr[4];
#pragma unroll
        for (int k = 0; k < 4; ++k) row_load(rr[k], src, r0 + h4 + k, lane);
#pragma unroll
        for (int k = 0; k < 4; ++k) cvt_row_q4(rr[k], dst, rs, r0 + h4 + k, lane, row0 < 16384 ? 0x88888888u : 0u);
    }
}
template <int PMODE = 0>
__device__ __forceinline__ void attn_phase(const P& p, char* smem, int bid, int nblk, int cidx = 0, unsigned tlo = 0u, unsigned thi = 2560u) {
    const int tid = tidx(), lane = tid & 63;
    char* wl = smem + (tid >> 6) * ATT_WAVE_LDS;
    float* gl = (float*)(smem + NWAVE * ATT_WAVE_LDS);
    if (tid < 128) gl[tid] = tid < 64 ? p.g_fox[tid] : p.g_sb[tid - 64];
    __syncthreads();
    unsigned* ctr = (unsigned*)(p.ws + WS_KMAX) + 64 + 1024 * cidx;
    int q = bid & 7, tried = 0;
    unsigned tk = 0;
    if (lane == 0) tk = atomicAdd(ctr + 64 * q, 1u);
    for (;;) {
        const unsigned i = (unsigned)__builtin_amdgcn_readfirstlane((int)tk) + tlo;
        if (i >= thi) {
            if (++tried == 8) break;
            q = (q + 1) & 7;
            if (lane == 0) tk = atomicAdd(ctr + 64 * q, 1u);
            continue;
        }
        if (lane == 0) tk = atomicAdd(ctr + 64 * q, 1u);
        const unsigned g5 = i / 5u, r5 = i - 5u * g5;
        if (r5 == 4u) { if (PMODE == 0) expert_cvt_job(p, (int)(q * 512 + g5), lane); continue; }
        const unsigned a = 4u * g5 + r5;
        const int type = a >> 10, rem = (int)(a & 1023u) * 8 + q, qt = 255 - (rem >> 5), bh = rem & 31;
        attn_task<PMODE>(p, wl, gl, type, bh, qt, lane);
    }
}

__device__ __forceinline__ void p5_row(const P& p, const f32x4 (&A2)[4], const f32x4 (&B2)[4], int t, int lane, const u32x4& xa, const u32x4& xb) {
    float v[16]; float ss = 0.f;
#pragma unroll
    for (int i = 0; i < 4; ++i) { v[2 * i] = bf_lo(xa[i]); v[2 * i + 1] = bf_hi(xa[i]); v[8 + 2 * i] = bf_lo(xb[i]); v[8 + 2 * i + 1] = bf_hi(xb[i]); }
#pragma unroll
    for (int i = 0; i < 16; ++i) ss += v[i] * v[i];
    const float inv = rsqrtf(wave_sum(ss) * (1.f / D) + EPS);
    u32x4 o[2];
#pragma unroll
    for (int q = 0; q < 4; ++q) {
        f32x4 h;
#pragma unroll
        for (int e2 = 0; e2 < 4; ++e2) h[e2] = (v[4 * q + e2] * inv) * A2[q][e2] + B2[q][e2];
        o[q >> 1][(q & 1) * 2] = cvt_pk_bf16(h[0], h[1]); o[q >> 1][(q & 1) * 2 + 1] = cvt_pk_bf16(h[2], h[3]);
    }
    bf16_t* hbuf = (bf16_t*)(p.ws + WS_H);
    *(u32x4*)(hbuf + (size_t)t * D + 16 * lane) = o[0]; *(u32x4*)(hbuf + (size_t)t * D + 16 * lane + 8) = o[1];
}
__device__ __forceinline__ void p5_norm2(const P& p, int bid, int nblk) {
    const int tid = tidx(), lane = tid & 63, wid = tid >> 6;
    const float* mod = (const float*)(p.ws + WS_MOD);
    const bf16_t* x1 = (const bf16_t*)(p.ws + WS_X1);
    const int nw = nblk * NWAVE;
    int bcur = -1; f32x4 A2[4], B2[4];
    for (int t = bid * NWAVE + wid; t < T; t += 4 * nw) {
        u32x4 xa[4], xb[4];
#pragma unroll
        for (int k = 0; k < 4; ++k) { xa[k] = *(const u32x4*)(x1 + (size_t)(t + k * nw) * D + 16 * lane); xb[k] = *(const u32x4*)(x1 + (size_t)(t + k * nw) * D + 16 * lane + 8); }
#pragma unroll
        for (int k = 0; k < 4; ++k) {
            const int tk = t + k * nw, b = tk >> 13;
            if (b != bcur) {
                bcur = b;
#pragma unroll
                for (int q = 0; q < 4; ++q) {
                    const f32x4 g = *(const f32x4*)(p.g_ffn + 16 * lane + 4 * q);
                    const f32x4 s = *(const f32x4*)(mod + b * NMOD + 4096 + 16 * lane + 4 * q);
                    A2[q] = g * (s + 1.0f); B2[q] = *(const f32x4*)(mod + b * NMOD + 3072 + 16 * lane + 4 * q);
                }
            }
            p5_row(p, A2, B2, tk, lane, xa[k], xb[k]);
        }
    }
}

__device__ __forceinline__ int enc_key(float v) { const int u = __float_as_int(v); return u ^ ((u >> 31) & 0x7fffffff); }
__device__ __forceinline__ float dec_key(int k) { return __int_as_float(k ^ ((k >> 31) & 0x7fffffff)); }
#define KEY_LOWEST ((int)0x80000000)
#define INS16(L, v) do { int _v = (v); _Pragma("unroll") for (int _s = 0; _s < 16; ++_s) { const int _h = max(L[_s], _v); _v = min(L[_s], _v); L[_s] = _h; } } while (0)

#define CEX(a,i,j) { const int _h = max(a[i], a[j]); const int _l = min(a[i], a[j]); a[i] = _h; a[j] = _l; }
#define SORT16_DESC(a) do { CEX(a,0,1); CEX(a,2,3); CEX(a,0,2); CEX(a,1,3); CEX(a,1,2); CEX(a,4,5); CEX(a,6,7); CEX(a,4,6); CEX(a,5,7); CEX(a,5,6); CEX(a,0,4); CEX(a,2,6); CEX(a,2,4); CEX(a,1,5); CEX(a,3,7); CEX(a,3,5); CEX(a,1,2); CEX(a,3,4); CEX(a,5,6); CEX(a,8,9); CEX(a,10,11); CEX(a,8,10); CEX(a,9,11); CEX(a,9,10); CEX(a,12,13); CEX(a,14,15); CEX(a,12,14); CEX(a,13,15); CEX(a,13,14); CEX(a,8,12); CEX(a,10,14); CEX(a,10,12); CEX(a,9,13); CEX(a,11,15); CEX(a,11,13); CEX(a,9,10); CEX(a,11,12); CEX(a,13,14); CEX(a,0,8); CEX(a,4,12); CEX(a,4,8); CEX(a,2,10); CEX(a,6,14); CEX(a,6,10); CEX(a,2,4); CEX(a,6,8); CEX(a,10,12); CEX(a,1,9); CEX(a,5,13); CEX(a,5,9); CEX(a,3,11); CEX(a,7,15); CEX(a,7,11); CEX(a,3,5); CEX(a,7,9); CEX(a,11,13); CEX(a,1,2); CEX(a,3,4); CEX(a,5,6); CEX(a,7,8); CEX(a,9,10); CEX(a,11,12); CEX(a,13,14); } while (0)
#define BMERGE16_DESC(a) do { CEX(a,0,8); CEX(a,1,9); CEX(a,2,10); CEX(a,3,11); CEX(a,4,12); CEX(a,5,13); CEX(a,6,14); CEX(a,7,15); CEX(a,0,4); CEX(a,1,5); CEX(a,2,6); CEX(a,3,7); CEX(a,8,12); CEX(a,9,13); CEX(a,10,14); CEX(a,11,15); CEX(a,0,2); CEX(a,1,3); CEX(a,4,6); CEX(a,5,7); CEX(a,8,10); CEX(a,9,11); CEX(a,12,14); CEX(a,13,15); CEX(a,0,1); CEX(a,2,3); CEX(a,4,5); CEX(a,6,7); CEX(a,8,9); CEX(a,10,11); CEX(a,12,13); CEX(a,14,15); } while (0)
#define MERGE_TOP16(A, B) do { _Pragma("unroll") for (int _i = 0; _i < 16; ++_i) A[_i] = max(A[_i], B[15 - _i]); BMERGE16_DESC(A); } while (0)
constexpr int SK_ROW = 272;

struct QFrag { bf16x8 f[16]; };
__device__ __forceinline__ void topk_load_q(QFrag& q, const P& p, int tt, int h, int lane) {
    const bf16_t* qb = (const bf16_t*)(p.ws + WS_QUERY) + ((size_t)tt * 8 + h) * 16 * 512 + lane * 8;
#pragma unroll
    for (int i = 0; i < 16; ++i) q.f[i] = *(const bf16x8*)(qb + i * 512);
}
__device__ __forceinline__ void topk_tile(const bf16x8* qf, const char* img, int mt, int r, int hh, int (&Kk)[16]) {
    f32x16 sc;
#pragma unroll
    for (int i = 0; i < 16; ++i) sc[i] = 0.f;
#pragma unroll
    for (int kk = 0; kk < 8; ++kk) {
        const bf16x8 kf = *(const bf16x8*)(img + (mt * 32 + r) * SK_ROW + kk * 32 + hh * 16);
        sc = __builtin_amdgcn_mfma_f32_32x32x16_bf16(kf, qf[kk], sc, 0, 0, 0);
    }
#pragma unroll
    for (int i = 0; i < 16; ++i) Kk[i] = (enc_key(sc[i]) & ~127) | (mt * 32 + 8 * (i >> 2) + 4 * hh + (i & 3));
    SORT16_DESC(Kk);
}
__device__ __forceinline__ void topk_half(const bf16x8* qf, const char* img, int r, int hh, int (&Lk)[16]) {
    topk_tile(qf, img, 0, r, hh, Lk);
#pragma unroll 1
    for (int mt = 1; mt < 4; ++mt) {
        int Kk[16];
        topk_tile(qf, img, mt, r, hh, Kk);
        MERGE_TOP16(Lk, Kk);
    }
    int Pn[16];
#pragma unroll
    for (int s = 0; s < 16; ++s) Pn[s] = __shfl_xor(Lk[s], 32);
    MERGE_TOP16(Lk, Pn);
}

__device__ __forceinline__ void topk_task(const P& p, const char* img, QFrag& qf, int tt, int tt_next, int h, int lane) {
    const int r = lane & 31, hh = lane >> 5, t = tt * 32 + r;
    int La[16], Lb[16];
    topk_half(qf.f, img, r, hh, La);
    topk_half(qf.f + 8, img + 128 * SK_ROW, r, hh, Lb);
    if (tt_next < T / 32) topk_load_q(qf, p, tt_next, h, lane);
    float v1[16], v2[16];
#pragma unroll
    for (int s = 0; s < 16; ++s) { v1[s] = dec_key(La[s] & ~127); v2[s] = dec_key(Lb[s] & ~127); }
    unsigned long long I1lo = 0, I1hi = 0, I2lo = 0, I2hi = 0;
#pragma unroll
    for (int s = 0; s < 8; ++s) {
        I1lo |= (unsigned long long)(unsigned)(La[s] & 127) << (8 * s); I1hi |= (unsigned long long)(unsigned)(La[s + 8] & 127) << (8 * s);
        I2lo |= (unsigned long long)(unsigned)(Lb[s] & 127) << (8 * s); I2hi |= (unsigned long long)(unsigned)(Lb[s + 8] & 127) << (8 * s);
    }
#define CK(a, b) ((enc_key(v1[a] + v2[b]) & ~255) | ((a) * 16 + (b)))
    int C[16], G[16];
#pragma unroll
    for (int bq = 0; bq < 16; ++bq) C[bq] = CK(0, bq);
#pragma unroll
    for (int bq = 0; bq < 8; ++bq) G[bq] = CK(1, bq);
#pragma unroll
    for (int bq = 0; bq < 5; ++bq) G[8 + bq] = CK(2, bq);
#pragma unroll
    for (int bq = 0; bq < 3; ++bq) G[13 + bq] = CK(4, bq);
    SORT16_DESC(G); MERGE_TOP16(C, G);
#pragma unroll
    for (int bq = 0; bq < 4; ++bq) G[bq] = CK(3, bq);
    G[4] = CK(5, 0); G[5] = CK(5, 1); G[6] = CK(6, 0); G[7] = CK(6, 1); G[8] = CK(7, 0); G[9] = CK(7, 1);
    G[10] = CK(8, 0); G[11] = CK(9, 0); G[12] = CK(10, 0); G[13] = CK(11, 0); G[14] = CK(12, 0); G[15] = CK(13, 0);
    SORT16_DESC(G); MERGE_TOP16(C, G);
    INS16(C, CK(14, 0)); INS16(C, CK(15, 0));
#undef CK
    float tv[16]; float sum = 0.f;
    const float mx = dec_key(C[0] & ~255);
#pragma unroll
    for (int s = 0; s < 16; ++s) { tv[s] = __expf(dec_key(C[s] & ~255) - mx); sum += tv[s]; }
    const float rinv = 1.f / sum;
    unsigned* ex = (unsigned*)(p.ws + WS_EXP) + (size_t)t * 128 + h * 16 + hh * 8;
    u32x4 eo[2];
#pragma unroll
    for (int s = 0; s < 8; ++s) {
        const int hm = -hh;
        const unsigned cs = (unsigned)(C[s] ^ ((C[s] ^ C[s + 8]) & hm));
        const float gv = __uint_as_float(__float_as_uint(tv[s]) ^ ((__float_as_uint(tv[s]) ^ __float_as_uint(tv[s + 8])) & (unsigned)hm)) * rinv;
        const unsigned pos = cs & 255u, a = pos >> 4, bq = pos & 15u;
        const unsigned i1 = (unsigned)(((a & 8u) ? I1hi : I1lo) >> (8 * (a & 7u))) & 127u;
        const unsigned i2 = (unsigned)(((bq & 8u) ? I2hi : I2lo) >> (8 * (bq & 7u))) & 127u;
        eo[s >> 2][s & 3] = (i1 * 128u + i2) | (cvt_pk_bf16(gv, 0.f) << 16);
    }
    *(u32x4*)ex = eo[0]; *(u32x4*)(ex + 4) = eo[1];
}

__device__ __forceinline__ void topk_phase(const P& p, char* smem, int bid, int nblk) {
    const int tid = tidx(), lane = tid & 63, wid = tid >> 6, h = bid & 7;
    const bf16_t* sk = (const bf16_t*)(p.ws + WS_SK) + (size_t)h * 2 * 128 * 128;
    const int nslots = (nblk >> 3) * NWAVE;
    QFrag qf;
    const int tt0 = (bid >> 3) * NWAVE + wid;
    if (tt0 < T / 32) topk_load_q(qf, p, tt0, h, lane);
    for (int idx = tid; idx < 4096; idx += NTHR) {
        const int row = idx >> 4, ch = idx & 15;
        *(u32x4*)(smem + row * SK_ROW + ch * 16) = *(const u32x4*)(sk + (size_t)row * 128 + ch * 8);
    }
    __syncthreads();
    for (int tt = tt0; tt < T / 32; tt += nslots) topk_task(p, smem, qf, tt, tt + nslots, h, lane);
    __syncthreads();
}

__device__ __forceinline__ float gelu_erf(float v) { return 0.5f * v * (1.f + erff(v * 0.70710678118654752f)); }

struct PeerIdx { int e0, e1; };
struct Rows8 { u32x4 r[8]; float sc[8]; };
__device__ __forceinline__ void peer_rows8(Rows8& b, const unsigned char* tab, const float* scale, const PeerIdx& ix, int jb, int lane) {
#pragma unroll
    for (int q = 0; q < 8; ++q) {
        const int e = __builtin_amdgcn_readlane(jb < 64 ? ix.e0 : ix.e1, (jb + q) & 63);
        b.r[q] = *(const u32x4*)(tab + (size_t)e * 1024 + 16 * lane);
        b.sc[q] = scale[e];
    }
}
struct Rows16h { u32x4 r[8]; float sc[8]; };
__device__ __forceinline__ void peer_rows16h(Rows16h& b, const unsigned char* tab, const float* scale, const PeerIdx& ix, int jb, int lane) {
    const int hh = lane >> 5, l5 = lane & 31;
#pragma unroll
    for (int i = 0; i < 8; ++i) {
        const int ee = __builtin_amdgcn_readlane(jb < 64 ? ix.e0 : ix.e1, (jb + 2 * i) & 63);
        const int eo = __builtin_amdgcn_readlane(jb < 64 ? ix.e0 : ix.e1, (jb + 2 * i + 1) & 63);
        const int e = hh ? eo : ee;
        b.r[i] = *(const u32x4*)(tab + (size_t)e * 512 + 16 * l5);
        b.sc[i] = scale[e];
    }
}
__device__ __forceinline__ void stage_scales(const float* src, char* smem) {
    for (int i = tidx(); i < 4096; i += NTHR) ((f32x4*)smem)[i] = ((const f32x4*)src)[i];
    __syncthreads();
}
__device__ __forceinline__ int peer_down_reduce8(const int (&dot)[8], int lane) {
    const int b4 = lane & 16, b3 = lane & 8, b2 = lane & 4;
    int k4[4], k2[2];
#pragma unroll
    for (int j = 0; j < 4; ++j) { const int snd = b4 ? dot[j] : dot[j + 4]; k4[j] = (b4 ? dot[j + 4] : dot[j]) + __shfl_xor(snd, 16); }
#pragma unroll
    for (int j = 0; j < 2; ++j) { const int snd = b3 ? k4[j] : k4[j + 2]; k2[j] = (b3 ? k4[j + 2] : k4[j]) + __shfl_xor(snd, 8); }
    const int snd = b2 ? k2[0] : k2[1];
    int v = (b2 ? k2[1] : k2[0]) + __shfl_xor(snd, 4);
    v += __shfl_xor(v, 2); v += __shfl_xor(v, 1);
    return v;
}
struct DownIn { u32x4 hraw[4]; };
__device__ __forceinline__ void down_in_load(DownIn& d, const P& p, int t, int lane) {
    const bf16_t* hrow = (const bf16_t*)(p.ws + WS_H) + (size_t)t * D + 32 * (lane & 31);
#pragma unroll
    for (int i = 0; i < 4; ++i) d.hraw[i] = *(const u32x4*)(hrow + 8 * i);
}
struct SlotRec { unsigned rc0, rc1; };
__device__ __forceinline__ void rec_load(SlotRec& r, const unsigned char* ws, size_t base, int t, int lane) {
    const unsigned* ex = (const unsigned*)(ws + base) + (size_t)t * 128;
    r.rc0 = ex[lane]; r.rc1 = ex[64 + lane];
}
#define PEER_PAIR_LOAD(dst, tab, e0v, e1v, m) do { \
    const int ee_ = __builtin_amdgcn_readlane((m) < 32 ? (e0v) : (e1v), (2 * (m)) & 63), eo_ = __builtin_amdgcn_readlane((m) < 32 ? (e0v) : (e1v), (2 * (m) + 1) & 63); \
    dst = *(const u32x4*)((tab) + ((unsigned)(hh ? eo_ : ee_) * 512u + l5off)); } while (0)
template <int MODE = 0>
__device__ __forceinline__ void peer_down_pass(const P& p, char* smem, int bid, int nblk) {
    const int tid = tidx(), lane = tid & 63, wid = tid >> 6, hh = lane >> 5;
    const unsigned l5off0 = 16u * (lane & 31);
    stage_scales((const float*)(p.ws + WS_RSD), smem);
    const float* RSD = (const float*)smem;
    const unsigned char* ED = p.ws + WS_ED;
    const int t0 = bid * NWAVE + wid, tstep = nblk * NWAVE;
    if (t0 < T) {
        DownIn din; SlotRec rec, recn;
        rec_load(rec, p.ws, WS_EXP, t0, lane);
        rec_load(recn, p.ws, WS_EXP, t0 + tstep < T ? t0 + tstep : t0, lane);
        down_in_load(din, p, t0, lane);
#pragma unroll
        for (int i = 0; i < 4; ++i) asm volatile("" : "+v"(din.hraw[i]));
        asm volatile("" : "+v"(recn.rc0), "+v"(recn.rc1));
        u32x4 ring[32];
        {
            const int e0 = (int)(rec.rc0 & 0xffffu);
            const unsigned l5off = l5off0;
#pragma unroll
            for (int m = 0; m < 32; ++m) { PEER_PAIR_LOAD(ring[m], ED, e0, e0, m); __builtin_amdgcn_sched_barrier(0); }
        }
#pragma unroll 1
        for (int t = t0; t < T; t += tstep) {
            const unsigned rc0 = rec.rc0, rc1 = rec.rc1;
            const int idmask = MODE == 3 ? (nblk >> 20) : 0xffff;
            const int e1 = (int)(rc1 & idmask), e0n = (int)(recn.rc0 & idmask);
            rec = recn;
            rec_load(recn, p.ws, WS_EXP, t + 2 * tstep < T ? t + 2 * tstep : t, lane);
            float mx = 0.f;
#pragma unroll
            for (int i = 0; i < 4; ++i)
#pragma unroll
                for (int k = 0; k < 4; ++k) mx = fmaxf(mx, fmaxf(fabsf(bf_lo(din.hraw[i][k])), fabsf(bf_hi(din.hraw[i][k]))));
            mx = wave_max(mx);
            const float qs = mx > 0.f ? 119.f / mx : 1.f, hscale = mx > 0.f ? mx * (1.f / 119.f) : 1.f;
            float hsum = 0.f;
            unsigned Hhi[4], Hlo[4];
#pragma unroll
            for (int d = 0; d < 4; ++d) {
                float ve[4], vo[4];
#pragma unroll
                for (int k = 0; k < 4; ++k) { ve[k] = __builtin_rintf(bf_lo(din.hraw[d][k]) * qs); vo[k] = __builtin_rintf(bf_hi(din.hraw[d][k]) * qs); hsum += ve[k] + vo[k]; }
                const unsigned E = pack_i8x4(ve[0], ve[1], ve[2], ve[3]), O = pack_i8x4(vo[0], vo[1], vo[2], vo[3]);
                const unsigned tE = ((E & 0x7f7f7f7fu) + 0x08080808u) ^ (E & 0x80808080u), tO = ((O & 0x7f7f7f7fu) + 0x08080808u) ^ (O & 0x80808080u);
                Hhi[d] = ((tE >> 4) & 0x0f0f0f0fu) | (tO & 0xf0f0f0f0u);
                Hlo[d] = ((tE & 0x0f0f0f0fu) | ((tO << 4) & 0xf0f0f0f0u)) ^ 0x88888888u;
            }
            const float hbias = 0.25f * wave_sum(hsum);
            int res[8], dot[8];
#pragma unroll
            for (int n = 0; n < 64; ++n) {
                u32x4& rr = ring[n & 31];
                if (MODE == 1) dot[n & 7] = (int)((rr[0] ^ rr[1] ^ rr[2] ^ rr[3]) & 0xffffu);
                else {
                    int sh = 0, sl = 0;
#pragma unroll
                    for (int d = 0; d < 4; ++d) {
                        sh = __builtin_amdgcn_sdot8((int)rr[d], (int)Hhi[d], sh, false);
                        sl = __builtin_amdgcn_sdot8((int)rr[d], (int)Hlo[d], sl, false);
                    }
                    dot[n & 7] = (sh << 4) + sl;
                }
                if (MODE != 2) {
                    unsigned l5off = l5off0; asm volatile("" : "+v"(l5off) : "v"(dot[n & 7]));
                    if (n < 32) PEER_PAIR_LOAD(rr, ED, e1, e1, n + 32);
                    else        PEER_PAIR_LOAD(rr, ED, e0n, e0n, n - 32);
                    __builtin_amdgcn_sched_barrier(0);
                }
                if ((n & 7) == 7) res[n >> 3] = peer_down_reduce8(dot, lane);
                if (n == 31) down_in_load(din, p, t + tstep < T ? t + tstep : t, lane);
            }
            const int sl = (lane & 1) * 32 + ((lane >> 1) & 7) * 4, bsel = lane >> 4;
            int i0 = __shfl(res[0], sl), i1 = __shfl(res[4], sl);
#pragma unroll
            for (int k = 1; k < 4; ++k) { const int x0 = __shfl(res[k], sl), x1 = __shfl(res[4 + k], sl); i0 = bsel == k ? x0 : i0; i1 = bsel == k ? x1 : i1; }
            const float s0 = ((float)i0 + hbias) * (RSD[rc0 & 0xffffu] * hscale), s1 = ((float)i1 + hbias) * (RSD[rc1 & 0xffffu] * hscale);
            unsigned* act = (unsigned*)(p.ws + WS_ACT) + (size_t)t * 128;
            act[lane] = (rc0 & 0xffffu) | (cvt_pk_bf16(gelu_erf(s0) * bf_hi(rc0), 0.f) << 16); act[64 + lane] = (rc1 & 0xffffu) | (cvt_pk_bf16(gelu_erf(s1) * bf_hi(rc1), 0.f) << 16);
        }
    }
    __syncthreads();
}
struct Rows8h { u32x4 r[4]; };
__device__ __forceinline__ void peer_rows8h(Rows8h& b, const unsigned char* tab, const PeerIdx& ix, int jb, int lane) {
    const int hh = lane >> 5, l5 = lane & 31;
#pragma unroll
    for (int k = 0; k < 4; ++k) {
        const int ee = __builtin_amdgcn_readlane(jb < 64 ? ix.e0 : ix.e1, (jb + 2 * k) & 63);
        const int eo = __builtin_amdgcn_readlane(jb < 64 ? ix.e0 : ix.e1, (jb + 2 * k + 1) & 63);
        b.r[k] = *(const u32x4*)(tab + (size_t)(hh ? eo : ee) * 512 + 16 * l5);
    }
}
__device__ __forceinline__ void peer_up_group(const Rows8h& b, int (&acc)[32], int q0, int q1, int jb, int lane) {
    const int hh = lane >> 5;
    unsigned ce = 0u, co = 0u;
#pragma unroll
    for (int k = 0; k < 4; ++k) {
        ce |= ((unsigned)__builtin_amdgcn_readlane(jb < 64 ? q0 : q1, (jb + 2 * k) & 63) & 0xffu) << (8 * k);
        co |= ((unsigned)__builtin_amdgcn_readlane(jb < 64 ? q0 : q1, (jb + 2 * k + 1) & 63) & 0xffu) << (8 * k);
    }
    const int C = (int)(hh ? co : ce);
#pragma unroll
    for (int d = 0; d < 4; ++d)
#pragma unroll
        for (int par = 0; par < 2; ++par) {
            unsigned B[4];
#pragma unroll
            for (int k = 0; k < 4; ++k) B[k] = (par ? (b.r[k][d] >> 4) : b.r[k][d]) & 0x0f0f0f0fu;
            const unsigned p01l = __builtin_amdgcn_perm(B[1], B[0], 0x05010400u), p01h = __builtin_amdgcn_perm(B[1], B[0], 0x07030602u);
            const unsigned p23l = __builtin_amdgcn_perm(B[3], B[2], 0x05010400u), p23h = __builtin_amdgcn_perm(B[3], B[2], 0x07030602u);
            const unsigned t0 = __builtin_amdgcn_perm(p23l, p01l, 0x05040100u), t1 = __builtin_amdgcn_perm(p23l, p01l, 0x07060302u);
            const unsigned t2 = __builtin_amdgcn_perm(p23h, p01h, 0x05040100u), t3 = __builtin_amdgcn_perm(p23h, p01h, 0x07060302u);
            acc[8 * d + par + 0] = __builtin_amdgcn_sdot4((int)t0, C, acc[8 * d + par + 0], false);
            acc[8 * d + par + 2] = __builtin_amdgcn_sdot4((int)t1, C, acc[8 * d + par + 2], false);
            acc[8 * d + par + 4] = __builtin_amdgcn_sdot4((int)t2, C, acc[8 * d + par + 4], false);
            acc[8 * d + par + 6] = __builtin_amdgcn_sdot4((int)t3, C, acc[8 * d + par + 6], false);
        }
}
struct UpIn { unsigned rc0, rc1; };
__device__ __forceinline__ void up_in_load(UpIn& u, const P& p, int t, int lane) {
    const unsigned* act = (const unsigned*)(p.ws + WS_ACT) + (size_t)t * 128;
    u.rc0 = act[lane]; u.rc1 = act[64 + lane];
}
template <int MODE = 0>
__device__ __forceinline__ void peer_up_tok(const P& p, const float* RSU, UpIn& uin, int t, int tnext, int lane, float* outbuf, const f32x4 (&gt2)[4], const f32x4 (&gfin)[4]) {
    const int hh = lane >> 5, l5 = lane & 31;
    const unsigned rc0 = uin.rc0, rc1 = uin.rc1;
    PeerIdx ix; ix.e0 = (int)(rc0 & 0xffffu); ix.e1 = (int)(rc1 & 0xffffu);
    const float a0 = bf_hi(rc0), a1 = bf_hi(rc1);
    const unsigned char* EU = p.ws + WS_EU;
    Rows8h g0, g1, g2, g3;
    peer_rows8h(g0, EU, ix, 0, lane); peer_rows8h(g1, EU, ix, 8, lane); peer_rows8h(g2, EU, ix, 16, lane); peer_rows8h(g3, EU, ix, 24, lane);
    if (tnext < T) up_in_load(uin, p, tnext, lane);
    const int col = 32 * l5 + 16 * hh;
    const bf16_t* xrow = (const bf16_t*)(p.ws + WS_X1) + (size_t)t * D + col;
    const u32x4 xa = *(const u32x4*)xrow, xb = *(const u32x4*)(xrow + 8);
    const float c0 = a0 * RSU[ix.e0], c1 = a1 * RSU[ix.e1];
    const float cmx = wave_max(fmaxf(fabsf(c0), fabsf(c1)));
    const float qs = cmx > 0.f ? 127.f / cmx : 0.f, cstep = cmx * (1.f / 127.f);
    const int q0 = (int)__builtin_rintf(c0 * qs), q1 = (int)__builtin_rintf(c1 * qs);
    const float qpar = (float)(q0 + q1);
    const float qev = wave_sum((lane & 1) ? 0.f : qpar), qod = wave_sum((lane & 1) ? qpar : 0.f);
    int acc[32];
#pragma unroll
    for (int i = 0; i < 32; ++i) acc[i] = 0;
#define UPG(g, j) do { if (MODE == 1) { _Pragma("unroll") for (int k_ = 0; k_ < 4; ++k_) _Pragma("unroll") for (int d_ = 0; d_ < 4; ++d_) acc[4 * k_ + d_] ^= (int)g.r[k_][d_]; } \
                       else peer_up_group(g, acc, q0, q1, j, lane); } while (0)
#define UPL(g, j) do { if (MODE != 2) peer_rows8h(g, EU, ix, j, lane); } while (0)
#pragma unroll 1
    for (int jb = 0; jb < 96; jb += 32) {
        UPG(g0, jb);      UPL(g0, jb + 32);
        UPG(g1, jb + 8);  UPL(g1, jb + 40);
        UPG(g2, jb + 16); UPL(g2, jb + 48);
        UPG(g3, jb + 24); UPL(g3, jb + 56);
    }
    UPG(g0, 96); UPG(g1, 104); UPG(g2, 112); UPG(g3, 120);
#undef UPG
#undef UPL
    const float cb = 7.5f * (hh ? qod : qev), cbp = 7.5f * (hh ? qev : qod);
    float tot[16];
#pragma unroll
    for (int i = 0; i < 16; ++i) {
        const float mine = (float)(hh ? acc[16 + i] : acc[i]) - cb;
        const float snd = (float)(hh ? acc[i] : acc[16 + i]);
        tot[i] = (mine + (xor32_get(snd, hh) - cbp)) * cstep;
    }
    float xv[16];
#pragma unroll
    for (int i = 0; i < 4; ++i) { xv[2 * i] = bf_lo(xa[i]); xv[2 * i + 1] = bf_hi(xa[i]); xv[8 + 2 * i] = bf_lo(xb[i]); xv[8 + 2 * i + 1] = bf_hi(xb[i]); }
    f32x4 x2[4]; float ss = 0.f;
#pragma unroll
    for (int i = 0; i < 4; ++i) {
        const f32x4 g = gt2[i];
#pragma unroll
        for (int e = 0; e < 4; ++e) { const float y = xv[4 * i + e] + g[e] * tot[4 * i + e]; x2[i][e] = y; ss += y * y; }
    }
    const float inv = rsqrtf(wave_sum(ss) * (1.f / D) + EPS);
#pragma unroll
    for (int i = 0; i < 4; ++i) {
        *(f32x4*)(outbuf + (size_t)t * D + col + 4 * i) = x2[i] * inv * gfin[i];
    }
}
template <int MODE = 0>
__device__ __forceinline__ void peer_up_pass(const P& p, char* smem, int bid, int nblk, float* outbuf) {
    const int tid = tidx(), lane = tid & 63, wid = tid >> 6;
    stage_scales((const float*)(p.ws + WS_RSU), smem);
    const int col = 32 * (lane & 31) + 16 * (lane >> 5);
    f32x4 gfin[4], gt2[4];
#pragma unroll
    for (int i = 0; i < 4; ++i) gfin[i] = *(const f32x4*)(p.g_final + col + 4 * i);
    int bcur = -1;
    const int t0 = bid * NWAVE + wid, tstep = nblk * NWAVE;
    UpIn uin;
    if (t0 < T) up_in_load(uin, p, t0, lane);
    for (int t = t0; t < T; t += tstep) {
        const int b = t >> 13;
        if (b != bcur) {
            bcur = b;
#pragma unroll
            for (int i = 0; i < 4; ++i) gt2[i] = *(const f32x4*)((const float*)(p.ws + WS_MOD) + b * NMOD + 5120 + col + 4 * i);
        }
        peer_up_tok<MODE>(p, (const float*)smem, uin, t, t + tstep, lane, outbuf, gt2, gfin);
    }
}

#define XB_TMO      128
#define XB_XCNT(j)  (256  + 64 * (j))
#define XB_XSUB(j)  (1280 + 64 * (j))
#define XB_XGEN(j)  (2304 + 64 * (j))
#define XB_TOP      3328
#define XB_TOPGEN   3392
#define XCD_BAR_WORDS 3456
#define XB_SPIN_CAP (1u << 18)
__device__ __forceinline__ unsigned xb_ld(unsigned* p)              { return __hip_atomic_load(p, __ATOMIC_RELAXED, __HIP_MEMORY_SCOPE_AGENT); }
__device__ __forceinline__ unsigned xb_add(unsigned* p, unsigned v) { return __hip_atomic_fetch_add(p, v, __ATOMIC_RELAXED, __HIP_MEMORY_SCOPE_AGENT); }
__device__ __forceinline__ unsigned xb_xcc_id() { return (unsigned)__builtin_amdgcn_s_getreg((3 << 11) | 20) & 0xFu; }
#define XB_SPIN(cond, bar) do { unsigned _sp = 0; while (cond) { __builtin_amdgcn_s_sleep(1); \
    if ((++_sp & 255u) == 0u) { if (xb_ld(&(bar)[XB_TMO])) break; if (_sp > XB_SPIN_CAP) { atomicAdd(&(bar)[XB_TMO], 1u); break; } } } } while (0)
struct XcdBarrier { unsigned* bar; unsigned x; volatile unsigned* st; };
__device__ __forceinline__ XcdBarrier xcd_barrier_post(unsigned* bar, volatile unsigned* st) {
    XcdBarrier b; b.bar = bar; b.x = xb_xcc_id(); b.st = st;
    if (threadIdx.x == 0) (void)xb_add(&bar[XB_XCNT(b.x)], 1u);
    return b;
}
__device__ __forceinline__ void xcd_barrier_complete(unsigned* bar, unsigned x, unsigned& nloc, unsigned& nx) {
    const unsigned G = gridDim.x * gridDim.y * gridDim.z;
    unsigned sum, cnt, mine, sp = 0u;
    for (;;) {
        sum = 0u; cnt = 0u; mine = 0u;
#pragma unroll
        for (unsigned j = 0; j < 16; ++j) { const unsigned c = xb_ld(&bar[XB_XCNT(j)]); sum += c; cnt += (c > 0u) ? 1u : 0u; mine = (j == x) ? c : mine; }
        if (sum == G) break;
        __builtin_amdgcn_s_sleep(1);
        if ((++sp & 255u) == 0u) { if (xb_ld(&bar[XB_TMO])) break; if (sp > XB_SPIN_CAP) { atomicAdd(&bar[XB_TMO], 1u); break; } }
    }
    nloc = mine > 0u ? mine : 1u; nx = cnt > 0u ? cnt : 1u;
}
__device__ __forceinline__ void xcd_barrier(const XcdBarrier& b) {
    asm volatile("s_waitcnt vmcnt(0)" ::: "memory");
    __syncthreads();
    if (threadIdx.x == 0) {
        unsigned* bar = b.bar;
        __builtin_amdgcn_s_waitcnt(0);
        unsigned nloc = b.st[0], nx = b.st[1];
        if (nloc == 0u) { xcd_barrier_complete(bar, b.x, nloc, nx); b.st[0] = nloc; b.st[1] = nx; }
        const unsigned old = xb_add(&bar[XB_XSUB(b.x)], 1u);
        const unsigned gen = old / nloc;
        if (old + 1u == (gen + 1u) * nloc) {
            __builtin_amdgcn_fence(__ATOMIC_RELEASE, "agent");
            asm volatile("s_waitcnt vmcnt(0)" ::: "memory");
            const unsigned og = xb_add(&bar[XB_TOP], 1u);
            const unsigned tg = og / nx;
            if (og + 1u == (tg + 1u) * nx) xb_add(&bar[XB_TOPGEN], 1u);
            else XB_SPIN(xb_ld(&bar[XB_TOPGEN]) == tg, bar);
            __builtin_amdgcn_fence(__ATOMIC_ACQUIRE, "agent");
            xb_add(&bar[XB_XGEN(b.x)], 1u);
            asm volatile("s_waitcnt vmcnt(0)" ::: "memory");
        } else {
            XB_SPIN(xb_ld(&bar[XB_XGEN(b.x)]) == gen, bar);
            __builtin_amdgcn_fence(__ATOMIC_ACQUIRE, "agent");
            asm volatile("s_waitcnt vmcnt(0)" ::: "memory");
        }
    }
    __syncthreads();
}

__global__ void __launch_bounds__(NTHR, 2) mega_kernel(P p) {
    extern __shared__ __attribute__((aligned(16))) char smem[];
    const int bid = blockIdx.x, nblk = gridDim.x;
    volatile unsigned* st = (volatile unsigned*)(smem + STAGE_LDS);
    if (threadIdx.x < 16) st[threadIdx.x] = 0u;
    __syncthreads();
    const XcdBarrier bar = xcd_barrier_post((unsigned*)(p.ws + WS_BAR), st);
    p0_mod(p, smem, bid, nblk);
    xcd_barrier(bar);
    p0_convert(p, smem, bid, nblk);
    p1_norm1(p, smem, bid, nblk);
#if PROBE_DUP == 1
    __syncthreads(); p1_norm1(p, smem, bid, nblk);
#endif
#if PROBE_DUP == 0
    __syncthreads(); p0_convert(p, smem, bid, nblk);
#endif
    xcd_barrier(bar);
    gemm_proj(p, smem);
#if PROBE_DUP == 2
    gemm_proj(p, smem);
#endif
    xcd_barrier(bar);
    attn_phase(p, smem, bid, nblk);
#if PROBE_DUP == 3
    attn_phase(p, smem, bid, nblk, 1);
#endif
#if PROBE_DUP == 33
    attn_phase<1>(p, smem, bid, nblk, 1);
#endif
    xcd_barrier(bar);
    gemm_out(p, smem);
#if PROBE_DUP == 4
    gemm_out(p, smem);
#endif
    xcd_barrier(bar);
    p5_norm2(p, bid, nblk);
#if PROBE_DUP == 5
    p5_norm2(p, bid, nblk);
#endif
    xcd_barrier(bar);
    gemm_query(p, smem);
#if PROBE_DUP == 6
    gemm_query(p, smem);
#endif
    xcd_barrier(bar);
    topk_phase(p, smem, bid, nblk);
#if PROBE_DUP == 7
    topk_phase(p, smem, bid, nblk);
#endif
    xcd_barrier(bar);
#if PROBE_DUP == 8
    peer_down_pass(p, smem, bid, nblk);
#endif
#if PROBE_DUP == 9
    peer_down_pass(p, smem, bid, nblk); xcd_barrier(bar);
    peer_up_pass(p, smem, bid, nblk, (float*)(p.ws + WS_QF));
#endif
#if PROBE_DUP == 13
    peer_down_pass<1>(p, smem, bid, nblk);
#endif
#if PROBE_DUP == 14
    peer_down_pass<2>(p, smem, bid, nblk);
#endif
#if PROBE_DUP == 15
    peer_down_pass<3>(p, smem, bid, nblk);
#endif
#if PROBE_DUP == 16
    peer_down_pass<0>(p, smem, bid, nblk);
#endif
    peer_down_pass(p, smem, bid, nblk);
    xcd_barrier(bar);
#if PROBE_DUP == 10
    peer_up_pass<0>(p, smem, bid, nblk, p.out); __syncthreads();
#endif
#if PROBE_DUP == 11
    peer_up_pass<1>(p, smem, bid, nblk, p.out); __syncthreads();
#endif
#if PROBE_DUP == 12
    peer_up_pass<2>(p, smem, bid, nblk, p.out); __syncthreads();
#endif
    peer_up_pass(p, smem, bid, nblk, p.out);
}

extern "C" void kernel_launch(void* const* d_in, const int* in_sizes, int n_in, void* d_out, int out_size, void* d_ws, size_t ws_size, hipStream_t stream) {
    if (n_in != 16 || out_size != T * D || ws_size < WS_END) { fprintf(stderr, "kernel_launch: unexpected shapes (n_in %d out %d ws %zu)\n", n_in, out_size, ws_size); return; }
    P p{};
    p.x = (const float*)d_in[0]; p.c = (const float*)d_in[1]; p.w_ada = (const float*)d_in[2]; p.b_ada = (const float*)d_in[3];
    p.g_mix = (const float*)d_in[4]; p.w_in = (const float*)d_in[5]; p.b_forget = (const float*)d_in[6]; p.g_fox = (const float*)d_in[7];
    p.g_sb = (const float*)d_in[8]; p.w_out = (const float*)d_in[9]; p.g_ffn = (const float*)d_in[10]; p.w_query = (const float*)d_in[11];
    p.sub_keys = (const float*)d_in[12]; p.e_down = (const float*)d_in[13]; p.e_up = (const float*)d_in[14]; p.g_final = (const float*)d_in[15];
    p.out = (float*)d_out; p.ws = (unsigned char*)d_ws;
    (void)hipMemsetAsync((char*)d_ws + WS_KMAX, 0, 24 * 1024, stream);
    static int grid_blocks = 0;
    if (!grid_blocks) {
        int dev = 0, cus = 0, per_cu = 0;
        (void)hipGetDevice(&dev);
        (void)hipDeviceGetAttribute(&cus, hipDeviceAttributeMultiprocessorCount, dev);
        (void)hipFuncSetAttribute((const void*)mega_kernel, hipFuncAttributeMaxDynamicSharedMemorySize, LDS_BYTES);
        (void)hipOccupancyMaxActiveBlocksPerMultiprocessor(&per_cu, mega_kernel, NTHR, LDS_BYTES);
        if (per_cu > 1) per_cu = 1;
        grid_blocks = cus * per_cu;
        if (grid_blocks % 8) grid_blocks -= grid_blocks % 8;
    }
    void* args[] = {&p};
    hipError_t e = hipLaunchCooperativeKernel((void*)mega_kernel, dim3(grid_blocks), dim3(NTHR), args, LDS_BYTES, stream);
    if (e != hipSuccess) fprintf(stderr, "cooperative launch failed: %s (grid %d)\n", hipGetErrorString(e), grid_blocks);
}
```

```cpp
#include <hip/hip_runtime.h>
#include <hip/hip_cooperative_groups.h>
#include <cstdio>
#include <cstdint>
namespace cg = cooperative_groups;

#ifndef PROBE_DUP
#define PROBE_DUP -1
#endif

namespace pg8 {
#define PG8_LAS __attribute__((address_space(3)))
typedef unsigned short bf16_t;
typedef short bf16x8 __attribute__((ext_vector_type(8)));
typedef float f32x4 __attribute__((ext_vector_type(4)));
typedef unsigned u32x4 __attribute__((ext_vector_type(4)));
constexpr int BM = 256, BK = 64, HALF = 128, HTB = HALF * BK * 2  , STAGE_BYTES = 8 * HTB, NXCD = 8, WGM = 8;

__host__ __device__ __forceinline__ int lds_byte(int r, int c) { const int st = (r >> 4) * 2 + (c >> 5), rr = r & 15, cc = c & 31, ob = rr * 64 + cc * 2; return st * 1024 + (ob ^ (((ob >> 9) & 1) << 5)); }
__host__ __device__ __forceinline__ void stage_rc(int b, int& R, int& C) { const int st = b / 1024, sb = b % 1024, swz = sb ^ (((sb >> 9) & 1) << 5); R = (st >> 1) * 16 + swz / 64; C = (st & 1) * 32 + (swz % 64) / 2; }
__host__ __device__ __forceinline__ int perm32(int rho) { const int n = rho >> 4, i = rho & 15; return 8 * (i >> 2) + 4 * n + (i & 3); }

struct Unit { int pm, pn; };
struct Gemm { const bf16_t* A; const bf16_t* Bt; int M, N, K; };

struct StaticOrder {
    int nM, nN, nwg, G, c;
    __host__ __device__ void init(int M, int N, int G_, int c_) { nM = M / BM; nN = N / BM; nwg = nM * nN; G = G_; c = c_; }
    __host__ __device__ bool next(int i, Unit& u) const {
        const long L = (long)i * G + c; if (L >= nwg) return false;
        int wgid = (int)L; { const int q = nwg / NXCD, r = nwg % NXCD, xcd = wgid % NXCD, off = wgid / NXCD; wgid = (xcd < r ? xcd * (q + 1) : r * (q + 1) + (xcd - r) * q) + off; }
        const int nig = WGM * nN, gid = wgid / nig, fm = gid * WGM, gsz = (nM - fm) < WGM ? (nM - fm) : WGM;
        u.pm = fm + ((wgid % nig) % gsz); u.pn = (wgid % nig) / gsz; return true;
    }
    __device__ __forceinline__ void a_ready(const Unit&) const {}
    __device__ __forceinline__ void done(const Unit&) const {}
};
template <class Epi, class Sched, bool ALIGN_EPI = false, bool SP2 = false>
__device__ __forceinline__ void gemm_phase(PG8_LAS unsigned char* lds, const Gemm g, const Sched& S, const Epi& E) {
    int tid = threadIdx.x; asm volatile("" : "+v"(tid));
    const int wid = __builtin_amdgcn_readfirstlane(tid >> 6), lane = tid & 63, wr = wid >> 2, wc = wid & 3, fr = lane & 15, fq = lane >> 4;
    const int K = g.K, nt = K / BK;
    unsigned voffA[2], voffB[2];
#pragma unroll
    for (int i = 0; i < 2; ++i) { int R, C; stage_rc(tid * 16 + i * 8192, R, C); const int Rb = Epi::PERM ? ((R & ~31) + perm32(R & 31)) : R;
        voffA[i] = (unsigned)(R * K + C) * 2u; voffB[i] = (unsigned)(Rb * K + C) * 2u; }
    const size_t kstep = (size_t)(BK * 2);
    const size_t hstep = (size_t)HALF * K * 2;
    const size_t tstep = 2 * hstep;
    const unsigned ldsw = (unsigned)wid * 1024u;
    const int aoff = lds_byte(wr * 64 + fr, fq * 8), boff = lds_byte(wc * 32 + fr, fq * 8);
#define PG8_SA(b, h) (((b) * 2 + (h)) * HTB)
#define PG8_SB(b, h) ((4 + (b) * 2 + (h)) * HTB)
#define PG8_STAGE(bufoff, gbase, voff) do { _Pragma("unroll") for (int _i = 0; _i < 2; ++_i) \
        __builtin_amdgcn_global_load_lds((const unsigned*)((const char*)(gbase) + (voff)[_i]), (PG8_LAS unsigned*)(lds + (bufoff) + ldsw + _i * 8192), 16, 0, 0); } while (0)
#define PG8_LDA(dst, b, h) do { _Pragma("unroll") for (int m = 0; m < 4; ++m) _Pragma("unroll") for (int k = 0; k < 2; ++k) dst[m][k] = *(const PG8_LAS bf16x8*)(lds + PG8_SA(b, h) + aoff + m * 2048 + k * 1024); } while (0)
#define PG8_LDB(dst, b, h) do { _Pragma("unroll") for (int n = 0; n < 2; ++n) _Pragma("unroll") for (int k = 0; k < 2; ++k) dst[n][k] = *(const PG8_LAS bf16x8*)(lds + PG8_SB(b, h) + boff + n * 2048 + k * 1024); } while (0)
#define PG8_MMA(ai, bj, At, Bt) do { __builtin_amdgcn_s_setprio(1); _Pragma("unroll") for (int m = 0; m < 4; ++m) _Pragma("unroll") for (int n = 0; n < 2; ++n) _Pragma("unroll") for (int k = 0; k < 2; ++k) \
        acc[ai][bj][m][n] = __builtin_amdgcn_mfma_f32_16x16x32_bf16(Bt[n][k], At[m][k], acc[ai][bj][m][n], 0, 0, 0); __builtin_amdgcn_s_setprio(0); } while (0)
#define PG8_WAIT_V(n) asm volatile("s_waitcnt vmcnt(" #n ")" ::: "memory")
#define PG8_WAIT_L(n) asm volatile("s_waitcnt lgkmcnt(" #n ")" ::: "memory")
#define PG8_BAR __builtin_amdgcn_s_barrier()
#define PG8_SCHED __builtin_amdgcn_sched_barrier(0)
    Unit cur, nxt; int ui = 0;
    if (!S.next(0, cur)) return;
    f32x4 acc[2][2][4][2];
#pragma unroll
    for (int a = 0; a < 2; ++a)
#pragma unroll
        for (int b = 0; b < 2; ++b)
#pragma unroll
            for (int m = 0; m < 4; ++m)
#pragma unroll
                for (int n = 0; n < 2; ++n) acc[a][b][m][n] = (f32x4){0.f, 0.f, 0.f, 0.f};
    bf16x8 At[4][2], B0[2][2], B1[2][2];
    const char* cA = (const char*)g.A + (size_t)cur.pm * tstep; const char* cB = (const char*)g.Bt + (size_t)cur.pn * tstep;
    S.a_ready(cur);
    if constexpr (SP2) {
        PG8_STAGE(PG8_SB(0, 0), cB, voffB); PG8_STAGE(PG8_SB(0, 1), cB + hstep, voffB); PG8_STAGE(PG8_SA(0, 0), cA, voffA); PG8_STAGE(PG8_SA(0, 1), cA + hstep, voffA);
        if (wr == 1) PG8_BAR;
        PG8_WAIT_V(2); PG8_BAR;
        PG8_STAGE(PG8_SB(1, 0), cB + kstep, voffB); PG8_STAGE(PG8_SA(1, 0), cA + kstep, voffA); PG8_STAGE(PG8_SB(1, 1), cB + hstep + kstep, voffB);
        PG8_WAIT_V(6); PG8_BAR;
    } else {
        PG8_STAGE(PG8_SB(0, 0), cB, voffB); PG8_STAGE(PG8_SA(0, 0), cA, voffA); PG8_STAGE(PG8_SB(0, 1), cB + hstep, voffB); PG8_STAGE(PG8_SA(0, 1), cA + hstep, voffA);
        if (wr == 1) PG8_BAR;
        PG8_WAIT_V(4); PG8_BAR;
        PG8_STAGE(PG8_SB(1, 0), cB + kstep, voffB); PG8_STAGE(PG8_SA(1, 0), cA + kstep, voffA); PG8_STAGE(PG8_SB(1, 1), cB + hstep + kstep, voffB);
        PG8_WAIT_V(6); PG8_BAR;
    }
    for (;;) {
        const bool has_next = S.next(ui + 1, nxt);
        const char* nA = has_next ? (const char*)g.A + (size_t)nxt.pm * tstep : cA; const char* nB = has_next ? (const char*)g.Bt + (size_t)nxt.pn * tstep : cB;
        for (int t = 0; t < nt; t += 2) {
            const bool last = (t == nt - 2);
            const char* a1 = cA + (size_t)(t + 1) * kstep;
            const char* a2 = last ? nA : cA + (size_t)(t + 2) * kstep; const char* b2 = last ? nB : cB + (size_t)(t + 2) * kstep;
            const char* a3 = a2 + kstep; const char* b3 = b2 + kstep;
            if (last && has_next) S.a_ready(nxt);
            if constexpr (SP2) {
            PG8_LDB(B0, 0, 0); PG8_LDB(B1, 0, 1); PG8_SCHED; PG8_LDA(At, 0, 0); PG8_STAGE(PG8_SA(1, 1), a1 + hstep, voffA);
            PG8_WAIT_V(8); PG8_WAIT_L(0); PG8_BAR; PG8_MMA(0, 0, At, B0); PG8_MMA(0, 1, At, B1); PG8_BAR; PG8_SCHED;
            PG8_LDA(At, 0, 1); PG8_STAGE(PG8_SB(0, 0), b2, voffB); PG8_STAGE(PG8_SB(0, 1), b2 + hstep, voffB); PG8_STAGE(PG8_SA(0, 0), a2, voffA);
            PG8_WAIT_V(8); PG8_WAIT_L(0); PG8_BAR; PG8_MMA(1, 0, At, B0); PG8_MMA(1, 1, At, B1); PG8_BAR; PG8_SCHED;
            PG8_LDB(B0, 1, 0); PG8_LDB(B1, 1, 1); PG8_SCHED; PG8_LDA(At, 1, 0); PG8_STAGE(PG8_SA(0, 1), a2 + hstep, voffA);
            PG8_WAIT_V(8); PG8_WAIT_L(0); PG8_BAR; PG8_MMA(0, 0, At, B0); PG8_MMA(0, 1, At, B1); PG8_BAR; PG8_SCHED;
            PG8_LDA(At, 1, 1); PG8_STAGE(PG8_SB(1, 0), b3, voffB); PG8_STAGE(PG8_SB(1, 1), b3 + hstep, voffB); PG8_STAGE(PG8_SA(1, 0), a3, voffA);
            PG8_WAIT_V(8); PG8_WAIT_L(0); PG8_BAR; PG8_MMA(1, 0, At, B0); PG8_MMA(1, 1, At, B1); PG8_BAR; PG8_SCHED;
            } else {
            PG8_LDB(B0, 0, 0); PG8_SCHED; PG8_LDA(At, 0, 0); PG8_STAGE(PG8_SA(1, 1), a1 + hstep, voffA);
            PG8_WAIT_L(8); PG8_BAR; PG8_WAIT_L(0); PG8_MMA(0, 0, At, B0); PG8_BAR; PG8_SCHED;
            PG8_LDB(B1, 0, 1); PG8_STAGE(PG8_SB(0, 0), b2, voffB);
            PG8_BAR; PG8_WAIT_L(0); PG8_MMA(0, 1, At, B1); PG8_BAR;
            PG8_LDA(At, 0, 1); PG8_STAGE(PG8_SA(0, 0), a2, voffA);
            PG8_BAR; PG8_WAIT_L(0); PG8_MMA(1, 0, At, B0); PG8_BAR; PG8_SCHED;
            PG8_STAGE(PG8_SB(0, 1), b2 + hstep, voffB);
            PG8_WAIT_V(6); PG8_BAR; PG8_MMA(1, 1, At, B1); PG8_BAR;
            PG8_LDB(B0, 1, 0); PG8_SCHED; PG8_LDA(At, 1, 0); PG8_STAGE(PG8_SA(0, 1), a2 + hstep, voffA);
            PG8_WAIT_L(8); PG8_BAR; PG8_WAIT_L(0); PG8_MMA(0, 0, At, B0); PG8_BAR; PG8_SCHED;
            PG8_LDB(B1, 1, 1); PG8_STAGE(PG8_SB(1, 0), b3, voffB);
            PG8_BAR; PG8_WAIT_L(0); PG8_MMA(0, 1, At, B1); PG8_BAR;
            PG8_LDA(At, 1, 1); PG8_STAGE(PG8_SA(1, 0), a3, voffA);
            PG8_BAR; PG8_WAIT_L(0); PG8_MMA(1, 0, At, B0); PG8_BAR; PG8_SCHED;
            PG8_STAGE(PG8_SB(1, 1), b3 + hstep, voffB);
            PG8_WAIT_V(6); PG8_BAR; PG8_MMA(1, 1, At, B1); PG8_BAR;
            }
        }
        if constexpr (ALIGN_EPI) { if (wr == 0) PG8_BAR; }
        if constexpr (!Epi::AFTER_DRAIN) { E(acc, cur, wr, wc, fr, fq); S.done(cur); }
        if (!has_next) break;
#pragma unroll
        for (int a = 0; a < 2; ++a)
#pragma unroll
            for (int b = 0; b < 2; ++b)
#pragma unroll
                for (int m = 0; m < 4; ++m)
#pragma unroll
                    for (int n = 0; n < 2; ++n) acc[a][b][m][n] = (f32x4){0.f, 0.f, 0.f, 0.f};
        cur = nxt; cA = nA; cB = nB; ++ui;
        if constexpr (ALIGN_EPI) { if (wr == 1) PG8_BAR; }
    }
    PG8_WAIT_V(0);
    if constexpr (!ALIGN_EPI) { if (wr == 0) PG8_BAR; }
    PG8_BAR;
    if constexpr (Epi::AFTER_DRAIN) { E.fused(acc, cur, wr, wc, fr, fq, lds, wid, lane); S.done(cur); }
#undef PG8_SA
#undef PG8_SB
#undef PG8_STAGE
#undef PG8_LDA
#undef PG8_LDB
#undef PG8_MMA
#undef PG8_WAIT_V
#undef PG8_WAIT_L
#undef PG8_BAR
#undef PG8_SCHED
}
}
typedef unsigned short bf16_t;
typedef short bf16x8 __attribute__((ext_vector_type(8)));
typedef float f32x16 __attribute__((ext_vector_type(16)));
typedef float f32x4 __attribute__((ext_vector_type(4)));
typedef unsigned u32x4 __attribute__((ext_vector_type(4)));
typedef unsigned u32x2 __attribute__((ext_vector_type(2)));

constexpr int D = 1024, NBATCH = 4, SEQ = 8192, T = NBATCH * SEQ;
constexpr int NH = 8, HD = 64, INC = 3080, NMOD = 6144;
constexpr float EPS = 1e-6f, ATT_SCALE = 0.125f, THRESH = 105.0f, LOG2E = 1.4426950408889634f;
constexpr float SC2 = ATT_SCALE * LOG2E, THRESH2 = THRESH * LOG2E;

constexpr size_t MiB = 1u << 20;
constexpr size_t WS_MOD = 0, WS_KMAX = 128 * 1024, WS_BAR = 136 * 1024, WS_CTOT = 192 * 1024, WS_FLOC = 1 * MiB;
constexpr size_t WS_WQK = 2 * MiB, WS_WV = 6 * MiB, WS_WOUT = 8 * MiB, WS_WQ = 10 * MiB, WS_SK = 14 * MiB, WS_ED = 16 * MiB, WS_EU = 48 * MiB;
constexpr size_t WS_RSD = 15 * MiB, WS_RSU = 15 * MiB + 64 * 1024;
constexpr size_t WS_H = 80 * MiB, WS_QF = 144 * MiB;
constexpr size_t WS_MIX = 336 * MiB, WS_EXP = 400 * MiB, WS_GATE = 416 * MiB, WS_END = 432 * MiB;
constexpr size_t WS_X1 = 272 * MiB;
constexpr size_t WS_ACT = 144 * MiB;
constexpr size_t WS_QUERY = 144 * MiB;

struct P {
    const float *x, *c, *w_ada, *b_ada, *g_mix, *w_in, *b_forget, *g_fox, *g_sb, *w_out, *g_ffn, *w_query, *sub_keys, *e_down, *e_up, *g_final;
    float* out;
    unsigned char* ws;
};

constexpr int NWAVE = 8, NTHR = NWAVE * 64;
constexpr int STAGE_LDS = 131072;
constexpr int LDS_BYTES = 147456;

typedef __bf16 bf16v2 __attribute__((ext_vector_type(2)));
__device__ __forceinline__ unsigned cvt_pk_bf16(float lo, float hi) { bf16v2 v; v.x = (__bf16)lo; v.y = (__bf16)hi; return __builtin_bit_cast(unsigned, v); }
__device__ __forceinline__ float bf_lo(unsigned w) { return __uint_as_float(w << 16); }
__device__ __forceinline__ float bf_hi(unsigned w) { return __uint_as_float(w & 0xffff0000u); }
__device__ __forceinline__ float bf2f(bf16_t h) { return __uint_as_float(((unsigned)h) << 16); }
__device__ __forceinline__ int tidx() { int t = threadIdx.x; asm volatile("" : "+v"(t)); return t; }
template <int CTRL> __device__ __forceinline__ float dpp_f(float x) { return __builtin_bit_cast(float, __builtin_amdgcn_mov_dpp(__builtin_bit_cast(int, x), CTRL, 0xf, 0xf, true)); }
__device__ __forceinline__ float wave_sum(float v) {
    v += dpp_f<0xB1>(v); v += dpp_f<0x4E>(v); v += dpp_f<0x141>(v); v += dpp_f<0x128>(v);
    auto s = __builtin_amdgcn_permlane16_swap(__float_as_uint(v), __float_as_uint(v), false, false);
    v = __uint_as_float(s[0]) + __uint_as_float(s[1]);
    auto t = __builtin_amdgcn_permlane32_swap(__float_as_uint(v), __float_as_uint(v), false, false);
    return __uint_as_float(t[0]) + __uint_as_float(t[1]);
}
__device__ __forceinline__ float wave_max(float v) {
    v = fmaxf(v, dpp_f<0xB1>(v)); v = fmaxf(v, dpp_f<0x4E>(v)); v = fmaxf(v, dpp_f<0x141>(v)); v = fmaxf(v, dpp_f<0x128>(v));
    auto s = __builtin_amdgcn_permlane16_swap(__float_as_uint(v), __float_as_uint(v), false, false);
    v = fmaxf(__uint_as_float(s[0]), __uint_as_float(s[1]));
    auto t = __builtin_amdgcn_permlane32_swap(__float_as_uint(v), __float_as_uint(v), false, false);
    return fmaxf(__uint_as_float(t[0]), __uint_as_float(t[1]));
}
__device__ __forceinline__ float xor32_sum(float v) { auto rr = __builtin_amdgcn_permlane32_swap(__float_as_uint(v), __float_as_uint(v), false, false); return __uint_as_float(rr[0]) + __uint_as_float(rr[1]); }
__device__ __forceinline__ float xor32_max(float v) { auto rr = __builtin_amdgcn_permlane32_swap(__float_as_uint(v), __float_as_uint(v), false, false); return fmaxf(__uint_as_float(rr[0]), __uint_as_float(rr[1])); }
__device__ __forceinline__ float xor32_get(float v, int hh) { auto rr = __builtin_amdgcn_permlane32_swap(__float_as_uint(v), __float_as_uint(v), false, false); return __uint_as_float(hh ? rr[0] : rr[1]); }
__device__ __forceinline__ float log_sigmoid(float x) { return fminf(x, 0.f) - log1pf(__expf(-fabsf(x))); }
__device__ __forceinline__ void p0_transpose_item(const float* W, int K, int N, int n0src, bf16_t* WT, int row0, int k0, float* scr, int lane) {
#pragma unroll 8
    for (int i = 0; i < 32; ++i) { const int kk = 2 * i + (lane >> 5); scr[kk * 33 + (lane & 31)] = W[(size_t)(k0 + kk) * N + n0src + (lane & 31)]; }
    asm volatile("s_waitcnt lgkmcnt(0)" ::: "memory");
    asm volatile("" ::: "memory");
    const int c = lane & 7;
#pragma unroll
    for (int j = 0; j < 4; ++j) {
        const int n = (lane >> 3) + 8 * j; const float* s = scr + (8 * c) * 33 + n;
        u32x4 o; o.x = cvt_pk_bf16(s[0 * 33], s[1 * 33]); o.y = cvt_pk_bf16(s[2 * 33], s[3 * 33]); o.z = cvt_pk_bf16(s[4 * 33], s[5 * 33]); o.w = cvt_pk_bf16(s[6 * 33], s[7 * 33]);
        *(u32x4*)(WT + (size_t)(row0 + n) * K + k0 + 8 * c) = o;
    }
    asm volatile("s_waitcnt lgkmcnt(0)" ::: "memory");
    asm volatile("" ::: "memory");
}

__device__ __forceinline__ void cvt_stream(const float* src, bf16_t* dst, size_t n8, size_t gtid, size_t gthreads) {
    for (size_t i = gtid; i < n8; i += gthreads) {
        const f32x4 a = *(const f32x4*)(src + i * 8), b = *(const f32x4*)(src + i * 8 + 4);
        u32x4 o; o.x = cvt_pk_bf16(a.x, a.y); o.y = cvt_pk_bf16(a.z, a.w); o.z = cvt_pk_bf16(b.x, b.y); o.w = cvt_pk_bf16(b.z, b.w);
        *(u32x4*)(dst + i * 8) = o;
    }
}

typedef float f32x2 __attribute__((ext_vector_type(2)));
__device__ __forceinline__ void cvt_row_fp8(const float* src, unsigned char* dst, float* rscale, int row, int lane) {
    const f32x4* s = (const f32x4*)(src + (size_t)row * 1024 + lane * 16);
    f32x4 v[4]; float mx = 0.f;
#pragma unroll
    for (int i = 0; i < 4; ++i) { v[i] = s[i]; mx = fmaxf(mx, fmaxf(fmaxf(fabsf(v[i].x), fabsf(v[i].y)), fmaxf(fabsf(v[i].z), fabsf(v[i].w)))); }
    mx = wave_max(mx);
    const float sc = mx > 0.f ? 224.f / mx : 1.f;
    u32x4 o;
#pragma unroll
    for (int i = 0; i < 4; ++i) {
        int w = 0;
        w = __builtin_amdgcn_cvt_pk_fp8_f32(v[i].x * sc, v[i].y * sc, w, false);
        w = __builtin_amdgcn_cvt_pk_fp8_f32(v[i].z * sc, v[i].w * sc, w, true);
        o[i] = (unsigned)w;
    }
    *(u32x4*)(dst + (size_t)row * 1024 + lane * 16) = o;
    if (lane == 0) rscale[row] = mx > 0.f ? mx * (1.f / 224.f) : 1.f;
}

__device__ __forceinline__ unsigned pack_i8x4(float a, float b, float c, float d) {
    const int ia = (int)__builtin_rintf(a), ib = (int)__builtin_rintf(b), ic = (int)__builtin_rintf(c), id = (int)__builtin_rintf(d);
    return (unsigned)(ia & 0xff) | ((unsigned)(ib & 0xff) << 8) | ((unsigned)(ic & 0xff) << 16) | ((unsigned)id << 24);
}
__device__ __forceinline__ void cvt_row_i8(const float* src, unsigned char* dst, float* rscale, int row, int lane) {
    const f32x4* s = (const f32x4*)(src + (size_t)row * 1024 + lane * 16);
    f32x4 v[4]; float mx = 0.f;
#pragma unroll
    for (int i = 0; i < 4; ++i) { v[i] = s[i]; mx = fmaxf(mx, fmaxf(fmaxf(fabsf(v[i].x), fabsf(v[i].y)), fmaxf(fabsf(v[i].z), fabsf(v[i].w)))); }
    mx = wave_max(mx);
    const float sc = mx > 0.f ? 127.f / mx : 1.f;
    u32x4 o;
#pragma unroll
    for (int i = 0; i < 4; ++i) o[i] = pack_i8x4(v[i].x * sc, v[i].y * sc, v[i].z * sc, v[i].w * sc);
    *(u32x4*)(dst + (size_t)row * 1024 + lane * 16) = o;
    if (lane == 0) rscale[row] = mx > 0.f ? mx * (1.f / 127.f) : 1.f;
}
struct RowF32 { f32x4 v[4]; };
__device__ __forceinline__ void row_load(RowF32& r, const float* src, int row, int lane) {
    const f32x4* s = (const f32x4*)(src + (size_t)row * 1024 + lane * 16);
#pragma unroll
    for (int i = 0; i < 4; ++i) r.v[i] = s[i];
}
__device__ __forceinline__ void cvt_row_q4(const RowF32& r, unsigned char* dst, float* rscale, int row, int lane, unsigned flip) {
    const f32x4 (&v)[4] = r.v; float ss = 0.f;
#pragma unroll
    for (int i = 0; i < 4; ++i) ss += (v[i].x * v[i].x + v[i].y * v[i].y) + (v[i].z * v[i].z + v[i].w * v[i].w);
    ss = wave_sum(ss);
    const float step = ss > 0.f ? 0.3352f * sqrtf(ss * (1.f / 1024.f)) : 1e-30f, inv = 1.f / step;
    unsigned w[2] = {0u, 0u};
#pragma unroll
    for (int i = 0; i < 16; ++i) {
        int n = (int)floorf(v[i >> 2][i & 3] * inv) + 8;
        n = n < 0 ? 0 : (n > 15 ? 15 : n);
        w[i >> 3] |= (unsigned)n << (4 * (i & 7));
    }
    u32x2 o; o.x = w[0] ^ flip; o.y = w[1] ^ flip;
    *(u32x2*)(dst + (size_t)row * 512 + lane * 8) = o;
    if (lane == 0) rscale[row] = step;
}
__device__ __forceinline__ void p0_mod(const P& p, char* smem, int bid, int nblk) {
    const int tid = tidx(), lane = tid & 63, wid = tid >> 6;
    const int gw = bid * NWAVE + wid, NGW = nblk * NWAVE;
    float* sc = (float*)smem;
    for (int i = tid; i < 4096; i += NTHR) { const float v = p.c[i]; sc[i] = v / (1.f + __expf(-v)); }
    __syncthreads();
    float* mod = (float*)(p.ws + WS_MOD);
    for (int it = gw; it < 1536; it += NGW) {
        const int col = it * 4 + (lane & 3), ks = lane >> 2;
        float a0 = 0.f, a1 = 0.f, a2 = 0.f, a3 = 0.f;
        const float* w = p.w_ada + (size_t)(ks * 64) * NMOD + col;
#pragma unroll 16
        for (int k = 0; k < 64; ++k) {
            const float wv = w[(size_t)k * NMOD]; const int kk = ks * 64 + k;
            a0 += sc[kk] * wv; a1 += sc[1024 + kk] * wv; a2 += sc[2048 + kk] * wv; a3 += sc[3072 + kk] * wv;
        }
#pragma unroll
        for (int o = 4; o < 64; o <<= 1) { a0 += __shfl_xor(a0, o); a1 += __shfl_xor(a1, o); a2 += __shfl_xor(a2, o); a3 += __shfl_xor(a3, o); }
        if (ks == 0) { const float bb = p.b_ada[col]; mod[col] = a0 + bb; mod[NMOD + col] = a1 + bb; mod[2 * NMOD + col] = a2 + bb; mod[3 * NMOD + col] = a3 + bb; }
    }
}
__device__ __forceinline__ void p0_convert(const P& p, char* smem, int bid, int nblk) {
    const int tid = tidx(), lane = tid & 63, wid = tid >> 6;
    const int gw = bid * NWAVE + wid, NGW = nblk * NWAVE;
    float* scr = (float*)(smem + 40960 + wid * 8448);
    for (int it = gw; it < 3072; it += NGW) {
        if (it < 1536) {
            const int kb = it / 96, nb = it % 96, seg = nb >> 4, nn = (nb & 15) * 32;
            const int srccol = seg * 512 + nn + (seg >= 3 ? 8 : 0);
            bf16_t* dstw = (bf16_t*)(p.ws + ((seg == 2 || seg == 5) ? WS_WV : WS_WQK));
            const int drow = (seg == 2 ? 0 : seg == 5 ? 512 : seg == 0 ? 0 : seg == 1 ? 512 : seg == 3 ? 1024 : 1536) + nn;
            p0_transpose_item(p.w_in, D, INC, srccol, dstw, drow, kb * 64, scr, lane);
        }
        else if (it < 2048) { const int r = it - 1536, kb = r / 32, nb = r % 32; p0_transpose_item(p.w_out, D, D, nb * 32, (bf16_t*)(p.ws + WS_WOUT), nb * 32, kb * 64, scr, lane); }
        else { const int r = it - 2048, kb = r / 64, nb = r % 64; p0_transpose_item(p.w_query, D, 2048, nb * 32, (bf16_t*)(p.ws + WS_WQ), nb * 32, kb * 64, scr, lane); }
    }
    const size_t gtid = (size_t)bid * NTHR + tid, gth = (size_t)nblk * NTHR;
    cvt_stream(p.sub_keys, (bf16_t*)(p.ws + WS_SK), (size_t)8 * 2 * 128 * 128 / 8, gtid, gth);
}

__device__ __forceinline__ void p1_norm1(const P& p, char* smem, int bid, int nblk) {
    const int tid = tidx(), lane = tid & 63, wid = tid >> 6;
    float* wfs = (float*)smem;
    float* lf = (float*)(smem + 32768);
    const float* mod = (const float*)(p.ws + WS_MOD);
    bf16_t* hbuf = (bf16_t*)(p.ws + WS_H);
    float* Floc = (float*)(p.ws + WS_FLOC);
    float* ctot = (float*)(p.ws + WS_CTOT);
    for (int i = tid; i < 2048; i += NTHR) {
        const int d = i >> 1, hf = i & 1;
        const f32x4 w = *(const f32x4*)(p.w_in + (size_t)d * INC + 1536 + 4 * hf);
        wfs[(4 * hf + 0) * 1024 + d] = w.x; wfs[(4 * hf + 1) * 1024 + d] = w.y; wfs[(4 * hf + 2) * 1024 + d] = w.z; wfs[(4 * hf + 3) * 1024 + d] = w.w;
    }
    __syncthreads();
    for (int ch = bid; ch < T / 64; ch += nblk) {
        const int t0 = ch * 64, b = t0 >> 13;
        f32x4 Am[4], Bm[4];
#pragma unroll
        for (int j = 0; j < 4; ++j) {
            const f32x4 g = ((const f32x4*)p.g_mix)[lane + 64 * j];
            const f32x4 s = ((const f32x4*)(mod + b * NMOD + 1024))[lane + 64 * j];
            Am[j] = g * (s + 1.0f);
            Bm[j] = ((const f32x4*)(mod + b * NMOD))[lane + 64 * j];
        }
        const int up32 = lane & 32, up16 = lane & 16, up8 = lane & 8;
        const int kL = ((lane >> 5) & 1) * 4 + ((lane >> 4) & 1) * 2 + ((lane >> 3) & 1);
        const float bfk = p.b_forget[kL];
        f32x4 vn[4];
        {
            const f32x4* xr = (const f32x4*)(p.x + (size_t)(t0 + wid * (64 / NWAVE)) * D) + lane;
#pragma unroll
            for (int j = 0; j < 4; ++j) vn[j] = xr[64 * j];
        }
        for (int i = 0; i < 64 / NWAVE; ++i) {
            const int t = t0 + wid * (64 / NWAVE) + i;
            f32x4 v[4]; float ss = 0.f;
#pragma unroll
            for (int j = 0; j < 4; ++j) { v[j] = vn[j]; ss += v[j].x * v[j].x + v[j].y * v[j].y + v[j].z * v[j].z + v[j].w * v[j].w; }
            if (i + 1 < 64 / NWAVE) {
                const f32x4* xr = (const f32x4*)(p.x + (size_t)(t + 1) * D) + lane;
#pragma unroll
                for (int j = 0; j < 4; ++j) vn[j] = xr[64 * j];
            }
            const float inv = rsqrtf(wave_sum(ss) * (1.f / D) + EPS);
            u32x2* o8 = (u32x2*)(hbuf + (size_t)t * D) + lane;
            float fa[8];
#pragma unroll
            for (int c = 0; c < 8; ++c) fa[c] = 0.f;
#pragma unroll
            for (int j = 0; j < 4; ++j) {
                const f32x4 h = (v[j] * inv) * Am[j] + Bm[j];
                u32x2 w; w.x = cvt_pk_bf16(h.x, h.y); w.y = cvt_pk_bf16(h.z, h.w); o8[64 * j] = w;
#pragma unroll
                for (int c = 0; c < 8; ++c) { const f32x4 wv = ((const f32x4*)(wfs + c * 1024))[lane + 64 * j]; fa[c] += (wv.x * h.x + wv.y * h.y) + (wv.z * h.z + wv.w * h.w); }
            }
            float k4[4], k2[2];
#pragma unroll
            for (int q = 0; q < 4; ++q) { const float snd = up32 ? fa[q] : fa[q + 4]; k4[q] = (up32 ? fa[q + 4] : fa[q]) + __shfl_xor(snd, 32); }
#pragma unroll
            for (int q = 0; q < 2; ++q) { const float snd = up16 ? k4[q] : k4[q + 2]; k2[q] = (up16 ? k4[q + 2] : k4[q]) + __shfl_xor(snd, 16); }
            const float snd = up8 ? k2[0] : k2[1];
            float f = (up8 ? k2[1] : k2[0]) + __shfl_xor(snd, 8);
            f += __shfl_xor(f, 4); f += __shfl_xor(f, 2); f += __shfl_xor(f, 1);
            if ((lane & 7) == 0) lf[(wid * (64 / NWAVE) + i) * 8 + kL] = log_sigmoid(f + bfk) * LOG2E;
        }
        __syncthreads();
        if (tid < 8) {
            float run = 0.f; float* dst = Floc + (size_t)(b * 8 + tid) * SEQ + (t0 & (SEQ - 1));
            for (int i = 0; i < 64; ++i) { run += lf[i * 8 + tid]; dst[i] = run; }
            ctot[(b * 8 + tid) * 128 + ((t0 & (SEQ - 1)) >> 6)] = run;
        }
        __syncthreads();
    }
}

struct EpiQK {
    static constexpr bool PERM = true, AFTER_DRAIN = false;
    unsigned char* ws;
    __device__ __forceinline__ void operator()(const pg8::f32x4 (&acc)[2][2][4][2], const pg8::Unit& u, int wr, int wc, int fr, int fq) const {
        const int b = (u.pm * 256) >> 13;
#pragma unroll
        for (int bj = 0; bj < 2; ++bj) {
            const int c0 = u.pn * 256 + bj * 128 + wc * 32 + 8 * fq, seg4 = c0 >> 9, hd = (c0 & 511) >> 6, d = c0 & 63;
            bf16_t* dst = (bf16_t*)(ws + WS_QF + (size_t)(seg4 < 2 ? seg4 : seg4 + 1) * 32 * MiB) + (size_t)(b * 8 + hd) * SEQ * 64 + d;
            float mx = 0.f;
#pragma unroll
            for (int ai = 0; ai < 2; ++ai)
#pragma unroll
                for (int m = 0; m < 4; ++m) {
                    const int s = (u.pm * 256 + ai * 128 + wr * 64 + m * 16 + fr) & (SEQ - 1);
                    const pg8::f32x4 v0 = acc[ai][bj][m][0], v1 = acc[ai][bj][m][1];
                    u32x4 w; w.x = cvt_pk_bf16(v0[0], v0[1]); w.y = cvt_pk_bf16(v0[2], v0[3]); w.z = cvt_pk_bf16(v1[0], v1[1]); w.w = cvt_pk_bf16(v1[2], v1[3]);
                    *(u32x4*)(dst + (size_t)s * 64) = w;
                    if (seg4 == 1) {
                        float q = (v0[0] * v0[0] + v0[1] * v0[1]) + (v0[2] * v0[2] + v0[3] * v0[3]) + (v1[0] * v1[0] + v1[1] * v1[1]) + (v1[2] * v1[2] + v1[3] * v1[3]);
                        q += __shfl_xor(q, 16); q += __shfl_xor(q, 32);
                        mx = fmaxf(mx, q);
                    }
                }
            if (seg4 == 1) {
                mx = wave_max(mx);
                if ((threadIdx.x & 63) == 0) atomicMax((unsigned*)(ws + WS_KMAX) + (b * 8 + hd) * 2 + (wc & 1), __float_as_uint(mx));
            }
        }
    }
};
struct EpiV {
    static constexpr bool PERM = true, AFTER_DRAIN = false;
    unsigned char* ws;
    __device__ __forceinline__ void operator()(const pg8::f32x4 (&acc)[2][2][4][2], const pg8::Unit& u, int wr, int wc, int fr, int fq) const {
#pragma unroll
        for (int bj = 0; bj < 2; ++bj) {
            const int t0 = u.pn * 256 + bj * 128 + wc * 32 + 8 * fq, b = t0 >> 13, s = t0 & (SEQ - 1);
#pragma unroll
            for (int ai = 0; ai < 2; ++ai)
#pragma unroll
                for (int m = 0; m < 4; ++m) {
                    const int vc = u.pm * 256 + ai * 128 + wr * 64 + m * 16 + fr, type = vc >> 9, hd = (vc & 511) >> 6, d = vc & 63;
                    bf16_t* dst = (bf16_t*)(ws + WS_QF + (size_t)(type * 3 + 2) * 32 * MiB) + (((size_t)(b * 8 + hd) * 256 + (s >> 5)) * 64 + d) * 32 + (s & 31);
                    const pg8::f32x4 v0 = acc[ai][bj][m][0], v1 = acc[ai][bj][m][1];
                    u32x4 w; w.x = cvt_pk_bf16(v0[0], v0[1]); w.y = cvt_pk_bf16(v0[2], v0[3]); w.z = cvt_pk_bf16(v1[0], v1[1]); w.w = cvt_pk_bf16(v1[2], v1[3]);
                    *(u32x4*)dst = w;
                }
        }
    }
};
struct EpiOut {
    static constexpr bool PERM = true, AFTER_DRAIN = false;
    const float* x; bf16_t* x1; const float* mod;
    __device__ __forceinline__ void operator()(const pg8::f32x4 (&acc)[2][2][4][2], const pg8::Unit& u, int wr, int wc, int fr, int fq) const {
        const int b = (u.pm * 256) >> 13;
#pragma unroll
        for (int bj = 0; bj < 2; ++bj) {
            const int c0 = u.pn * 256 + bj * 128 + wc * 32 + 8 * fq;
            const f32x4 g0 = *(const f32x4*)(mod + b * NMOD + 2048 + c0), g1 = *(const f32x4*)(mod + b * NMOD + 2048 + c0 + 4);
#pragma unroll
            for (int ai = 0; ai < 2; ++ai)
#pragma unroll
                for (int m = 0; m < 4; ++m) {
                    const size_t off = (size_t)(u.pm * 256 + ai * 128 + wr * 64 + m * 16 + fr) * D + c0;
                    const f32x4 v0 = *(const f32x4*)(x + off) + g0 * acc[ai][bj][m][0], v1 = *(const f32x4*)(x + off + 4) + g1 * acc[ai][bj][m][1];
                    u32x4 w; w.x = cvt_pk_bf16(v0[0], v0[1]); w.y = cvt_pk_bf16(v0[2], v0[3]); w.z = cvt_pk_bf16(v1[0], v1[1]); w.w = cvt_pk_bf16(v1[2], v1[3]);
                    *(u32x4*)(x1 + off) = w;
                }
        }
    }
};
struct EpiQuery {
    static constexpr bool PERM = true, AFTER_DRAIN = false;
    bf16_t* q;
    __device__ __forceinline__ void operator()(const pg8::f32x4 (&acc)[2][2][4][2], const pg8::Unit& u, int wr, int wc, int fr, int fq) const {
#pragma unroll
        for (int bj = 0; bj < 2; ++bj) {
            const int i16 = bj * 8 + 2 * wc + (fq >> 1), hh = fq & 1;
#pragma unroll
            for (int ai = 0; ai < 2; ++ai)
#pragma unroll
                for (int m = 0; m < 4; ++m) {
                    const pg8::f32x4 v0 = acc[ai][bj][m][0], v1 = acc[ai][bj][m][1];
                    u32x4 w; w.x = cvt_pk_bf16(v0[0], v0[1]); w.y = cvt_pk_bf16(v0[2], v0[3]); w.z = cvt_pk_bf16(v1[0], v1[1]); w.w = cvt_pk_bf16(v1[2], v1[3]);
                    const int off = ((((u.pm * 8 + ai * 4 + wr * 2 + (m >> 1)) * 8 + u.pn) * 16 + i16) * 2 + hh) * 256 + ((m & 1) * 16 + fr) * 8;
                    *(u32x4*)(q + off) = w;
                }
        }
    }
};
#define LASP(ptr) ((__attribute__((address_space(3))) unsigned char*)(ptr))
template <class Epi>
__device__ __forceinline__ void run_gemm(char* smem, const bf16_t* A, const bf16_t* Bt, int M, int N, const Epi& E) {
    pg8::Gemm g{A, Bt, M, N, 1024}; pg8::StaticOrder S; S.init(M, N, (int)gridDim.x, (int)blockIdx.x);
    pg8::gemm_phase<Epi, pg8::StaticOrder, true, true>(LASP(smem), g, S, E);
}
__device__ __forceinline__ void gemm_proj(const P& p, char* smem) {
    run_gemm(smem, (const bf16_t*)(p.ws + WS_H), (const bf16_t*)(p.ws + WS_WQK), T, 2048, EpiQK{p.ws});
    run_gemm(smem, (const bf16_t*)(p.ws + WS_WV), (const bf16_t*)(p.ws + WS_H), 1024, T, EpiV{p.ws});
}
__device__ __forceinline__ void gemm_out(const P& p, char* smem) {
    run_gemm(smem, (const bf16_t*)(p.ws + WS_MIX), (const bf16_t*)(p.ws + WS_WOUT), T, 1024, EpiOut{p.x, (bf16_t*)(p.ws + WS_X1), (const float*)(p.ws + WS_MOD)});
}
__device__ __forceinline__ void gemm_query(const P& p, char* smem) {
    run_gemm(smem, (const bf16_t*)(p.ws + WS_H), (const bf16_t*)(p.ws + WS_WQ), T, 2048, EpiQuery{(bf16_t*)(p.ws + WS_QUERY)});
}

__device__ __forceinline__ void attn_store(const P& p, const f32x16& o0, const f32x16& o1, float rs, const float* gout, int b, int h, int qt, int r, int hh, size_t dstoff = WS_MIX) {
    float ss = 0.f;
#pragma unroll
    for (int i = 0; i < 16; ++i) { const float a = o0[i] * rs, c = o1[i] * rs; ss += a * a + c * c; }
    ss = xor32_sum(ss);
    const float inv = rsqrtf(ss * (1.f / 64.f) + EPS) * rs;
    bf16_t* dst = (bf16_t*)(p.ws + dstoff) + (size_t)(b * SEQ + qt * 32 + r) * D + h * 64;
#pragma unroll
    for (int dt = 0; dt < 2; ++dt)
#pragma unroll
        for (int g = 0; g < 4; ++g) {
            const int d = dt * 32 + 8 * g + 4 * hh;
            const f32x4 gg = *(const f32x4*)(gout + d);
            const f32x16& o = dt == 0 ? o0 : o1;
            u32x2 w; w.x = cvt_pk_bf16(o[4 * g] * inv * gg.x, o[4 * g + 1] * inv * gg.y); w.y = cvt_pk_bf16(o[4 * g + 2] * inv * gg.z, o[4 * g + 3] * inv * gg.w);
            *(u32x2*)(dst + d) = w;
        }
}

__device__ __forceinline__ bf16x8 pack8(float a0, float a1, float a2, float a3, float a4, float a5, float a6, float a7) {
    u32x4 w; w.x = cvt_pk_bf16(a0, a1); w.y = cvt_pk_bf16(a2, a3); w.z = cvt_pk_bf16(a4, a5); w.w = cvt_pk_bf16(a6, a7);
    return __builtin_bit_cast(bf16x8, w);
}
__device__ __forceinline__ bf16x8 load_vfrag(const bf16_t* vt, int dt, int r, int s, int hh) {
    const bf16_t* a = vt + (dt * 32 + r) * 32 + 16 * s + 4 * hh;
    const u32x2 lo = *(const u32x2*)a, hi = *(const u32x2*)(a + 8);
    u32x4 w; w.x = lo.x; w.y = lo.y; w.z = hi.x; w.w = hi.y;
    return __builtin_bit_cast(bf16x8, w);
}

constexpr int ATT_WAVE_LDS = 4096 + 64 * 72;
struct RawTile { u32x4 k[4], v[4]; };
__device__ __forceinline__ void raw_load(RawTile& t, const bf16_t* Kp, const bf16_t* Vp, int kt, int lane) {
    const u32x4* gk = (const u32x4*)(Kp + (size_t)kt * 2048) + lane;
    const u32x4* gv = (const u32x4*)(Vp + (size_t)kt * 2048) + lane;
#pragma unroll
    for (int i = 0; i < 4; ++i) { t.k[i] = gk[64 * i]; t.v[i] = gv[64 * i]; }
}
__device__ __forceinline__ void raw_store(const RawTile& t, char* wl, int lane) {
#pragma unroll
    for (int i = 0; i < 4; ++i) {
        const int row = i * 8 + (lane >> 3), ch = lane & 7;
        *(u32x4*)(wl + row * 128 + ((ch ^ ((row >> 1) & 7)) * 16)) = t.k[i];
        const int d = i * 16 + (lane >> 2), c4 = lane & 3;
        u32x2 lo, hi; lo.x = t.v[i].x; lo.y = t.v[i].y; hi.x = t.v[i].z; hi.y = t.v[i].w;
        *(u32x2*)(wl + 4096 + d * 72 + c4 * 16) = lo;
        *(u32x2*)(wl + 4096 + d * 72 + c4 * 16 + 8) = hi;
    }
}
__device__ __forceinline__ void frag_read(bf16x8 (&kf)[4], bf16x8 (&vf)[4], const char* wl, int r, int hh) {
#pragma unroll
    for (int kk = 0; kk < 4; ++kk) kf[kk] = *(const bf16x8*)(wl + r * 128 + (((2 * kk + hh) ^ ((r >> 1) & 7)) * 16));
#pragma unroll
    for (int s2 = 0; s2 < 2; ++s2)
#pragma unroll
        for (int dt = 0; dt < 2; ++dt) {
            const char* a = wl + 4096 + (dt * 32 + r) * 72 + 32 * s2 + 8 * hh;
            const u32x2 lo = *(const u32x2*)a, hi = *(const u32x2*)(a + 16);
            u32x4 w; w.x = lo.x; w.y = lo.y; w.z = hi.x; w.w = hi.y;
            vf[2 * s2 + dt] = __builtin_bit_cast(bf16x8, w);
        }
}

template <bool DIAG>
__device__ __forceinline__ void fox_tile(const bf16x8 (&kf)[4], const bf16x8 (&vf)[4], const bf16x8 (&qf)[4], const f32x4 (&fk)[4], float Fq, float off,
                                         int hh, int r, float& m, float& lsum, f32x16& o0, f32x16& o1) {
    f32x16 s;
#pragma unroll
    for (int i = 0; i < 16; ++i) s[i] = 0.f;
#pragma unroll
    for (int kk = 0; kk < 4; ++kk) s = __builtin_amdgcn_mfma_f32_32x32x16_bf16(kf[kk], qf[kk], s, 0, 0, 0);
    const float fb = Fq - off;
    float lg[16]; float tmax = -INFINITY;
#pragma unroll
    for (int i = 0; i < 16; ++i) {
        float v = s[i] * SC2 + (fb - fk[i >> 2][i & 3]);
        if (DIAG && (8 * (i >> 2) + 4 * hh + (i & 3)) > r) v = -INFINITY;
        lg[i] = v; tmax = fmaxf(tmax, v);
    }
    tmax = xor32_max(tmax);
    const float mnew = fmaxf(m, tmax);
    if (!__all(mnew == m)) {
        const float alpha = __builtin_amdgcn_exp2f(m - mnew);
        lsum *= alpha;
#pragma unroll
        for (int i = 0; i < 16; ++i) { o0[i] *= alpha; o1[i] *= alpha; }
        m = mnew;
    }
    float ps = 0.f;
#pragma unroll
    for (int i = 0; i < 16; ++i) { lg[i] = __builtin_amdgcn_exp2f(lg[i] - m); ps += lg[i]; }
    lsum += xor32_sum(ps);
#pragma unroll
    for (int s2 = 0; s2 < 2; ++s2) {
        const bf16x8 pf = pack8(lg[8 * s2], lg[8 * s2 + 1], lg[8 * s2 + 2], lg[8 * s2 + 3], lg[8 * s2 + 4], lg[8 * s2 + 5], lg[8 * s2 + 6], lg[8 * s2 + 7]);
        o0 = __builtin_amdgcn_mfma_f32_32x32x16_bf16(vf[2 * s2], pf, o0, 0, 0, 0);
        o1 = __builtin_amdgcn_mfma_f32_32x32x16_bf16(vf[2 * s2 + 1], pf, o1, 0, 0, 0);
    }
}

template <bool DIAG>
__device__ __forceinline__ void sb_tile(const bf16x8 (&kf)[4], const bf16x8 (&vf)[4], const bf16x8 (&qf)[4], int hh, int r, float& R, f32x16& o0, f32x16& o1) {
    f32x16 s;
#pragma unroll
    for (int i = 0; i < 16; ++i) s[i] = 0.f;
#pragma unroll
    for (int kk = 0; kk < 4; ++kk) s = __builtin_amdgcn_mfma_f32_32x32x16_bf16(kf[kk], qf[kk], s, 0, 0, 0);
    float lom[16], lb[16];
#pragma unroll
    for (int i = 0; i < 16; ++i) {
        const float z = s[i] * SC2;
        const float sp = fmaxf(z, 0.f) + __builtin_amdgcn_logf(1.f + __builtin_amdgcn_exp2f(-fabsf(z)));
        const bool valid = !DIAG || (8 * (i >> 2) + 4 * hh + (i & 3)) < r;
        lom[i] = valid ? -sp : 0.f;
        lb[i] = valid ? (z - sp) : -INFINITY;
    }
    float G[4], PG[4], Tt[4];
#pragma unroll
    for (int g = 0; g < 4; ++g) { G[g] = (lom[4 * g] + lom[4 * g + 1]) + (lom[4 * g + 2] + lom[4 * g + 3]); PG[g] = xor32_get(G[g], hh); Tt[g] = G[g] + PG[g]; }
    float TS[4]; TS[3] = 0.f; TS[2] = Tt[3]; TS[1] = TS[2] + Tt[2]; TS[0] = TS[1] + Tt[1];
    float a[16];
#pragma unroll
    for (int g = 0; g < 4; ++g) {
        const float r3 = R + TS[g] + (hh == 0 ? PG[g] : 0.f);
        const float r2 = r3 + lom[4 * g + 3], r1 = r2 + lom[4 * g + 2], r0 = r1 + lom[4 * g + 1];
        a[4 * g + 3] = __builtin_amdgcn_exp2f(lb[4 * g + 3] + r3); a[4 * g + 2] = __builtin_amdgcn_exp2f(lb[4 * g + 2] + r2);
        a[4 * g + 1] = __builtin_amdgcn_exp2f(lb[4 * g + 1] + r1); a[4 * g + 0] = __builtin_amdgcn_exp2f(lb[4 * g + 0] + r0);
    }
    R += TS[0] + Tt[0];
#pragma unroll
    for (int s2 = 0; s2 < 2; ++s2) {
        const bf16x8 pf = pack8(a[8 * s2], a[8 * s2 + 1], a[8 * s2 + 2], a[8 * s2 + 3], a[8 * s2 + 4], a[8 * s2 + 5], a[8 * s2 + 6], a[8 * s2 + 7]);
        o0 = __builtin_amdgcn_mfma_f32_32x32x16_bf16(vf[2 * s2], pf, o0, 0, 0, 0);
        o1 = __builtin_amdgcn_mfma_f32_32x32x16_bf16(vf[2 * s2 + 1], pf, o1, 0, 0, 0);
    }
}

template <int PMODE>
__device__ __forceinline__ void attn_task(const P& p, char* wl, const float* gl, int type, int bh, int qt, int lane) {
    const int r = lane & 31, hh = lane >> 5, b = bh >> 3, h = bh & 7;
    const size_t segoff = (size_t)(type * 3) * 32 * MiB;
    const bf16_t* Q = (const bf16_t*)(p.ws + WS_QF + segoff) + ((size_t)bh * SEQ + qt * 32) * 64;
    const bf16_t* Kp = (const bf16_t*)(p.ws + WS_QF + segoff + 32 * MiB) + (size_t)bh * SEQ * 64;
    const bf16_t* Vp = (const bf16_t*)(p.ws + WS_QF + segoff + 64 * MiB) + (size_t)bh * 256 * 2048;
    RawTile raw;
    raw_load(raw, Kp, Vp, qt, lane);
    bf16x8 qf[4];
#pragma unroll
    for (int kk = 0; kk < 4; ++kk) qf[kk] = *(const bf16x8*)(Q + r * 64 + kk * 16 + hh * 8);
    f32x16 o0, o1;
#pragma unroll
    for (int i = 0; i < 16; ++i) { o0[i] = 0.f; o1[i] = 0.f; }
    float rs = 1.f;
    bf16x8 kf[4], vf[4];
    const float* F = (const float*)(p.ws + WS_FLOC) + (size_t)bh * SEQ;
    const float* Ct = (const float*)(p.ws + WS_CTOT) + bh * 128;
    f32x4 fk[4];
#pragma unroll
    for (int g = 0; g < 4; ++g) fk[g] = *(const f32x4*)(F + qt * 32 + 8 * g + 4 * hh);
    const float Fq = F[qt * 32 + r];
    const float kmx = __uint_as_float(((const unsigned*)(p.ws + WS_KMAX))[bh * 2]) + __uint_as_float(((const unsigned*)(p.ws + WS_KMAX))[bh * 2 + 1]);
    raw_store(raw, wl, lane);
    if (type == 0) {
        float Flast = 0.f;
        float qn2 = 0.f;
#pragma unroll
        for (int kk = 0; kk < 4; ++kk)
#pragma unroll
            for (int j = 0; j < 8; ++j) { const float v = bf2f((bf16_t)qf[kk][j]); qn2 += v * v; }
        qn2 = xor32_sum(qn2);
        const float qb = (sqrtf(qn2 * kmx) * ATT_SCALE * 1.01f + 0.01f) * LOG2E;
        float off = 0.f, m = -INFINITY, lsum = 0.f;
        f32x4 fn[4]; float ctn = 0.f;
        frag_read(kf, vf, wl, r, hh);
        if (qt > 0) {
            raw_load(raw, Kp, Vp, qt - 1, lane);
#pragma unroll
            for (int g = 0; g < 4; ++g) fn[g] = *(const f32x4*)(F + (qt - 1) * 32 + 8 * g + 4 * hh);
            Flast = F[(qt - 1) * 32 + 31]; ctn = ((qt - 1) & 1) ? Ct[(qt - 1) >> 1] : 0.f;
        }
        fox_tile<true>(kf, vf, qf, fk, Fq, off, hh, r, m, lsum, o0, o1);
        for (int kt = qt - 1; kt >= 0 && PMODE != 1; --kt) {
            raw_store(raw, wl, lane);
            off -= ctn;
            if (__all((qb + Fq - (Flast + off)) - m < -THRESH2)) break;
#pragma unroll
            for (int g = 0; g < 4; ++g) fk[g] = fn[g];
            frag_read(kf, vf, wl, r, hh);
            if (kt > 0) {
                raw_load(raw, Kp, Vp, kt - 1, lane);
#pragma unroll
                for (int g = 0; g < 4; ++g) fn[g] = *(const f32x4*)(F + (kt - 1) * 32 + 8 * g + 4 * hh);
                Flast = F[(kt - 1) * 32 + 31]; ctn = ((kt - 1) & 1) ? Ct[(kt - 1) >> 1] : 0.f;
            }
            fox_tile<false>(kf, vf, qf, fk, Fq, off, hh, r, m, lsum, o0, o1);
        }
        rs = 1.f / lsum;
    } else {
        float R = 0.f;
        frag_read(kf, vf, wl, r, hh);
        if (qt > 0) raw_load(raw, Kp, Vp, qt - 1, lane);
        sb_tile<true>(kf, vf, qf, hh, r, R, o0, o1);
        for (int kt = qt - 1; kt >= 0 && PMODE != 1; --kt) {
            raw_store(raw, wl, lane);
            if (__all(R < -THRESH2)) break;
            frag_read(kf, vf, wl, r, hh);
            if (kt > 0) raw_load(raw, Kp, Vp, kt - 1, lane);
            sb_tile<false>(kf, vf, qf, hh, r, R, o0, o1);
        }
    }
    attn_store(p, o0, o1, rs, gl + type * 64, b, type * 8 + h, qt, r, hh, PMODE == 0 ? WS_MIX : WS_H);
}

__device__ __forceinline__ void expert_cvt_job(const P& p, int job, int lane) {
    const int row0 = job * 8;
    const float* src = row0 < 16384 ? p.e_down : p.e_up;
    unsigned char* dst = p.ws + (row0 < 16384 ? WS_ED : WS_EU);
    float* rs = (float*)(p.ws + (row0 < 16384 ? WS_RSD : WS_RSU));
    const int r0 = row0 & 16383;
#pragma unroll 1
    for (int h4 = 0; h4 < 8; h4 += 4) {
        RowF32 rr[4];
#pragma unroll
        for (int k = 0; k < 4; ++k) row_load(rr[k], src, r0 + h4 + k, lane);
#pragma unroll
        for (int k = 0; k < 4; ++k) cvt_row_q4(rr[k], dst, rs, r0 + h4 + k, lane, row0 < 16384 ? 0x88888888u : 0x80808080u);
    }
}
template <int PMODE = 0>
__device__ __forceinline__ void attn_phase(const P& p, char* smem, int bid, int nblk, int cidx = 0, unsigned tlo = 0u, unsigned thi = 2560u) {
    const int tid = tidx(), lane = tid & 63;
    char* wl = smem + (tid >> 6) * ATT_WAVE_LDS;
    float* gl = (float*)(smem + NWAVE * ATT_WAVE_LDS);
    if (tid < 128) gl[tid] = tid < 64 ? p.g_fox[tid] : p.g_sb[tid - 64];
    __syncthreads();
    unsigned* ctr = (unsigned*)(p.ws + WS_KMAX) + 64 + 1024 * cidx;
    int q = bid & 7, tried = 0;
    unsigned tk = 0;
    if (lane == 0) tk = atomicAdd(ctr + 64 * q, 1u);
    for (;;) {
        const unsigned i = (unsigned)__builtin_amdgcn_readfirstlane((int)tk) + tlo;
        if (i >= thi) {
            if (++tried == 8) break;
            q = (q + 1) & 7;
            if (lane == 0) tk = atomicAdd(ctr + 64 * q, 1u);
            continue;
        }
        if (lane == 0) tk = atomicAdd(ctr + 64 * q, 1u);
        const unsigned g5 = i / 5u, r5 = i - 5u * g5;
        if (r5 == 4u) { if (PMODE == 0) expert_cvt_job(p, (int)(q * 512 + g5), lane); continue; }
        const unsigned a = 4u * g5 + r5;
        const int type = a >> 10, rem = (int)(a & 1023u) * 8 + q, qt = 255 - (rem >> 5), bh = rem & 31;
        attn_task<PMODE>(p, wl, gl, type, bh, qt, lane);
    }
}

__device__ __forceinline__ void p5_row(const P& p, const f32x4 (&A2)[4], const f32x4 (&B2)[4], int t, int lane, const u32x4& xa, const u32x4& xb) {
    float v[16]; float ss = 0.f;
#pragma unroll
    for (int i = 0; i < 4; ++i) { v[2 * i] = bf_lo(xa[i]); v[2 * i + 1] = bf_hi(xa[i]); v[8 + 2 * i] = bf_lo(xb[i]); v[8 + 2 * i + 1] = bf_hi(xb[i]); }
#pragma unroll
    for (int i = 0; i < 16; ++i) ss += v[i] * v[i];
    const float inv = rsqrtf(wave_sum(ss) * (1.f / D) + EPS);
    u32x4 o[2];
#pragma unroll
    for (int q = 0; q < 4; ++q) {
        f32x4 h;
#pragma unroll
        for (int e2 = 0; e2 < 4; ++e2) h[e2] = (v[4 * q + e2] * inv) * A2[q][e2] + B2[q][e2];
        o[q >> 1][(q & 1) * 2] = cvt_pk_bf16(h[0], h[1]); o[q >> 1][(q & 1) * 2 + 1] = cvt_pk_bf16(h[2], h[3]);
    }
    bf16_t* hbuf = (bf16_t*)(p.ws + WS_H);
    *(u32x4*)(hbuf + (size_t)t * D + 16 * lane) = o[0]; *(u32x4*)(hbuf + (size_t)t * D + 16 * lane + 8) = o[1];
}
__device__ __forceinline__ void p5_norm2(const P& p, int bid, int nblk) {
    const int tid = tidx(), lane = tid & 63, wid = tid >> 6;
    const float* mod = (const float*)(p.ws + WS_MOD);
    const bf16_t* x1 = (const bf16_t*)(p.ws + WS_X1);
    const int nw = nblk * NWAVE;
    int bcur = -1; f32x4 A2[4], B2[4];
    for (int t = bid * NWAVE + wid; t < T; t += 4 * nw) {
        u32x4 xa[4], xb[4];
#pragma unroll
        for (int k = 0; k < 4; ++k) { xa[k] = *(const u32x4*)(x1 + (size_t)(t + k * nw) * D + 16 * lane); xb[k] = *(const u32x4*)(x1 + (size_t)(t + k * nw) * D + 16 * lane + 8); }
#pragma unroll
        for (int k = 0; k < 4; ++k) {
            const int tk = t + k * nw, b = tk >> 13;
            if (b != bcur) {
                bcur = b;
#pragma unroll
                for (int q = 0; q < 4; ++q) {
                    const f32x4 g = *(const f32x4*)(p.g_ffn + 16 * lane + 4 * q);
                    const f32x4 s = *(const f32x4*)(mod + b * NMOD + 4096 + 16 * lane + 4 * q);
                    A2[q] = g * (s + 1.0f); B2[q] = *(const f32x4*)(mod + b * NMOD + 3072 + 16 * lane + 4 * q);
                }
            }
            p5_row(p, A2, B2, tk, lane, xa[k], xb[k]);
        }
    }
}

__device__ __forceinline__ int enc_key(float v) { const int u = __float_as_int(v); return u ^ ((u >> 31) & 0x7fffffff); }
__device__ __forceinline__ float dec_key(int k) { return __int_as_float(k ^ ((k >> 31) & 0x7fffffff)); }
#define KEY_LOWEST ((int)0x80000000)
#define INS16(L, v) do { int _v = (v); _Pragma("unroll") for (int _s = 0; _s < 16; ++_s) { const int _h = max(L[_s], _v); _v = min(L[_s], _v); L[_s] = _h; } } while (0)

#define CEX(a,i,j) { const int _h = max(a[i], a[j]); const int _l = min(a[i], a[j]); a[i] = _h; a[j] = _l; }
#define SORT16_DESC(a) do { CEX(a,0,1); CEX(a,2,3); CEX(a,0,2); CEX(a,1,3); CEX(a,1,2); CEX(a,4,5); CEX(a,6,7); CEX(a,4,6); CEX(a,5,7); CEX(a,5,6); CEX(a,0,4); CEX(a,2,6); CEX(a,2,4); CEX(a,1,5); CEX(a,3,7); CEX(a,3,5); CEX(a,1,2); CEX(a,3,4); CEX(a,5,6); CEX(a,8,9); CEX(a,10,11); CEX(a,8,10); CEX(a,9,11); CEX(a,9,10); CEX(a,12,13); CEX(a,14,15); CEX(a,12,14); CEX(a,13,15); CEX(a,13,14); CEX(a,8,12); CEX(a,10,14); CEX(a,10,12); CEX(a,9,13); CEX(a,11,15); CEX(a,11,13); CEX(a,9,10); CEX(a,11,12); CEX(a,13,14); CEX(a,0,8); CEX(a,4,12); CEX(a,4,8); CEX(a,2,10); CEX(a,6,14); CEX(a,6,10); CEX(a,2,4); CEX(a,6,8); CEX(a,10,12); CEX(a,1,9); CEX(a,5,13); CEX(a,5,9); CEX(a,3,11); CEX(a,7,15); CEX(a,7,11); CEX(a,3,5); CEX(a,7,9); CEX(a,11,13); CEX(a,1,2); CEX(a,3,4); CEX(a,5,6); CEX(a,7,8); CEX(a,9,10); CEX(a,11,12); CEX(a,13,14); } while (0)
#define BMERGE16_DESC(a) do { CEX(a,0,8); CEX(a,1,9); CEX(a,2,10); CEX(a,3,11); CEX(a,4,12); CEX(a,5,13); CEX(a,6,14); CEX(a,7,15); CEX(a,0,4); CEX(a,1,5); CEX(a,2,6); CEX(a,3,7); CEX(a,8,12); CEX(a,9,13); CEX(a,10,14); CEX(a,11,15); CEX(a,0,2); CEX(a,1,3); CEX(a,4,6); CEX(a,5,7); CEX(a,8,10); CEX(a,9,11); CEX(a,12,14); CEX(a,13,15); CEX(a,0,1); CEX(a,2,3); CEX(a,4,5); CEX(a,6,7); CEX(a,8,9); CEX(a,10,11); CEX(a,12,13); CEX(a,14,15); } while (0)
#define MERGE_TOP16(A, B) do { _Pragma("unroll") for (int _i = 0; _i < 16; ++_i) A[_i] = max(A[_i], B[15 - _i]); BMERGE16_DESC(A); } while (0)
constexpr int SK_ROW = 272;

struct QFrag { bf16x8 f[16]; };
__device__ __forceinline__ void topk_load_q(QFrag& q, const P& p, int tt, int h, int lane) {
    const bf16_t* qb = (const bf16_t*)(p.ws + WS_QUERY) + ((size_t)tt * 8 + h) * 16 * 512 + lane * 8;
#pragma unroll
    for (int i = 0; i < 16; ++i) q.f[i] = *(const bf16x8*)(qb + i * 512);
}
__device__ __forceinline__ void topk_tile(const bf16x8* qf, const char* img, int mt, int r, int hh, int (&Kk)[16]) {
    f32x16 sc;
#pragma unroll
    for (int i = 0; i < 16; ++i) sc[i] = 0.f;
#pragma unroll
    for (int kk = 0; kk < 8; ++kk) {
        const bf16x8 kf = *(const bf16x8*)(img + (mt * 32 + r) * SK_ROW + kk * 32 + hh * 16);
        sc = __builtin_amdgcn_mfma_f32_32x32x16_bf16(kf, qf[kk], sc, 0, 0, 0);
    }
#pragma unroll
    for (int i = 0; i < 16; ++i) Kk[i] = (enc_key(sc[i]) & ~127) | (mt * 32 + 8 * (i >> 2) + 4 * hh + (i & 3));
    SORT16_DESC(Kk);
}
__device__ __forceinline__ void topk_half(const bf16x8* qf, const char* img, int r, int hh, int (&Lk)[16]) {
    topk_tile(qf, img, 0, r, hh, Lk);
#pragma unroll 1
    for (int mt = 1; mt < 4; ++mt) {
        int Kk[16];
        topk_tile(qf, img, mt, r, hh, Kk);
        MERGE_TOP16(Lk, Kk);
    }
    int Pn[16];
#pragma unroll
    for (int s = 0; s < 16; ++s) Pn[s] = __shfl_xor(Lk[s], 32);
    MERGE_TOP16(Lk, Pn);
}

__device__ __forceinline__ void topk_task(const P& p, const char* img, QFrag& qf, int tt, int tt_next, int h, int lane) {
    const int r = lane & 31, hh = lane >> 5, t = tt * 32 + r;
    int La[16], Lb[16];
    topk_half(qf.f, img, r, hh, La);
    topk_half(qf.f + 8, img + 128 * SK_ROW, r, hh, Lb);
    if (tt_next < T / 32) topk_load_q(qf, p, tt_next, h, lane);
    float v1[16], v2[16];
#pragma unroll
    for (int s = 0; s < 16; ++s) { v1[s] = dec_key(La[s] & ~127); v2[s] = dec_key(Lb[s] & ~127); }
    unsigned long long I1lo = 0, I1hi = 0, I2lo = 0, I2hi = 0;
#pragma unroll
    for (int s = 0; s < 8; ++s) {
        I1lo |= (unsigned long long)(unsigned)(La[s] & 127) << (8 * s); I1hi |= (unsigned long long)(unsigned)(La[s + 8] & 127) << (8 * s);
        I2lo |= (unsigned long long)(unsigned)(Lb[s] & 127) << (8 * s); I2hi |= (unsigned long long)(unsigned)(Lb[s + 8] & 127) << (8 * s);
    }
#define CK(a, b) ((enc_key(v1[a] + v2[b]) & ~255) | ((a) * 16 + (b)))
    int C[16], G[16];
#pragma unroll
    for (int bq = 0; bq < 16; ++bq) C[bq] = CK(0, bq);
#pragma unroll
    for (int bq = 0; bq < 8; ++bq) G[bq] = CK(1, bq);
#pragma unroll
    for (int bq = 0; bq < 5; ++bq) G[8 + bq] = CK(2, bq);
#pragma unroll
    for (int bq = 0; bq < 3; ++bq) G[13 + bq] = CK(4, bq);
    SORT16_DESC(G); MERGE_TOP16(C, G);
#pragma unroll
    for (int bq = 0; bq < 4; ++bq) G[bq] = CK(3, bq);
    G[4] = CK(5, 0); G[5] = CK(5, 1); G[6] = CK(6, 0); G[7] = CK(6, 1); G[8] = CK(7, 0); G[9] = CK(7, 1);
    G[10] = CK(8, 0); G[11] = CK(9, 0); G[12] = CK(10, 0); G[13] = CK(11, 0); G[14] = CK(12, 0); G[15] = CK(13, 0);
    SORT16_DESC(G); MERGE_TOP16(C, G);
    INS16(C, CK(14, 0)); INS16(C, CK(15, 0));
#undef CK
    float tv[16]; float sum = 0.f;
    const float mx = dec_key(C[0] & ~255);
#pragma unroll
    for (int s = 0; s < 16; ++s) { tv[s] = __expf(dec_key(C[s] & ~255) - mx); sum += tv[s]; }
    const float rinv = 1.f / sum;
    unsigned* ex = (unsigned*)(p.ws + WS_EXP) + (size_t)t * 128 + h * 16 + hh * 8;
    u32x4 eo[2];
#pragma unroll
    for (int s = 0; s < 8; ++s) {
        const int hm = -hh;
        const unsigned cs = (unsigned)(C[s] ^ ((C[s] ^ C[s + 8]) & hm));
        const float gv = __uint_as_float(__float_as_uint(tv[s]) ^ ((__float_as_uint(tv[s]) ^ __float_as_uint(tv[s + 8])) & (unsigned)hm)) * rinv;
        const unsigned pos = cs & 255u, a = pos >> 4, bq = pos & 15u;
        const unsigned i1 = (unsigned)(((a & 8u) ? I1hi : I1lo) >> (8 * (a & 7u))) & 127u;
        const unsigned i2 = (unsigned)(((bq & 8u) ? I2hi : I2lo) >> (8 * (bq & 7u))) & 127u;
        eo[s >> 2][s & 3] = (i1 * 128u + i2) | (cvt_pk_bf16(gv, 0.f) << 16);
    }
    *(u32x4*)ex = eo[0]; *(u32x4*)(ex + 4) = eo[1];
}

__device__ __forceinline__ void topk_phase(const P& p, char* smem, int bid, int nblk) {
    const int tid = tidx(), lane = tid & 63, wid = tid >> 6, h = bid & 7;
    const bf16_t* sk = (const bf16_t*)(p.ws + WS_SK) + (size_t)h * 2 * 128 * 128;
    const int nslots = (nblk >> 3) * NWAVE;
    QFrag qf;
    const int tt0 = (bid >> 3) * NWAVE + wid;
    if (tt0 < T / 32) topk_load_q(qf, p, tt0, h, lane);
    for (int idx = tid; idx < 4096; idx += NTHR) {
        const int row = idx >> 4, ch = idx & 15;
        *(u32x4*)(smem + row * SK_ROW + ch * 16) = *(const u32x4*)(sk + (size_t)row * 128 + ch * 8);
    }
    __syncthreads();
    for (int tt = tt0; tt < T / 32; tt += nslots) topk_task(p, smem, qf, tt, tt + nslots, h, lane);
    __syncthreads();
}

__device__ __forceinline__ float gelu_erf(float v) { return 0.5f * v * (1.f + erff(v * 0.70710678118654752f)); }

struct PeerIdx { int e0, e1; };
struct Rows8 { u32x4 r[8]; float sc[8]; };
__device__ __forceinline__ void peer_rows8(Rows8& b, const unsigned char* tab, const float* scale, const PeerIdx& ix, int jb, int lane) {
#pragma unroll
    for (int q = 0; q < 8; ++q) {
        const int e = __builtin_amdgcn_readlane(jb < 64 ? ix.e0 : ix.e1, (jb + q) & 63);
        b.r[q] = *(const u32x4*)(tab + (size_t)e * 1024 + 16 * lane);
        b.sc[q] = scale[e];
    }
}
struct Rows16h { u32x4 r[8]; float sc[8]; };
__device__ __forceinline__ void peer_rows16h(Rows16h& b, const unsigned char* tab, const float* scale, const PeerIdx& ix, int jb, int lane) {
    const int hh = lane >> 5, l5 = lane & 31;
#pragma unroll
    for (int i = 0; i < 8; ++i) {
        const int ee = __builtin_amdgcn_readlane(jb < 64 ? ix.e0 : ix.e1, (jb + 2 * i) & 63);
        const int eo = __builtin_amdgcn_readlane(jb < 64 ? ix.e0 : ix.e1, (jb + 2 * i + 1) & 63);
        const int e = hh ? eo : ee;
        b.r[i] = *(const u32x4*)(tab + (size_t)e * 512 + 16 * l5);
        b.sc[i] = scale[e];
    }
}
__device__ __forceinline__ void stage_scales(const float* src, char* smem) {
    for (int i = tidx(); i < 4096; i += NTHR) ((f32x4*)smem)[i] = ((const f32x4*)src)[i];
    __syncthreads();
}
__device__ __forceinline__ int peer_down_reduce8(const int (&dot)[8], int lane) {
    const int b4 = lane & 16, b3 = lane & 8, b2 = lane & 4;
    int k4[4], k2[2];
#pragma unroll
    for (int j = 0; j < 4; ++j) { const int snd = b4 ? dot[j] : dot[j + 4]; k4[j] = (b4 ? dot[j + 4] : dot[j]) + __shfl_xor(snd, 16); }
#pragma unroll
    for (int j = 0; j < 2; ++j) { const int snd = b3 ? k4[j] : k4[j + 2]; k2[j] = (b3 ? k4[j + 2] : k4[j]) + __shfl_xor(snd, 8); }
    const int snd = b2 ? k2[0] : k2[1];
    int v = (b2 ? k2[1] : k2[0]) + __shfl_xor(snd, 4);
    v += __shfl_xor(v, 2); v += __shfl_xor(v, 1);
    return v;
}
struct DownIn { u32x4 hraw[4]; };
__device__ __forceinline__ void down_in_load(DownIn& d, const P& p, int t, int lane) {
    const bf16_t* hrow = (const bf16_t*)(p.ws + WS_H) + (size_t)t * D + 32 * (lane & 31);
#pragma unroll
    for (int i = 0; i < 4; ++i) d.hraw[i] = *(const u32x4*)(hrow + 8 * i);
}
struct SlotRec { unsigned rc0, rc1; };
__device__ __forceinline__ void rec_load(SlotRec& r, const unsigned char* ws, size_t base, int t, int lane) {
    const unsigned* ex = (const unsigned*)(ws + base) + (size_t)t * 128;
    r.rc0 = ex[lane]; r.rc1 = ex[64 + lane];
}
#define PEER_PAIR_LOAD(dst, tab, e0v, e1v, m) do { \
    const int ee_ = __builtin_amdgcn_readlane((m) < 32 ? (e0v) : (e1v), (2 * (m)) & 63), eo_ = __builtin_amdgcn_readlane((m) < 32 ? (e0v) : (e1v), (2 * (m) + 1) & 63); \
    dst = *(const u32x4*)((tab) + ((unsigned)(hh ? eo_ : ee_) * 512u + l5off)); } while (0)
template <int MODE = 0>
__device__ __forceinline__ void peer_down_pass(const P& p, char* smem, int bid, int nblk) {
    const int tid = tidx(), lane = tid & 63, wid = tid >> 6, hh = lane >> 5;
    const unsigned l5off0 = 16u * (lane & 31);
    stage_scales((const float*)(p.ws + WS_RSD), smem);
    const float* RSD = (const float*)smem;
    const unsigned char* ED = p.ws + WS_ED;
    const int t0 = bid * NWAVE + wid, tstep = nblk * NWAVE;
    if (t0 < T) {
        DownIn din; SlotRec rec, recn;
        rec_load(rec, p.ws, WS_EXP, t0, lane);
        rec_load(recn, p.ws, WS_EXP, t0 + tstep < T ? t0 + tstep : t0, lane);
        down_in_load(din, p, t0, lane);
#pragma unroll
        for (int i = 0; i < 4; ++i) asm volatile("" : "+v"(din.hraw[i]));
        asm volatile("" : "+v"(recn.rc0), "+v"(recn.rc1));
        u32x4 ring[32];
        {
            const int e0 = (int)(rec.rc0 & 0xffffu);
            const unsigned l5off = l5off0;
#pragma unroll
            for (int m = 0; m < 32; ++m) { PEER_PAIR_LOAD(ring[m], ED, e0, e0, m); __builtin_amdgcn_sched_barrier(0); }
        }
#pragma unroll 1
        for (int t = t0; t < T; t += tstep) {
            const unsigned rc0 = rec.rc0, rc1 = rec.rc1;
            const int idmask = MODE == 3 ? (nblk >> 20) : 0xffff;
            const int e1 = (int)(rc1 & idmask), e0n = (int)(recn.rc0 & idmask);
            rec = recn;
            rec_load(recn, p.ws, WS_EXP, t + 2 * tstep < T ? t + 2 * tstep : t, lane);
            float mx = 0.f;
#pragma unroll
            for (int i = 0; i < 4; ++i)
#pragma unroll
                for (int k = 0; k < 4; ++k) mx = fmaxf(mx, fmaxf(fabsf(bf_lo(din.hraw[i][k])), fabsf(bf_hi(din.hraw[i][k]))));
            mx = wave_max(mx);
            const float qs = mx > 0.f ? 119.f / mx : 1.f, hscale = mx > 0.f ? mx * (1.f / 119.f) : 1.f;
            float hsum = 0.f;
            unsigned Hhi[4], Hlo[4];
#pragma unroll
            for (int d = 0; d < 4; ++d) {
                float ve[4], vo[4];
#pragma unroll
                for (int k = 0; k < 4; ++k) { ve[k] = __builtin_rintf(bf_lo(din.hraw[d][k]) * qs); vo[k] = __builtin_rintf(bf_hi(din.hraw[d][k]) * qs); hsum += ve[k] + vo[k]; }
                const unsigned E = pack_i8x4(ve[0], ve[1], ve[2], ve[3]), O = pack_i8x4(vo[0], vo[1], vo[2], vo[3]);
                const unsigned tE = ((E & 0x7f7f7f7fu) + 0x08080808u) ^ (E & 0x80808080u), tO = ((O & 0x7f7f7f7fu) + 0x08080808u) ^ (O & 0x80808080u);
                Hhi[d] = ((tE >> 4) & 0x0f0f0f0fu) | (tO & 0xf0f0f0f0u);
                Hlo[d] = ((tE & 0x0f0f0f0fu) | ((tO << 4) & 0xf0f0f0f0u)) ^ 0x88888888u;
            }
            const float hbias = 0.25f * wave_sum(hsum);
            int res[8], dot[8];
#pragma unroll
            for (int n = 0; n < 64; ++n) {
                u32x4& rr = ring[n & 31];
                if (MODE == 1) dot[n & 7] = (int)((rr[0] ^ rr[1] ^ rr[2] ^ rr[3]) & 0xffffu);
                else {
                    int sh = 0, sl = 0;
#pragma unroll
                    for (int d = 0; d < 4; ++d) {
                        sh = __builtin_amdgcn_sdot8((int)rr[d], (int)Hhi[d], sh, false);
                        sl = __builtin_amdgcn_sdot8((int)rr[d], (int)Hlo[d], sl, false);
                    }
                    dot[n & 7] = (sh << 4) + sl;
                }
                if (MODE != 2) {
                    unsigned l5off = l5off0; asm volatile("" : "+v"(l5off) : "v"(dot[n & 7]));
                    if (n < 32) PEER_PAIR_LOAD(rr, ED, e1, e1, n + 32);
                    else        PEER_PAIR_LOAD(rr, ED, e0n, e0n, n - 32);
                    __builtin_amdgcn_sched_barrier(0);
                }
                if ((n & 7) == 7) res[n >> 3] = peer_down_reduce8(dot, lane);
                if (n == 31) down_in_load(din, p, t + tstep < T ? t + tstep : t, lane);
            }
            const int sl = (lane & 1) * 32 + ((lane >> 1) & 7) * 4, bsel = lane >> 4;
            int i0 = __shfl(res[0], sl), i1 = __shfl(res[4], sl);
#pragma unroll
            for (int k = 1; k < 4; ++k) { const int x0 = __shfl(res[k], sl), x1 = __shfl(res[4 + k], sl); i0 = bsel == k ? x0 : i0; i1 = bsel == k ? x1 : i1; }
            const float s0 = ((float)i0 + hbias) * (RSD[rc0 & 0xffffu] * hscale), s1 = ((float)i1 + hbias) * (RSD[rc1 & 0xffffu] * hscale);
            unsigned* act = (unsigned*)(p.ws + WS_ACT) + (size_t)t * 128;
            act[lane] = (rc0 & 0xffffu) | (cvt_pk_bf16(gelu_erf(s0) * bf_hi(rc0), 0.f) << 16); act[64 + lane] = (rc1 & 0xffffu) | (cvt_pk_bf16(gelu_erf(s1) * bf_hi(rc1), 0.f) << 16);
        }
    }
    __syncthreads();
}
__device__ __forceinline__ int xor32_geti(int v, int hh) { auto rr = __builtin_amdgcn_permlane32_swap((unsigned)v, (unsigned)v, false, false); return (int)(hh ? rr[0] : rr[1]); }
__device__ __forceinline__ unsigned up_pack_coef(int q) {
    const int a2 = __builtin_amdgcn_update_dpp(0, q, 0x102, 0xf, 0xf, true), a4 = __builtin_amdgcn_update_dpp(0, q, 0x104, 0xf, 0xf, true), a6 = __builtin_amdgcn_update_dpp(0, q, 0x106, 0xf, 0xf, true);
    return ((unsigned)q & 0xffu) | (((unsigned)a2 & 0xffu) << 8) | (((unsigned)a4 & 0xffu) << 16) | ((unsigned)a6 << 24);
}
constexpr int UPG = 4;
template <int MODE = 0>
__device__ __forceinline__ void peer_up_pass(const P& p, char* smem, int bid, int nblk, float* outbuf) {
    const int tid = tidx(), lane = tid & 63, wid = tid >> 6, hh = lane >> 5;
    const unsigned l5off0 = 16u * (lane & 31);
    float* RSU = (float*)smem; float* GF = RSU + 16384; float* GT = GF + 1024;
    for (int i = tid; i < 4096; i += NTHR) ((f32x4*)RSU)[i] = ((const f32x4*)(p.ws + WS_RSU))[i];
    for (int i = tid; i < 256; i += NTHR) ((f32x4*)GF)[i] = ((const f32x4*)p.g_final)[i];
    for (int i = tid; i < 1024; i += NTHR) ((f32x4*)GT)[i] = *(const f32x4*)((const float*)(p.ws + WS_MOD) + (i >> 8) * NMOD + 5120 + 4 * (i & 255));
    __syncthreads();
    const unsigned char* EU = p.ws + WS_EU;
    const int col = 32 * (lane & 31) + 16 * hh;
    const int t0 = bid * NWAVE + wid, tstep = nblk * NWAVE;
    if (t0 < T) {
        SlotRec rec, recn;
        rec_load(rec, p.ws, WS_ACT, t0, lane);
        rec_load(recn, p.ws, WS_ACT, t0 + tstep < T ? t0 + tstep : t0, lane);
        asm volatile("" : "+v"(recn.rc0), "+v"(recn.rc1));
        u32x4 ring[4 * UPG];
        {
            const int e0 = (int)(rec.rc0 & 0xffffu);
            const unsigned l5off = l5off0;
#pragma unroll
            for (int m = 0; m < 4 * UPG; ++m) { PEER_PAIR_LOAD(ring[m], EU, e0, e0, m); __builtin_amdgcn_sched_barrier(0); }
        }
#pragma unroll 1
        for (int t = t0; t < T; t += tstep) {
            const unsigned rc0 = rec.rc0, rc1 = rec.rc1;
            const int e0 = (int)(rc0 & 0xffffu), e1 = (int)(rc1 & 0xffffu), e0n = (int)(recn.rc0 & 0xffffu);
            rec = recn;
            rec_load(recn, p.ws, WS_ACT, t + 2 * tstep < T ? t + 2 * tstep : t, lane);
            const float c0 = bf_hi(rc0) * RSU[rc0 & 0xffffu], c1 = bf_hi(rc1) * RSU[rc1 & 0xffffu];
            const float cmx = wave_max(fmaxf(fabsf(c0), fabsf(c1)));
            const float qs = cmx > 0.f ? 127.f * __builtin_amdgcn_rcpf(cmx) : 0.f, cstep = cmx * (1.f / 127.f);
            const int q0 = (int)__builtin_rintf(c0 * qs), q1 = (int)__builtin_rintf(c1 * qs);
            const float S = wave_sum((float)(q0 + q1));
            const unsigned P0 = up_pack_coef(q0), P1 = up_pack_coef(q1);
            int accF[16], accL[16];
#pragma unroll
            for (int i = 0; i < 16; ++i) { accF[i] = 0; accL[i] = 0; }
            u32x4 xa, xb;
#pragma unroll
            for (int G = 0; G < 16; ++G) {
                u32x4 (&r)[4] = *(u32x4 (*)[4])&ring[4 * (G % UPG)];
                if (MODE == 1) {
#pragma unroll
                    for (int k = 0; k < 4; ++k)
#pragma unroll
                        for (int d = 0; d < 4; ++d) accF[4 * k + d] ^= (int)r[k][d];
                } else {
                    const int ce = __builtin_amdgcn_readlane((int)(G < 8 ? P0 : P1), (8 * G) & 63), co = __builtin_amdgcn_readlane((int)(G < 8 ? P0 : P1), (8 * G + 1) & 63);
                    const int C = hh ? co : ce;
#pragma unroll
                    for (int d = 0; d < 4; ++d) {
                        const unsigned p01l = __builtin_amdgcn_perm(r[1][d], r[0][d], 0x05010400u), p01h = __builtin_amdgcn_perm(r[1][d], r[0][d], 0x07030602u);
                        const unsigned p23l = __builtin_amdgcn_perm(r[3][d], r[2][d], 0x05010400u), p23h = __builtin_amdgcn_perm(r[3][d], r[2][d], 0x07030602u);
                        unsigned tb[4];
                        tb[0] = __builtin_amdgcn_perm(p23l, p01l, 0x05040100u); tb[1] = __builtin_amdgcn_perm(p23l, p01l, 0x07060302u);
                        tb[2] = __builtin_amdgcn_perm(p23h, p01h, 0x05040100u); tb[3] = __builtin_amdgcn_perm(p23h, p01h, 0x07060302u);
#pragma unroll
                        for (int b = 0; b < 4; ++b) {
                            accF[4 * d + b] = __builtin_amdgcn_sdot4((int)tb[b], C, accF[4 * d + b], false);
                            accL[4 * d + b] = __builtin_amdgcn_sdot4((int)(tb[b] & 0x0f0f0f0fu), C, accL[4 * d + b], false);
                        }
                    }
                }
                if (MODE != 2) {
                    unsigned l5off = l5off0; asm volatile("" : "+v"(l5off) : "v"(accL[15]));
#pragma unroll
                    for (int k = 0; k < 4; ++k) {
                        if (G + UPG < 16) PEER_PAIR_LOAD(r[k], EU, e0, e1, 4 * (G + UPG) + k);
                        else              PEER_PAIR_LOAD(r[k], EU, e0n, e0n, 4 * (G + UPG - 16) + k);
                    }
                    __builtin_amdgcn_sched_barrier(0);
                }
                if (G == 11) {
                    const bf16_t* xrow = (const bf16_t*)(p.ws + WS_X1) + (size_t)t * D + col;
                    xa = *(const u32x4*)xrow; xb = *(const u32x4*)(xrow + 8);
                }
            }
            float tot[16];
#pragma unroll
            for (int j = 0; j < 8; ++j) {
                const int F = (hh ? accF[8 + j] : accF[j]) + xor32_geti(hh ? accF[j] : accF[8 + j], hh);
                const int L = (hh ? accL[8 + j] : accL[j]) + xor32_geti(hh ? accL[j] : accL[8 + j], hh);
                tot[2 * j] = ((float)L - 7.5f * S) * cstep;
                tot[2 * j + 1] = ((float)(F - L) * 0.0625f + 0.5f * S) * cstep;
            }
            float xv[16];
#pragma unroll
            for (int i = 0; i < 4; ++i) { xv[2 * i] = bf_lo(xa[i]); xv[2 * i + 1] = bf_hi(xa[i]); xv[8 + 2 * i] = bf_lo(xb[i]); xv[8 + 2 * i + 1] = bf_hi(xb[i]); }
            const float* gt = GT + (t >> 13) * 1024 + col;
            f32x4 x2[4]; float ss = 0.f;
#pragma unroll
            for (int i = 0; i < 4; ++i) {
                const f32x4 g = *(const f32x4*)(gt + 4 * i);
#pragma unroll
                for (int e = 0; e < 4; ++e) { const float y = xv[4 * i + e] + g[e] * tot[4 * i + e]; x2[i][e] = y; ss += y * y; }
            }
            const float inv = rsqrtf(wave_sum(ss) * (1.f / D) + EPS);
#pragma unroll
            for (int i = 0; i < 4; ++i) *(f32x4*)(outbuf + (size_t)t * D + col + 4 * i) = x2[i] * inv * *(const f32x4*)(GF + col + 4 * i);
        }
    }
}

#define XB_TMO      128
#define XB_XCNT(j)  (256  + 64 * (j))
#define XB_XSUB(j)  (1280 + 64 * (j))
#define XB_XGEN(j)  (2304 + 64 * (j))
#define XB_TOP      3328
#define XB_TOPGEN   3392
#define XCD_BAR_WORDS 3456
#define XB_SPIN_CAP (1u << 18)
__device__ __forceinline__ unsigned xb_ld(unsigned* p)              { return __hip_atomic_load(p, __ATOMIC_RELAXED, __HIP_MEMORY_SCOPE_AGENT); }
__device__ __forceinline__ unsigned xb_add(unsigned* p, unsigned v) { return __hip_atomic_fetch_add(p, v, __ATOMIC_RELAXED, __HIP_MEMORY_SCOPE_AGENT); }
__device__ __forceinline__ unsigned xb_xcc_id() { return (unsigned)__builtin_amdgcn_s_getreg((3 << 11) | 20) & 0xFu; }
#define XB_SPIN(cond, bar) do { unsigned _sp = 0; while (cond) { __builtin_amdgcn_s_sleep(1); \
    if ((++_sp & 255u) == 0u) { if (xb_ld(&(bar)[XB_TMO])) break; if (_sp > XB_SPIN_CAP) { atomicAdd(&(bar)[XB_TMO], 1u); break; } } } } while (0)
struct XcdBarrier { unsigned* bar; unsigned x; volatile unsigned* st; };
__device__ __forceinline__ XcdBarrier xcd_barrier_post(unsigned* bar, volatile unsigned* st) {
    XcdBarrier b; b.bar = bar; b.x = xb_xcc_id(); b.st = st;
    if (threadIdx.x == 0) (void)xb_add(&bar[XB_XCNT(b.x)], 1u);
    return b;
}
__device__ __forceinline__ void xcd_barrier_complete(unsigned* bar, unsigned x, unsigned& nloc, unsigned& nx) {
    const unsigned G = gridDim.x * gridDim.y * gridDim.z;
    unsigned sum, cnt, mine, sp = 0u;
    for (;;) {
        sum = 0u; cnt = 0u; mine = 0u;
#pragma unroll
        for (unsigned j = 0; j < 16; ++j) { const unsigned c = xb_ld(&bar[XB_XCNT(j)]); sum += c; cnt += (c > 0u) ? 1u : 0u; mine = (j == x) ? c : mine; }
        if (sum == G) break;
        __builtin_amdgcn_s_sleep(1);
        if ((++sp & 255u) == 0u) { if (xb_ld(&bar[XB_TMO])) break; if (sp > XB_SPIN_CAP) { atomicAdd(&bar[XB_TMO], 1u); break; } }
    }
    nloc = mine > 0u ? mine : 1u; nx = cnt > 0u ? cnt : 1u;
}
__device__ __forceinline__ void xcd_barrier(const XcdBarrier& b) {
    asm volatile("s_waitcnt vmcnt(0)" ::: "memory");
    __syncthreads();
    if (threadIdx.x == 0) {
        unsigned* bar = b.bar;
        __builtin_amdgcn_s_waitcnt(0);
        unsigned nloc = b.st[0], nx = b.st[1];
        if (nloc == 0u) { xcd_barrier_complete(bar, b.x, nloc, nx); b.st[0] = nloc; b.st[1] = nx; }
        const unsigned old = xb_add(&bar[XB_XSUB(b.x)], 1u);
        const unsigned gen = old / nloc;
        if (old + 1u == (gen + 1u) * nloc) {
            __builtin_amdgcn_fence(__ATOMIC_RELEASE, "agent");
            asm volatile("s_waitcnt vmcnt(0)" ::: "memory");
            const unsigned og = xb_add(&bar[XB_TOP], 1u);
            const unsigned tg = og / nx;
            if (og + 1u == (tg + 1u) * nx) xb_add(&bar[XB_TOPGEN], 1u);
            else XB_SPIN(xb_ld(&bar[XB_TOPGEN]) == tg, bar);
            __builtin_amdgcn_fence(__ATOMIC_ACQUIRE, "agent");
            xb_add(&bar[XB_XGEN(b.x)], 1u);
            asm volatile("s_waitcnt vmcnt(0)" ::: "memory");
        } else {
            XB_SPIN(xb_ld(&bar[XB_XGEN(b.x)]) == gen, bar);
            __builtin_amdgcn_fence(__ATOMIC_ACQUIRE, "agent");
            asm volatile("s_waitcnt vmcnt(0)" ::: "memory");
        }
    }
    __syncthreads();
}

__global__ void __launch_bounds__(NTHR, 2) mega_kernel(P p) {
    extern __shared__ __attribute__((aligned(16))) char smem[];
    const int bid = blockIdx.x, nblk = gridDim.x;
    volatile unsigned* st = (volatile unsigned*)(smem + STAGE_LDS);
    if (threadIdx.x < 16) st[threadIdx.x] = 0u;
    __syncthreads();
    const XcdBarrier bar = xcd_barrier_post((unsigned*)(p.ws + WS_BAR), st);
    p0_mod(p, smem, bid, nblk);
    xcd_barrier(bar);
    p0_convert(p, smem, bid, nblk);
    p1_norm1(p, smem, bid, nblk);
#if PROBE_DUP == 1
    __syncthreads(); p1_norm1(p, smem, bid, nblk);
#endif
#if PROBE_DUP == 0
    __syncthreads(); p0_convert(p, smem, bid, nblk);
#endif
    xcd_barrier(bar);
    gemm_proj(p, smem);
#if PROBE_DUP == 2
    gemm_proj(p, smem);
#endif
    xcd_barrier(bar);
    attn_phase(p, smem, bid, nblk);
#if PROBE_DUP == 3
    attn_phase(p, smem, bid, nblk, 1);
#endif
#if PROBE_DUP == 33
    attn_phase<1>(p, smem, bid, nblk, 1);
#endif
    xcd_barrier(bar);
    gemm_out(p, smem);
#if PROBE_DUP == 4
    gemm_out(p, smem);
#endif
    xcd_barrier(bar);
    p5_norm2(p, bid, nblk);
#if PROBE_DUP == 5
    p5_norm2(p, bid, nblk);
#endif
    xcd_barrier(bar);
    gemm_query(p, smem);
#if PROBE_DUP == 6
    gemm_query(p, smem);
#endif
    xcd_barrier(bar);
    topk_phase(p, smem, bid, nblk);
#if PROBE_DUP == 7
    topk_phase(p, smem, bid, nblk);
#endif
    xcd_barrier(bar);
#if PROBE_DUP == 8
    peer_down_pass(p, smem, bid, nblk);
#endif
#if PROBE_DUP == 9
    peer_down_pass(p, smem, bid, nblk); xcd_barrier(bar);
    peer_up_pass(p, smem, bid, nblk, (float*)(p.ws + WS_QF));
#endif
#if PROBE_DUP == 13
    peer_down_pass<1>(p, smem, bid, nblk);
#endif
#if PROBE_DUP == 14
    peer_down_pass<2>(p, smem, bid, nblk);
#endif
#if PROBE_DUP == 15
    peer_down_pass<3>(p, smem, bid, nblk);
#endif
#if PROBE_DUP == 16
    peer_down_pass<0>(p, smem, bid, nblk);
#endif
    peer_down_pass(p, smem, bid, nblk);
    xcd_barrier(bar);
#if PROBE_DUP == 10
    peer_up_pass<0>(p, smem, bid, nblk, p.out); __syncthreads();
#endif
#if PROBE_DUP == 11
    peer_up_pass<1>(p, smem, bid, nblk, p.out); __syncthreads();
#endif
#if PROBE_DUP == 12
    peer_up_pass<2>(p, smem, bid, nblk, p.out); __syncthreads();
#endif
    peer_up_pass(p, smem, bid, nblk, p.out);
}

extern "C" void kernel_launch(void* const* d_in, const int* in_sizes, int n_in, void* d_out, int out_size, void* d_ws, size_t ws_size, hipStream_t stream) {
    if (n_in != 16 || out_size != T * D || ws_size < WS_END) { fprintf(stderr, "kernel_launch: unexpected shapes (n_in %d out %d ws %zu)\n", n_in, out_size, ws_size); return; }
    P p{};
    p.x = (const float*)d_in[0]; p.c = (const float*)d_in[1]; p.w_ada = (const float*)d_in[2]; p.b_ada = (const float*)d_in[3];
    p.g_mix = (const float*)d_in[4]; p.w_in = (const float*)d_in[5]; p.b_forget = (const float*)d_in[6]; p.g_fox = (const float*)d_in[7];
    p.g_sb = (const float*)d_in[8]; p.w_out = (const float*)d_in[9]; p.g_ffn = (const float*)d_in[10]; p.w_query = (const float*)d_in[11];
    p.sub_keys = (const float*)d_in[12]; p.e_down = (const float*)d_in[13]; p.e_up = (const float*)d_in[14]; p.g_final = (const float*)d_in[15];
    p.out = (float*)d_out; p.ws = (unsigned char*)d_ws;
    (void)hipMemsetAsync((char*)d_ws + WS_KMAX, 0, 24 * 1024, stream);
    static int grid_blocks = 0;
    if (!grid_blocks) {
        int dev = 0, cus = 0, per_cu = 0;
        (void)hipGetDevice(&dev);
        (void)hipDeviceGetAttribute(&cus, hipDeviceAttributeMultiprocessorCount, dev);
        (void)hipFuncSetAttribute((const void*)mega_kernel, hipFuncAttributeMaxDynamicSharedMemorySize, LDS_BYTES);
        (void)hipOccupancyMaxActiveBlocksPerMultiprocessor(&per_cu, mega_kernel, NTHR, LDS_BYTES);
        if (per_cu > 1) per_cu = 1;
        grid_blocks = cus * per_cu;
        if (grid_blocks % 8) grid_blocks -= grid_blocks % 8;
    }
    void* args[] = {&p};
    hipError_t e = hipLaunchCooperativeKernel((void*)mega_kernel, dim3(grid_blocks), dim3(NTHR), args, LDS_BYTES, stream);
    if (e != hipSuccess) fprintf(stderr, "cooperative launch failed: %s (grid %d)\n", hipGetErrorString(e), grid_blocks);
}
```

```cpp
#include <hip/hip_runtime.h>
#include <hip/hip_cooperative_groups.h>
#include <cstdio>
#include <cstdint>
namespace cg = cooperative_groups;

#ifndef PROBE_DUP
#define PROBE_DUP -1
#endif

namespace pg8 {
#define PG8_LAS __attribute__((address_space(3)))
typedef unsigned short bf16_t;
typedef short bf16x8 __attribute__((ext_vector_type(8)));
typedef float f32x4 __attribute__((ext_vector_type(4)));
typedef unsigned u32x4 __attribute__((ext_vector_type(4)));
constexpr int BM = 256, BK = 64, HALF = 128, HTB = HALF * BK * 2  , STAGE_BYTES = 8 * HTB, NXCD = 8, WGM = 8;

__host__ __device__ __forceinline__ int lds_byte(int r, int c) { const int st = (r >> 4) * 2 + (c >> 5), rr = r & 15, cc = c & 31, ob = rr * 64 + cc * 2; return st * 1024 + (ob ^ (((ob >> 9) & 1) << 5)); }
__host__ __device__ __forceinline__ void stage_rc(int b, int& R, int& C) { const int st = b / 1024, sb = b % 1024, swz = sb ^ (((sb >> 9) & 1) << 5); R = (st >> 1) * 16 + swz / 64; C = (st & 1) * 32 + (swz % 64) / 2; }
__host__ __device__ __forceinline__ int perm32(int rho) { const int n = rho >> 4, i = rho & 15; return 8 * (i >> 2) + 4 * n + (i & 3); }

struct Unit { int pm, pn, seg; };
struct Gemm { const bf16_t* A; const bf16_t* Bt; int M, N, K; size_t bbatch; };

struct StaticOrder {
    int nM, nN, nwg, G, c;
    __host__ __device__ void init(int M, int N, int G_, int c_) { nM = M / BM; nN = N / BM; nwg = nM * nN; G = G_; c = c_; }
    __host__ __device__ bool next(int i, Unit& u) const { u.seg = 0; return map((long)i * G + c, u); }
    __host__ __device__ bool map(long L, Unit& u) const {
        if (L >= nwg) return false;
        int wgid = (int)L; { const int q = nwg / NXCD, r = nwg % NXCD, xcd = wgid % NXCD, off = wgid / NXCD; wgid = (xcd < r ? xcd * (q + 1) : r * (q + 1) + (xcd - r) * q) + off; }
        const int nig = WGM * nN, gid = wgid / nig, fm = gid * WGM, gsz = (nM - fm) < WGM ? (nM - fm) : WGM;
        u.pm = fm + ((wgid % nig) % gsz); u.pn = (wgid % nig) / gsz; return true;
    }
    __device__ __forceinline__ void a_ready(const Unit&) const {}
    __device__ __forceinline__ void done(const Unit&) const {}
};
struct ChainOrder {
    StaticOrder a, b;
    __host__ __device__ bool next(int i, Unit& u) const {
        const long L = (long)i * a.G + a.c;
        if (L < a.nwg) { u.seg = 0; return a.map(L, u); }
        u.seg = 1; return b.map(L - a.nwg, u);
    }
    __device__ __forceinline__ void a_ready(const Unit&) const {}
    __device__ __forceinline__ void done(const Unit&) const {}
};
template <class Epi, class Sched, bool ALIGN_EPI = false, bool SP2 = false, class Epi2 = Epi>
__device__ __forceinline__ void gemm_phase(PG8_LAS unsigned char* lds, const Gemm g, const Sched& S, const Epi& E, const Gemm g2, const Epi2& E2) {
    int tid = threadIdx.x; asm volatile("" : "+v"(tid));
    const int wid = __builtin_amdgcn_readfirstlane(tid >> 6), lane = tid & 63, wr = wid >> 2, wc = wid & 3, fr = lane & 15, fq = lane >> 4;
    const int K = g.K, nt = K / BK;
    unsigned voffA, voffB;
    { int R, C; stage_rc(tid * 16, R, C); const int Rb = Epi::PERM ? ((R & ~31) + perm32(R & 31)) : R; voffA = (unsigned)(R * K + C) * 2u; voffB = (unsigned)(Rb * K + C) * 2u; }
    const size_t pstep = (size_t)64 * K * 2;
    const size_t kstep = (size_t)(BK * 2);
    const size_t hstep = (size_t)HALF * K * 2;
    const size_t tstep = 2 * hstep;
    const unsigned ldsw = (unsigned)wid * 1024u;
    const int aoff = lds_byte(wr * 64 + fr, fq * 8), boff = lds_byte(wc * 32 + fr, fq * 8);
#define PG8_SA(b, h) (((b) * 2 + (h)) * HTB)
#define PG8_SB(b, h) ((4 + (b) * 2 + (h)) * HTB)
#define PG8_STAGE(bufoff, gbase, voff) do { _Pragma("unroll") for (int _i = 0; _i < 2; ++_i) \
        __builtin_amdgcn_global_load_lds((const unsigned*)((const char*)(gbase) + _i * pstep + (voff)), (PG8_LAS unsigned*)(lds + (bufoff) + ldsw + _i * 8192), 16, 0, 0); } while (0)
#define PG8_LDA(dst, b, h) do { _Pragma("unroll") for (int m = 0; m < 4; ++m) _Pragma("unroll") for (int k = 0; k < 2; ++k) dst[m][k] = *(const PG8_LAS bf16x8*)(lds + PG8_SA(b, h) + aoff + m * 2048 + k * 1024); } while (0)
#define PG8_LDB(dst, b, h) do { _Pragma("unroll") for (int n = 0; n < 2; ++n) _Pragma("unroll") for (int k = 0; k < 2; ++k) dst[n][k] = *(const PG8_LAS bf16x8*)(lds + PG8_SB(b, h) + boff + n * 2048 + k * 1024); } while (0)
#define PG8_MMA(ai, bj, At, Bt) do { __builtin_amdgcn_s_setprio(1); _Pragma("unroll") for (int m = 0; m < 4; ++m) _Pragma("unroll") for (int n = 0; n < 2; ++n) _Pragma("unroll") for (int k = 0; k < 2; ++k) \
        acc[ai][bj][m][n] = __builtin_amdgcn_mfma_f32_16x16x32_bf16(Bt[n][k], At[m][k], acc[ai][bj][m][n], 0, 0, 0); __builtin_amdgcn_s_setprio(0); } while (0)
#define PG8_WAIT_V(n) asm volatile("s_waitcnt vmcnt(" #n ")" ::: "memory")
#define PG8_WAIT_L(n) asm volatile("s_waitcnt lgkmcnt(" #n ")" ::: "memory")
#define PG8_BAR __builtin_amdgcn_s_barrier()
#define PG8_SCHED __builtin_amdgcn_sched_barrier(0)
    Unit cur, nxt; int ui = 0;
    if (!S.next(0, cur)) return;
    f32x4 acc[2][2][4][2];
#pragma unroll
    for (int a = 0; a < 2; ++a)
#pragma unroll
        for (int b = 0; b < 2; ++b)
#pragma unroll
            for (int m = 0; m < 4; ++m)
#pragma unroll
                for (int n = 0; n < 2; ++n) acc[a][b][m][n] = (f32x4){0.f, 0.f, 0.f, 0.f};
    bf16x8 At[4][2], B0[2][2], B1[2][2];
    const char* cA = (const char*)(cur.seg ? g2.A : g.A) + (size_t)cur.pm * tstep; const char* cB = (const char*)(cur.seg ? g2.Bt : g.Bt) + (size_t)cur.pn * tstep + (size_t)(cur.pm >> 5) * (cur.seg ? g2.bbatch : g.bbatch);
    S.a_ready(cur);
    if constexpr (SP2) {
        PG8_STAGE(PG8_SB(0, 0), cB, voffB); PG8_STAGE(PG8_SB(0, 1), cB + hstep, voffB); PG8_STAGE(PG8_SA(0, 0), cA, voffA); PG8_STAGE(PG8_SA(0, 1), cA + hstep, voffA);
        if (wr == 1) PG8_BAR;
        PG8_WAIT_V(2); PG8_BAR;
        PG8_STAGE(PG8_SB(1, 0), cB + kstep, voffB); PG8_STAGE(PG8_SA(1, 0), cA + kstep, voffA); PG8_STAGE(PG8_SB(1, 1), cB + hstep + kstep, voffB);
        PG8_WAIT_V(6); PG8_BAR;
    } else {
        PG8_STAGE(PG8_SB(0, 0), cB, voffB); PG8_STAGE(PG8_SA(0, 0), cA, voffA); PG8_STAGE(PG8_SB(0, 1), cB + hstep, voffB); PG8_STAGE(PG8_SA(0, 1), cA + hstep, voffA);
        if (wr == 1) PG8_BAR;
        PG8_WAIT_V(4); PG8_BAR;
        PG8_STAGE(PG8_SB(1, 0), cB + kstep, voffB); PG8_STAGE(PG8_SA(1, 0), cA + kstep, voffA); PG8_STAGE(PG8_SB(1, 1), cB + hstep + kstep, voffB);
        PG8_WAIT_V(6); PG8_BAR;
    }
    for (;;) {
        const bool has_next = S.next(ui + 1, nxt);
        const char* nA = has_next ? (const char*)(nxt.seg ? g2.A : g.A) + (size_t)nxt.pm * tstep : cA; const char* nB = has_next ? (const char*)(nxt.seg ? g2.Bt : g.Bt) + (size_t)nxt.pn * tstep + (size_t)(nxt.pm >> 5) * (nxt.seg ? g2.bbatch : g.bbatch) : cB;
        for (int t = 0; t < nt; t += 2) {
            const bool last = (t == nt - 2);
            const char* a1 = cA + (size_t)(t + 1) * kstep;
            const char* a2 = last ? nA : cA + (size_t)(t + 2) * kstep; const char* b2 = last ? nB : cB + (size_t)(t + 2) * kstep;
            const char* a3 = a2 + kstep; const char* b3 = b2 + kstep;
            if (last && has_next) S.a_ready(nxt);
            if constexpr (SP2) {
            PG8_LDB(B0, 0, 0); PG8_LDB(B1, 0, 1); PG8_SCHED; PG8_LDA(At, 0, 0); PG8_STAGE(PG8_SA(1, 1), a1 + hstep, voffA);
            PG8_WAIT_V(8); PG8_WAIT_L(0); PG8_BAR; PG8_MMA(0, 0, At, B0); PG8_MMA(0, 1, At, B1); PG8_BAR; PG8_SCHED;
            PG8_LDA(At, 0, 1); PG8_STAGE(PG8_SB(0, 0), b2, voffB); PG8_STAGE(PG8_SB(0, 1), b2 + hstep, voffB); PG8_STAGE(PG8_SA(0, 0), a2, voffA);
            PG8_WAIT_V(8); PG8_WAIT_L(0); PG8_BAR; PG8_MMA(1, 0, At, B0); PG8_MMA(1, 1, At, B1); PG8_BAR; PG8_SCHED;
            PG8_LDB(B0, 1, 0); PG8_LDB(B1, 1, 1); PG8_SCHED; PG8_LDA(At, 1, 0); PG8_STAGE(PG8_SA(0, 1), a2 + hstep, voffA);
            PG8_WAIT_V(8); PG8_WAIT_L(0); PG8_BAR; PG8_MMA(0, 0, At, B0); PG8_MMA(0, 1, At, B1); PG8_BAR; PG8_SCHED;
            PG8_LDA(At, 1, 1); PG8_STAGE(PG8_SB(1, 0), b3, voffB); PG8_STAGE(PG8_SB(1, 1), b3 + hstep, voffB); PG8_STAGE(PG8_SA(1, 0), a3, voffA);
            PG8_WAIT_V(8); PG8_WAIT_L(0); PG8_BAR; PG8_MMA(1, 0, At, B0); PG8_MMA(1, 1, At, B1); PG8_BAR; PG8_SCHED;
            } else {
            PG8_LDB(B0, 0, 0); PG8_SCHED; PG8_LDA(At, 0, 0); PG8_STAGE(PG8_SA(1, 1), a1 + hstep, voffA);
            PG8_WAIT_L(8); PG8_BAR; PG8_WAIT_L(0); PG8_MMA(0, 0, At, B0); PG8_BAR; PG8_SCHED;
            PG8_LDB(B1, 0, 1); PG8_STAGE(PG8_SB(0, 0), b2, voffB);
            PG8_BAR; PG8_WAIT_L(0); PG8_MMA(0, 1, At, B1); PG8_BAR;
            PG8_LDA(At, 0, 1); PG8_STAGE(PG8_SA(0, 0), a2, voffA);
            PG8_BAR; PG8_WAIT_L(0); PG8_MMA(1, 0, At, B0); PG8_BAR; PG8_SCHED;
            PG8_STAGE(PG8_SB(0, 1), b2 + hstep, voffB);
            PG8_WAIT_V(6); PG8_BAR; PG8_MMA(1, 1, At, B1); PG8_BAR;
            PG8_LDB(B0, 1, 0); PG8_SCHED; PG8_LDA(At, 1, 0); PG8_STAGE(PG8_SA(0, 1), a2 + hstep, voffA);
            PG8_WAIT_L(8); PG8_BAR; PG8_WAIT_L(0); PG8_MMA(0, 0, At, B0); PG8_BAR; PG8_SCHED;
            PG8_LDB(B1, 1, 1); PG8_STAGE(PG8_SB(1, 0), b3, voffB);
            PG8_BAR; PG8_WAIT_L(0); PG8_MMA(0, 1, At, B1); PG8_BAR;
            PG8_LDA(At, 1, 1); PG8_STAGE(PG8_SA(1, 0), a3, voffA);
            PG8_BAR; PG8_WAIT_L(0); PG8_MMA(1, 0, At, B0); PG8_BAR; PG8_SCHED;
            PG8_STAGE(PG8_SB(1, 1), b3 + hstep, voffB);
            PG8_WAIT_V(6); PG8_BAR; PG8_MMA(1, 1, At, B1); PG8_BAR;
            }
        }
        if constexpr (ALIGN_EPI) { if (wr == 0) PG8_BAR; }
        if constexpr (!Epi::AFTER_DRAIN) { if (cur.seg == 0) E(acc, cur, wr, wc, fr, fq); else E2(acc, cur, wr, wc, fr, fq); S.done(cur); }
        if (!has_next) break;
#pragma unroll
        for (int a = 0; a < 2; ++a)
#pragma unroll
            for (int b = 0; b < 2; ++b)
#pragma unroll
                for (int m = 0; m < 4; ++m)
#pragma unroll
                    for (int n = 0; n < 2; ++n) acc[a][b][m][n] = (f32x4){0.f, 0.f, 0.f, 0.f};
        cur = nxt; cA = nA; cB = nB; ++ui;
        if constexpr (ALIGN_EPI) { if (wr == 1) PG8_BAR; }
    }
    PG8_WAIT_V(0);
    if constexpr (!ALIGN_EPI) { if (wr == 0) PG8_BAR; }
    PG8_BAR;
    if constexpr (Epi::AFTER_DRAIN) { E.fused(acc, cur, wr, wc, fr, fq, lds, wid, lane); S.done(cur); }
#undef PG8_SA
#undef PG8_SB
#undef PG8_STAGE
#undef PG8_LDA
#undef PG8_LDB
#undef PG8_MMA
#undef PG8_WAIT_V
#undef PG8_WAIT_L
#undef PG8_BAR
#undef PG8_SCHED
}
}
typedef unsigned short bf16_t;
typedef short bf16x8 __attribute__((ext_vector_type(8)));
typedef float f32x16 __attribute__((ext_vector_type(16)));
typedef float f32x4 __attribute__((ext_vector_type(4)));
typedef unsigned u32x4 __attribute__((ext_vector_type(4)));
typedef unsigned u32x2 __attribute__((ext_vector_type(2)));

constexpr int D = 1024, NBATCH = 4, SEQ = 8192, T = NBATCH * SEQ;
constexpr int NH = 8, HD = 64, INC = 3080, NMOD = 6144;
constexpr float EPS = 1e-6f, ATT_SCALE = 0.125f, THRESH = 26.0f, THRESH_SB = 18.0f, LOG2E = 1.4426950408889634f;
__device__ __forceinline__ float fox_thresh2(int qt) { return 29.f + __builtin_amdgcn_logf((float)(qt + 1)); }
constexpr float SC2 = ATT_SCALE * LOG2E, THRESH2 = THRESH * LOG2E, THRESH2_SB = THRESH_SB * LOG2E;

constexpr size_t MiB = 1u << 20;
constexpr size_t WS_MOD = 0, WS_KMAX = 128 * 1024, WS_BAR = 136 * 1024, WS_CTOT = 192 * 1024, WS_FLOC = 1 * MiB;
constexpr size_t WS_WQK = 2 * MiB, WS_WV = 6 * MiB, WS_WOUT = 8 * MiB, WS_WQ = 10 * MiB, WS_SK = 14 * MiB, WS_ED = 16 * MiB, WS_EU = 48 * MiB;
constexpr size_t WS_RSD = 15 * MiB, WS_RSU = 15 * MiB + 64 * 1024;
constexpr size_t WS_H = 80 * MiB, WS_QF = 144 * MiB;
constexpr size_t WS_MIX = 336 * MiB, WS_EXP = 400 * MiB, WS_GATE = 416 * MiB, WS_END = 432 * MiB;
constexpr size_t WS_X1 = 272 * MiB;
constexpr size_t WS_ACT = 144 * MiB;
constexpr size_t WS_QUERY = 144 * MiB;
constexpr size_t WS_WQB = 416 * MiB;
constexpr size_t WS_BIASQ = 512 * 1024;
constexpr size_t WS_GS2 = 576 * 1024, WS_SH2 = 592 * 1024;
constexpr size_t WS_SSQ = 80 * MiB;

struct P {
    const float *x, *c, *w_ada, *b_ada, *g_mix, *w_in, *b_forget, *g_fox, *g_sb, *w_out, *g_ffn, *w_query, *sub_keys, *e_down, *e_up, *g_final;
    float* out;
    unsigned char* ws;
};

constexpr int NWAVE = 8, NTHR = NWAVE * 64;
constexpr int STAGE_LDS = 131072;
constexpr int LDS_BYTES = 147456;

typedef __bf16 bf16v2 __attribute__((ext_vector_type(2)));
__device__ __forceinline__ unsigned cvt_pk_bf16(float lo, float hi) { bf16v2 v; v.x = (__bf16)lo; v.y = (__bf16)hi; return __builtin_bit_cast(unsigned, v); }
__device__ __forceinline__ float bf_lo(unsigned w) { return __uint_as_float(w << 16); }
__device__ __forceinline__ float bf_hi(unsigned w) { return __uint_as_float(w & 0xffff0000u); }
__device__ __forceinline__ float bf2f(bf16_t h) { return __uint_as_float(((unsigned)h) << 16); }
__device__ __forceinline__ int tidx() { int t = threadIdx.x; asm volatile("" : "+v"(t)); return t; }
template <int CTRL> __device__ __forceinline__ float dpp_f(float x) { return __builtin_bit_cast(float, __builtin_amdgcn_mov_dpp(__builtin_bit_cast(int, x), CTRL, 0xf, 0xf, true)); }
__device__ __forceinline__ float wave_sum(float v) {
    v += dpp_f<0xB1>(v); v += dpp_f<0x4E>(v); v += dpp_f<0x141>(v); v += dpp_f<0x128>(v);
    auto s = __builtin_amdgcn_permlane16_swap(__float_as_uint(v), __float_as_uint(v), false, false);
    v = __uint_as_float(s[0]) + __uint_as_float(s[1]);
    auto t = __builtin_amdgcn_permlane32_swap(__float_as_uint(v), __float_as_uint(v), false, false);
    return __uint_as_float(t[0]) + __uint_as_float(t[1]);
}
__device__ __forceinline__ float wave_max(float v) {
    v = fmaxf(v, dpp_f<0xB1>(v)); v = fmaxf(v, dpp_f<0x4E>(v)); v = fmaxf(v, dpp_f<0x141>(v)); v = fmaxf(v, dpp_f<0x128>(v));
    auto s = __builtin_amdgcn_permlane16_swap(__float_as_uint(v), __float_as_uint(v), false, false);
    v = fmaxf(__uint_as_float(s[0]), __uint_as_float(s[1]));
    auto t = __builtin_amdgcn_permlane32_swap(__float_as_uint(v), __float_as_uint(v), false, false);
    return fmaxf(__uint_as_float(t[0]), __uint_as_float(t[1]));
}
__device__ __forceinline__ float xor32_sum(float v) { auto rr = __builtin_amdgcn_permlane32_swap(__float_as_uint(v), __float_as_uint(v), false, false); return __uint_as_float(rr[0]) + __uint_as_float(rr[1]); }
__device__ __forceinline__ float xor32_max(float v) { auto rr = __builtin_amdgcn_permlane32_swap(__float_as_uint(v), __float_as_uint(v), false, false); return fmaxf(__uint_as_float(rr[0]), __uint_as_float(rr[1])); }
__device__ __forceinline__ float xor32_get(float v, int hh) { auto rr = __builtin_amdgcn_permlane32_swap(__float_as_uint(v), __float_as_uint(v), false, false); return __uint_as_float(hh ? rr[0] : rr[1]); }
__device__ __forceinline__ float log_sigmoid(float x) { return fminf(x, 0.f) - log1pf(__expf(-fabsf(x))); }
__device__ __forceinline__ void p0_transpose_item(const float* W, int K, int N, int n0src, bf16_t* WT, int row0, int k0, float* scr, int lane) {
#pragma unroll 8
    for (int i = 0; i < 32; ++i) { const int kk = 2 * i + (lane >> 5); scr[kk * 33 + (lane & 31)] = W[(size_t)(k0 + kk) * N + n0src + (lane & 31)]; }
    asm volatile("s_waitcnt lgkmcnt(0)" ::: "memory");
    asm volatile("" ::: "memory");
    const int c = lane & 7;
#pragma unroll
    for (int j = 0; j < 4; ++j) {
        const int n = (lane >> 3) + 8 * j; const float* s = scr + (8 * c) * 33 + n;
        u32x4 o; o.x = cvt_pk_bf16(s[0 * 33], s[1 * 33]); o.y = cvt_pk_bf16(s[2 * 33], s[3 * 33]); o.z = cvt_pk_bf16(s[4 * 33], s[5 * 33]); o.w = cvt_pk_bf16(s[6 * 33], s[7 * 33]);
        *(u32x4*)(WT + (size_t)(row0 + n) * K + k0 + 8 * c) = o;
    }
    asm volatile("s_waitcnt lgkmcnt(0)" ::: "memory");
    asm volatile("" ::: "memory");
}

__device__ __forceinline__ void p0_transpose_item_x4(const float* W, int K, int N, int n0, bf16_t* WT, size_t bstride, int k0, float* scr, int lane, const float* gs) {
#pragma unroll 8
    for (int i = 0; i < 32; ++i) { const int kk = 2 * i + (lane >> 5); scr[kk * 33 + (lane & 31)] = W[(size_t)(k0 + kk) * N + n0 + (lane & 31)]; }
    asm volatile("s_waitcnt lgkmcnt(0)" ::: "memory");
    asm volatile("" ::: "memory");
    const int c = lane & 7;
#pragma unroll
    for (int b = 0; b < 4; ++b) {
        const f32x4 ga = *(const f32x4*)(gs + b * 1024 + k0 + 8 * c), gb = *(const f32x4*)(gs + b * 1024 + k0 + 8 * c + 4);
#pragma unroll
        for (int j = 0; j < 4; ++j) {
            const int n = (lane >> 3) + 8 * j; const float* s = scr + (8 * c) * 33 + n;
            u32x4 o; o.x = cvt_pk_bf16(s[0 * 33] * ga[0], s[1 * 33] * ga[1]); o.y = cvt_pk_bf16(s[2 * 33] * ga[2], s[3 * 33] * ga[3]); o.z = cvt_pk_bf16(s[4 * 33] * gb[0], s[5 * 33] * gb[1]); o.w = cvt_pk_bf16(s[6 * 33] * gb[2], s[7 * 33] * gb[3]);
            *(u32x4*)(WT + b * bstride + (size_t)(n0 + n) * K + k0 + 8 * c) = o;
        }
    }
    asm volatile("s_waitcnt lgkmcnt(0)" ::: "memory");
    asm volatile("" ::: "memory");
}

__device__ __forceinline__ void cvt_stream(const float* src, bf16_t* dst, size_t n8, size_t gtid, size_t gthreads) {
    for (size_t i = gtid; i < n8; i += gthreads) {
        const f32x4 a = *(const f32x4*)(src + i * 8), b = *(const f32x4*)(src + i * 8 + 4);
        u32x4 o; o.x = cvt_pk_bf16(a.x, a.y); o.y = cvt_pk_bf16(a.z, a.w); o.z = cvt_pk_bf16(b.x, b.y); o.w = cvt_pk_bf16(b.z, b.w);
        *(u32x4*)(dst + i * 8) = o;
    }
}

typedef float f32x2 __attribute__((ext_vector_type(2)));
__device__ __forceinline__ void cvt_row_fp8(const float* src, unsigned char* dst, float* rscale, int row, int lane) {
    const f32x4* s = (const f32x4*)(src + (size_t)row * 1024 + lane * 16);
    f32x4 v[4]; float mx = 0.f;
#pragma unroll
    for (int i = 0; i < 4; ++i) { v[i] = s[i]; mx = fmaxf(mx, fmaxf(fmaxf(fabsf(v[i].x), fabsf(v[i].y)), fmaxf(fabsf(v[i].z), fabsf(v[i].w)))); }
    mx = wave_max(mx);
    const float sc = mx > 0.f ? 224.f / mx : 1.f;
    u32x4 o;
#pragma unroll
    for (int i = 0; i < 4; ++i) {
        int w = 0;
        w = __builtin_amdgcn_cvt_pk_fp8_f32(v[i].x * sc, v[i].y * sc, w, false);
        w = __builtin_amdgcn_cvt_pk_fp8_f32(v[i].z * sc, v[i].w * sc, w, true);
        o[i] = (unsigned)w;
    }
    *(u32x4*)(dst + (size_t)row * 1024 + lane * 16) = o;
    if (lane == 0) rscale[row] = mx > 0.f ? mx * (1.f / 224.f) : 1.f;
}

__device__ __forceinline__ unsigned pack_i8x4(float a, float b, float c, float d) {
    const int ia = (int)__builtin_rintf(a), ib = (int)__builtin_rintf(b), ic = (int)__builtin_rintf(c), id = (int)__builtin_rintf(d);
    return (unsigned)(ia & 0xff) | ((unsigned)(ib & 0xff) << 8) | ((unsigned)(ic & 0xff) << 16) | ((unsigned)id << 24);
}
__device__ __forceinline__ void cvt_row_i8(const float* src, unsigned char* dst, float* rscale, int row, int lane) {
    const f32x4* s = (const f32x4*)(src + (size_t)row * 1024 + lane * 16);
    f32x4 v[4]; float mx = 0.f;
#pragma unroll
    for (int i = 0; i < 4; ++i) { v[i] = s[i]; mx = fmaxf(mx, fmaxf(fmaxf(fabsf(v[i].x), fabsf(v[i].y)), fmaxf(fabsf(v[i].z), fabsf(v[i].w)))); }
    mx = wave_max(mx);
    const float sc = mx > 0.f ? 127.f / mx : 1.f;
    u32x4 o;
#pragma unroll
    for (int i = 0; i < 4; ++i) o[i] = pack_i8x4(v[i].x * sc, v[i].y * sc, v[i].z * sc, v[i].w * sc);
    *(u32x4*)(dst + (size_t)row * 1024 + lane * 16) = o;
    if (lane == 0) rscale[row] = mx > 0.f ? mx * (1.f / 127.f) : 1.f;
}
struct RowF32 { f32x4 v[4]; };
__device__ __forceinline__ void row_load(RowF32& r, const float* src, int row, int lane) {
    const f32x4* s = (const f32x4*)(src + (size_t)row * 1024 + lane * 16);
#pragma unroll
    for (int i = 0; i < 4; ++i) r.v[i] = s[i];
}
__device__ __forceinline__ void cvt_row_q4(const RowF32& r, unsigned char* dst, float* rscale, int row, int lane, unsigned flip) {
    const f32x4 (&v)[4] = r.v; float ss = 0.f;
#pragma unroll
    for (int i = 0; i < 4; ++i) ss += (v[i].x * v[i].x + v[i].y * v[i].y) + (v[i].z * v[i].z + v[i].w * v[i].w);
    ss = wave_sum(ss);
    const float step = ss > 0.f ? 0.3352f * sqrtf(ss * (1.f / 1024.f)) : 1e-30f, inv = 1.f / step;
    unsigned w[2] = {0u, 0u};
#pragma unroll
    for (int i = 0; i < 16; ++i) {
        int n = (int)floorf(v[i >> 2][i & 3] * inv) + 8;
        n = n < 0 ? 0 : (n > 15 ? 15 : n);
        w[i >> 3] |= (unsigned)n << (4 * (i & 7));
    }
    u32x2 o; o.x = w[0] ^ flip; o.y = w[1] ^ flip;
    *(u32x2*)(dst + (size_t)row * 512 + lane * 8) = o;
    if (lane == 0) rscale[row] = step;
}
__device__ __forceinline__ void p0_mod(const P& p, char* smem, int bid, int nblk) {
    const int tid = tidx(), lane = tid & 63, wid = tid >> 6;
    const int gw = bid * NWAVE + wid, NGW = nblk * NWAVE;
    float* sc = (float*)smem;
    const int ks = lane >> 2;
    float wv[64];
    const __amdgpu_buffer_rsrc_t wr = __builtin_amdgcn_make_buffer_rsrc((void*)p.w_ada, 0, 1024 * NMOD * 4, 0x00020000);
    if (gw < 1536) {
        const unsigned loff = ((unsigned)(ks * 64) * NMOD + (unsigned)(gw * 4 + (lane & 3))) * 4u;
#pragma unroll
        for (int k = 0; k < 64; ++k) wv[k] = __builtin_bit_cast(float, __builtin_amdgcn_raw_buffer_load_b32(wr, loff, k * NMOD * 4, 0));
    }
    for (int i = tid; i < 4096; i += NTHR) { const float v = p.c[i]; sc[i] = v / (1.f + __expf(-v)); }
    __syncthreads();
    float* mod = (float*)(p.ws + WS_MOD);
    for (int it = gw; it < 1536; it += NGW) {
        const int col = it * 4 + (lane & 3);
        if (it != gw) {
            const unsigned loff = ((unsigned)(ks * 64) * NMOD + (unsigned)col) * 4u;
#pragma unroll
            for (int k = 0; k < 64; ++k) wv[k] = __builtin_bit_cast(float, __builtin_amdgcn_raw_buffer_load_b32(wr, loff, k * NMOD * 4, 0));
        }
        float a0 = 0.f, a1 = 0.f, a2 = 0.f, a3 = 0.f;
#pragma unroll
        for (int k4 = 0; k4 < 16; ++k4) {
            const f32x4 s0 = *(const f32x4*)(sc + ks * 64 + 4 * k4), s1 = *(const f32x4*)(sc + 1024 + ks * 64 + 4 * k4), s2 = *(const f32x4*)(sc + 2048 + ks * 64 + 4 * k4), s3 = *(const f32x4*)(sc + 3072 + ks * 64 + 4 * k4);
#pragma unroll
            for (int e = 0; e < 4; ++e) { const float w = wv[4 * k4 + e]; a0 += s0[e] * w; a1 += s1[e] * w; a2 += s2[e] * w; a3 += s3[e] * w; }
            if (k4 & 1) __builtin_amdgcn_sched_barrier(0);
        }
#pragma unroll
        for (int o = 4; o < 64; o <<= 1) { a0 += __shfl_xor(a0, o); a1 += __shfl_xor(a1, o); a2 += __shfl_xor(a2, o); a3 += __shfl_xor(a3, o); }
        if (ks == 0) { const float bb = p.b_ada[col]; mod[col] = a0 + bb; mod[NMOD + col] = a1 + bb; mod[2 * NMOD + col] = a2 + bb; mod[3 * NMOD + col] = a3 + bb; }
    }
}
__device__ __forceinline__ void p0_convert(const P& p, char* smem, int bid, int nblk) {
    const int tid = tidx(), lane = tid & 63, wid = tid >> 6;
    const int gw = bid * NWAVE + wid, NGW = nblk * NWAVE;
    float* scr = (float*)(smem + 40960 + wid * 8448);
    const float* mod = (const float*)(p.ws + WS_MOD);
    const size_t gtid = (size_t)bid * NTHR + tid, gth = (size_t)nblk * NTHR;
    for (size_t i = gtid; i < 4096; i += gth) { const float* mb = mod + (i >> 10) * NMOD; ((float*)(p.ws + WS_GS2))[i] = p.g_ffn[i & 1023] * (1.f + mb[4096 + (i & 1023)]); ((float*)(p.ws + WS_SH2))[i] = mb[3072 + (i & 1023)]; }
    for (int it = gw; it < 1536; it += NGW) {
        const int kb = it / 96, nb = it % 96, seg = nb >> 4, nn = (nb & 15) * 32;
        const int srccol = seg * 512 + nn + (seg >= 3 ? 8 : 0);
        bf16_t* dstw = (bf16_t*)(p.ws + ((seg == 2 || seg == 5) ? WS_WV : WS_WQK));
        const int drow = (seg == 2 ? 0 : seg == 5 ? 512 : seg == 0 ? 0 : seg == 1 ? 512 : seg == 3 ? 1024 : 1536) + nn;
        p0_transpose_item(p.w_in, D, INC, srccol, dstw, drow, kb * 64, scr, lane);
    }
    cvt_stream(p.sub_keys, (bf16_t*)(p.ws + WS_SK), (size_t)8 * 2 * 128 * 128 / 8, gtid, gth);
}
__device__ __forceinline__ void weight_cvt_job(const P& p, int j, float* scr, int lane) {
    if (j < 1024) {
        const int kb = j / 64, nb = j % 64;
        p0_transpose_item_x4(p.w_query, D, 2048, nb * 32, (bf16_t*)(p.ws + WS_WQB), (size_t)2048 * 1024, kb * 64, scr, lane, (const float*)(p.ws + WS_GS2));
    } else if (j < 1536) {
        const float* sh2 = (const float*)(p.ws + WS_SH2);
        const int col = (j - 1024) * 4 + (lane & 3), ks = lane >> 2;
        float a0 = 0.f, a1 = 0.f, a2 = 0.f, a3 = 0.f;
        const float* w = p.w_query + (size_t)(ks * 64) * 2048 + col;
#pragma unroll 16
        for (int k = 0; k < 64; ++k) {
            const float wv = w[(size_t)k * 2048]; const int kk = ks * 64 + k;
            a0 += sh2[kk] * wv; a1 += sh2[1024 + kk] * wv; a2 += sh2[2048 + kk] * wv; a3 += sh2[3072 + kk] * wv;
        }
#pragma unroll
        for (int o = 4; o < 64; o <<= 1) { a0 += __shfl_xor(a0, o); a1 += __shfl_xor(a1, o); a2 += __shfl_xor(a2, o); a3 += __shfl_xor(a3, o); }
        float* bq = (float*)(p.ws + WS_BIASQ);
        if (ks == 0) { bq[col] = a0; bq[2048 + col] = a1; bq[4096 + col] = a2; bq[6144 + col] = a3; }
    } else {
        const int r = j - 1536, kb = r / 32, nb = r % 32;
        p0_transpose_item(p.w_out, D, D, nb * 32, (bf16_t*)(p.ws + WS_WOUT), nb * 32, kb * 64, scr, lane);
    }
}

__device__ __forceinline__ void norm1_stage(const P& p, char* smem) {
    const int t = (int)threadIdx.x - 320;
    if (t < 0) return;
    float* wfs = (float*)smem;
    f32x4 w[11];
#pragma unroll
    for (int k = 0; k < 11; ++k) { const int i = t + 192 * k; if (i < 2048) w[k] = *(const f32x4*)(p.w_in + (size_t)(i >> 1) * INC + 1536 + 4 * (i & 1)); }
#pragma unroll
    for (int k = 0; k < 11; ++k) {
        const int i = t + 192 * k, d = i >> 1, hf = i & 1;
        if (i < 2048) { wfs[(4 * hf + 0) * 1024 + d] = w[k].x; wfs[(4 * hf + 1) * 1024 + d] = w[k].y; wfs[(4 * hf + 2) * 1024 + d] = w[k].z; wfs[(4 * hf + 3) * 1024 + d] = w[k].w; }
    }
}
__device__ __forceinline__ void p1_norm1(const P& p, char* smem, int bid, int nblk) {
    const int tid = tidx(), lane = tid & 63, wid = tid >> 6;
    float* wfs = (float*)smem;
    float* lf = (float*)(smem + 32768);
    const float* mod = (const float*)(p.ws + WS_MOD);
    bf16_t* hbuf = (bf16_t*)(p.ws + WS_H);
    float* Floc = (float*)(p.ws + WS_FLOC);
    float* ctot = (float*)(p.ws + WS_CTOT);
    for (int ch = bid; ch < T / 64; ch += nblk) {
        const int t0 = ch * 64, b = t0 >> 13;
        f32x4 Am[4], Bm[4];
#pragma unroll
        for (int j = 0; j < 4; ++j) {
            const f32x4 g = ((const f32x4*)p.g_mix)[lane + 64 * j];
            const f32x4 s = ((const f32x4*)(mod + b * NMOD + 1024))[lane + 64 * j];
            Am[j] = g * (s + 1.0f);
            Bm[j] = ((const f32x4*)(mod + b * NMOD))[lane + 64 * j];
        }
        const int up32 = lane & 32, up16 = lane & 16, up8 = lane & 8;
        const int kL = ((lane >> 5) & 1) * 4 + ((lane >> 4) & 1) * 2 + ((lane >> 3) & 1);
        const float bfk = p.b_forget[kL];
        f32x4 vn[4];
        {
            const f32x4* xr = (const f32x4*)(p.x + (size_t)(t0 + wid * (64 / NWAVE)) * D) + lane;
#pragma unroll
            for (int j = 0; j < 4; ++j) vn[j] = xr[64 * j];
        }
        for (int i = 0; i < 64 / NWAVE; ++i) {
            const int t = t0 + wid * (64 / NWAVE) + i;
            f32x4 v[4]; float ss = 0.f;
#pragma unroll
            for (int j = 0; j < 4; ++j) { v[j] = vn[j]; ss += v[j].x * v[j].x + v[j].y * v[j].y + v[j].z * v[j].z + v[j].w * v[j].w; }
            if (i + 1 < 64 / NWAVE) {
                const f32x4* xr = (const f32x4*)(p.x + (size_t)(t + 1) * D) + lane;
#pragma unroll
                for (int j = 0; j < 4; ++j) vn[j] = xr[64 * j];
            }
            const float inv = rsqrtf(wave_sum(ss) * (1.f / D) + EPS);
            u32x2* o8 = (u32x2*)(hbuf + (size_t)t * D) + lane;
            float fa[8];
#pragma unroll
            for (int c = 0; c < 8; ++c) fa[c] = 0.f;
#pragma unroll
            for (int j = 0; j < 4; ++j) {
                const f32x4 h = (v[j] * inv) * Am[j] + Bm[j];
                u32x2 w; w.x = cvt_pk_bf16(h.x, h.y); w.y = cvt_pk_bf16(h.z, h.w); o8[64 * j] = w;
#pragma unroll
                for (int c = 0; c < 8; ++c) { const f32x4 wv = ((const f32x4*)(wfs + c * 1024))[lane + 64 * j]; fa[c] += (wv.x * h.x + wv.y * h.y) + (wv.z * h.z + wv.w * h.w); }
            }
            float k4[4], k2[2];
#pragma unroll
            for (int q = 0; q < 4; ++q) { const float snd = up32 ? fa[q] : fa[q + 4]; k4[q] = (up32 ? fa[q + 4] : fa[q]) + __shfl_xor(snd, 32); }
#pragma unroll
            for (int q = 0; q < 2; ++q) { const float snd = up16 ? k4[q] : k4[q + 2]; k2[q] = (up16 ? k4[q + 2] : k4[q]) + __shfl_xor(snd, 16); }
            const float snd = up8 ? k2[0] : k2[1];
            float f = (up8 ? k2[1] : k2[0]) + __shfl_xor(snd, 8);
            f += __shfl_xor(f, 4); f += __shfl_xor(f, 2); f += __shfl_xor(f, 1);
            if ((lane & 7) == 0) lf[(wid * (64 / NWAVE) + i) * 8 + kL] = log_sigmoid(f + bfk) * LOG2E;
        }
        __syncthreads();
        if (tid < 8) {
            float run = 0.f; float* dst = Floc + (size_t)(b * 8 + tid) * SEQ + (t0 & (SEQ - 1));
            for (int i = 0; i < 64; ++i) { run += lf[i * 8 + tid]; dst[i] = run; }
            ctot[(b * 8 + tid) * 128 + ((t0 & (SEQ - 1)) >> 6)] = run;
        }
        __syncthreads();
    }
}

struct EpiQK {
    static constexpr bool PERM = true, AFTER_DRAIN = false;
    unsigned char* ws;
    __device__ __forceinline__ void operator()(const pg8::f32x4 (&acc)[2][2][4][2], const pg8::Unit& u, int wr, int wc, int fr, int fq) const {
        const int b = (u.pm * 256) >> 13;
#pragma unroll
        for (int bj = 0; bj < 2; ++bj) {
            const int c0 = u.pn * 256 + bj * 128 + wc * 32 + 8 * fq, seg4 = c0 >> 9, hd = (c0 & 511) >> 6, d = c0 & 63;
            bf16_t* dst = (bf16_t*)(ws + WS_QF + (size_t)(seg4 < 2 ? seg4 : seg4 + 1) * 32 * MiB) + (size_t)(b * 8 + hd) * SEQ * 64 + d;
            float mx = 0.f;
#pragma unroll
            for (int ai = 0; ai < 2; ++ai)
#pragma unroll
                for (int m = 0; m < 4; ++m) {
                    const int s = (u.pm * 256 + ai * 128 + wr * 64 + m * 16 + fr) & (SEQ - 1);
                    const pg8::f32x4 v0 = acc[ai][bj][m][0], v1 = acc[ai][bj][m][1];
                    u32x4 w; w.x = cvt_pk_bf16(v0[0], v0[1]); w.y = cvt_pk_bf16(v0[2], v0[3]); w.z = cvt_pk_bf16(v1[0], v1[1]); w.w = cvt_pk_bf16(v1[2], v1[3]);
                    *(u32x4*)(dst + (size_t)s * 64) = w;
                    if (seg4 == 1) {
                        float q = (v0[0] * v0[0] + v0[1] * v0[1]) + (v0[2] * v0[2] + v0[3] * v0[3]) + (v1[0] * v1[0] + v1[1] * v1[1]) + (v1[2] * v1[2] + v1[3] * v1[3]);
                        q += __shfl_xor(q, 16); q += __shfl_xor(q, 32);
                        mx = fmaxf(mx, q);
                    }
                }
            if (seg4 == 1) {
                mx = wave_max(mx);
                if ((threadIdx.x & 63) == 0) atomicMax((unsigned*)(ws + WS_KMAX) + (b * 8 + hd) * 2 + (wc & 1), __float_as_uint(mx));
            }
        }
    }
};
struct EpiV {
    static constexpr bool PERM = true, AFTER_DRAIN = false;
    unsigned char* ws;
    __device__ __forceinline__ void operator()(const pg8::f32x4 (&acc)[2][2][4][2], const pg8::Unit& u, int wr, int wc, int fr, int fq) const {
#pragma unroll
        for (int bj = 0; bj < 2; ++bj) {
            const int t0 = u.pn * 256 + bj * 128 + wc * 32 + 8 * fq, b = t0 >> 13, s = t0 & (SEQ - 1);
#pragma unroll
            for (int ai = 0; ai < 2; ++ai)
#pragma unroll
                for (int m = 0; m < 4; ++m) {
                    const int vc = u.pm * 256 + ai * 128 + wr * 64 + m * 16 + fr, type = vc >> 9, hd = (vc & 511) >> 6, d = vc & 63;
                    bf16_t* dst = (bf16_t*)(ws + WS_QF + (size_t)(type * 3 + 2) * 32 * MiB) + (((size_t)(b * 8 + hd) * 256 + (s >> 5)) * 64 + d) * 32 + (s & 31);
                    const pg8::f32x4 v0 = acc[ai][bj][m][0], v1 = acc[ai][bj][m][1];
                    u32x4 w; w.x = cvt_pk_bf16(v0[0], v0[1]); w.y = cvt_pk_bf16(v0[2], v0[3]); w.z = cvt_pk_bf16(v1[0], v1[1]); w.w = cvt_pk_bf16(v1[2], v1[3]);
                    *(u32x4*)dst = w;
                }
        }
    }
};
struct EpiOut {
    static constexpr bool PERM = true, AFTER_DRAIN = false;
    const float* x; bf16_t* x1; const float* mod; float* ssq;
    __device__ __forceinline__ void operator()(const pg8::f32x4 (&acc)[2][2][4][2], const pg8::Unit& u, int wr, int wc, int fr, int fq) const {
        const int b = (u.pm * 256) >> 13;
        float sq[2][4];
#pragma unroll
        for (int ai = 0; ai < 2; ++ai)
#pragma unroll
            for (int m = 0; m < 4; ++m) sq[ai][m] = 0.f;
#pragma unroll
        for (int bj = 0; bj < 2; ++bj) {
            const int c0 = u.pn * 256 + bj * 128 + wc * 32 + 8 * fq;
            const f32x4 g0 = *(const f32x4*)(mod + b * NMOD + 2048 + c0), g1 = *(const f32x4*)(mod + b * NMOD + 2048 + c0 + 4);
#pragma unroll
            for (int ai = 0; ai < 2; ++ai)
#pragma unroll
                for (int m = 0; m < 4; ++m) {
                    const size_t off = (size_t)(u.pm * 256 + ai * 128 + wr * 64 + m * 16 + fr) * D + c0;
                    const f32x4 v0 = *(const f32x4*)(x + off) + g0 * acc[ai][bj][m][0], v1 = *(const f32x4*)(x + off + 4) + g1 * acc[ai][bj][m][1];
                    u32x4 w; w.x = cvt_pk_bf16(v0[0], v0[1]); w.y = cvt_pk_bf16(v0[2], v0[3]); w.z = cvt_pk_bf16(v1[0], v1[1]); w.w = cvt_pk_bf16(v1[2], v1[3]);
                    *(u32x4*)(x1 + off) = w;
                    float s = 0.f;
#pragma unroll
                    for (int e = 0; e < 4; ++e) { const float lo = bf_lo(w[e]), hi = bf_hi(w[e]); s += lo * lo + hi * hi; }
                    sq[ai][m] += s;
                }
        }
#pragma unroll
        for (int ai = 0; ai < 2; ++ai)
#pragma unroll
            for (int m = 0; m < 4; ++m) {
                float v = sq[ai][m];
                auto s1 = __builtin_amdgcn_permlane16_swap(__float_as_uint(v), __float_as_uint(v), false, false); v = __uint_as_float(s1[0]) + __uint_as_float(s1[1]);
                auto s2 = __builtin_amdgcn_permlane32_swap(__float_as_uint(v), __float_as_uint(v), false, false); v = __uint_as_float(s2[0]) + __uint_as_float(s2[1]);
                if (fq == 0) ssq[(size_t)(u.pm * 256 + ai * 128 + wr * 64 + m * 16 + fr) * 16 + u.pn * 4 + wc] = v;
            }
    }
};
struct EpiQuery {
    static constexpr bool PERM = true, AFTER_DRAIN = false;
    bf16_t* q; const float* ssq; const float* biasq;
    __device__ __forceinline__ void operator()(const pg8::f32x4 (&acc)[2][2][4][2], const pg8::Unit& u, int wr, int wc, int fr, int fq) const {
        float rstd[2][4];
#pragma unroll
        for (int ai = 0; ai < 2; ++ai)
#pragma unroll
            for (int m = 0; m < 4; ++m) {
                const f32x4 pp = *(const f32x4*)(ssq + (size_t)(u.pm * 256 + ai * 128 + wr * 64 + m * 16 + fr) * 16 + 4 * fq);
                float v = (pp[0] + pp[1]) + (pp[2] + pp[3]);
                auto s1 = __builtin_amdgcn_permlane16_swap(__float_as_uint(v), __float_as_uint(v), false, false); v = __uint_as_float(s1[0]) + __uint_as_float(s1[1]);
                auto s2 = __builtin_amdgcn_permlane32_swap(__float_as_uint(v), __float_as_uint(v), false, false); v = __uint_as_float(s2[0]) + __uint_as_float(s2[1]);
                rstd[ai][m] = rsqrtf(v * (1.f / D) + EPS);
            }
        const float* bq = biasq + ((u.pm * 256) >> 13) * 2048 + u.pn * 256;
        pg8::f32x4 bb[2][2];
#pragma unroll
        for (int bj = 0; bj < 2; ++bj) { bb[bj][0] = *(const pg8::f32x4*)(bq + bj * 128 + wc * 32 + 8 * fq); bb[bj][1] = *(const pg8::f32x4*)(bq + bj * 128 + wc * 32 + 8 * fq + 4); }
#pragma unroll
        for (int bj = 0; bj < 2; ++bj) {
            const pg8::f32x4 b0 = bb[bj][0], b1 = bb[bj][1];
            const int i16 = bj * 8 + 2 * wc + (fq >> 1), hh = fq & 1;
#pragma unroll
            for (int ai = 0; ai < 2; ++ai)
#pragma unroll
                for (int m = 0; m < 4; ++m) {
                    const pg8::f32x4 v0 = acc[ai][bj][m][0] * rstd[ai][m] + b0, v1 = acc[ai][bj][m][1] * rstd[ai][m] + b1;
                    u32x4 w; w.x = cvt_pk_bf16(v0[0], v0[1]); w.y = cvt_pk_bf16(v0[2], v0[3]); w.z = cvt_pk_bf16(v1[0], v1[1]); w.w = cvt_pk_bf16(v1[2], v1[3]);
                    const int off = ((((u.pm * 8 + ai * 4 + wr * 2 + (m >> 1)) * 8 + u.pn) * 16 + i16) * 2 + hh) * 256 + ((m & 1) * 16 + fr) * 8;
                    *(u32x4*)(q + off) = w;
                }
        }
    }
};
#define LASP(ptr) ((__attribute__((address_space(3))) unsigned char*)(ptr))
template <class Epi>
__device__ __forceinline__ void run_gemm(char* smem, const bf16_t* A, const bf16_t* Bt, int M, int N, const Epi& E, size_t bbatch = 0) {
    pg8::Gemm g{A, Bt, M, N, 1024, bbatch}; pg8::StaticOrder S; S.init(M, N, (int)gridDim.x, (int)blockIdx.x);
    pg8::gemm_phase<Epi, pg8::StaticOrder, true, true>(LASP(smem), g, S, E, g, E);
}
__device__ __forceinline__ void gemm_proj(const P& p, char* smem) {
    pg8::Gemm g1{(const bf16_t*)(p.ws + WS_H), (const bf16_t*)(p.ws + WS_WQK), T, 2048, 1024, 0}, g2{(const bf16_t*)(p.ws + WS_WV), (const bf16_t*)(p.ws + WS_H), 1024, T, 1024, 0};
    pg8::ChainOrder S; S.a.init(T, 2048, (int)gridDim.x, (int)blockIdx.x); S.b.init(1024, T, (int)gridDim.x, (int)blockIdx.x);
    pg8::gemm_phase<EpiQK, pg8::ChainOrder, true, true, EpiV>(LASP(smem), g1, S, EpiQK{p.ws}, g2, EpiV{p.ws});
}
__device__ __forceinline__ void gemm_out(const P& p, char* smem) {
    run_gemm(smem, (const bf16_t*)(p.ws + WS_MIX), (const bf16_t*)(p.ws + WS_WOUT), T, 1024, EpiOut{p.x, (bf16_t*)(p.ws + WS_X1), (const float*)(p.ws + WS_MOD), (float*)(p.ws + WS_SSQ)});
}
__device__ __forceinline__ void gemm_query(const P& p, char* smem) {
    run_gemm(smem, (const bf16_t*)(p.ws + WS_X1), (const bf16_t*)(p.ws + WS_WQB), T, 2048, EpiQuery{(bf16_t*)(p.ws + WS_QUERY), (const float*)(p.ws + WS_SSQ), (const float*)(p.ws + WS_BIASQ)}, (size_t)2048 * 1024 * 2);
}

__device__ __forceinline__ void attn_store(const P& p, const f32x16& o0, const f32x16& o1, float rs, const float* gout, int b, int h, int qt, int r, int hh, size_t dstoff = WS_MIX) {
    float ss = 0.f;
#pragma unroll
    for (int i = 0; i < 16; ++i) { const float a = o0[i] * rs, c = o1[i] * rs; ss += a * a + c * c; }
    ss = xor32_sum(ss);
    const float inv = rsqrtf(ss * (1.f / 64.f) + EPS) * rs;
    bf16_t* dst = (bf16_t*)(p.ws + dstoff) + (size_t)(b * SEQ + qt * 32 + r) * D + h * 64;
#pragma unroll
    for (int dt = 0; dt < 2; ++dt)
#pragma unroll
        for (int g = 0; g < 4; ++g) {
            const int d = dt * 32 + 8 * g + 4 * hh;
            const f32x4 gg = *(const f32x4*)(gout + d);
            const f32x16& o = dt == 0 ? o0 : o1;
            u32x2 w; w.x = cvt_pk_bf16(o[4 * g] * inv * gg.x, o[4 * g + 1] * inv * gg.y); w.y = cvt_pk_bf16(o[4 * g + 2] * inv * gg.z, o[4 * g + 3] * inv * gg.w);
            *(u32x2*)(dst + d) = w;
        }
}

__device__ __forceinline__ bf16x8 pack8(float a0, float a1, float a2, float a3, float a4, float a5, float a6, float a7) {
    u32x4 w; w.x = cvt_pk_bf16(a0, a1); w.y = cvt_pk_bf16(a2, a3); w.z = cvt_pk_bf16(a4, a5); w.w = cvt_pk_bf16(a6, a7);
    return __builtin_bit_cast(bf16x8, w);
}
__device__ __forceinline__ bf16x8 load_vfrag(const bf16_t* vt, int dt, int r, int s, int hh) {
    const bf16_t* a = vt + (dt * 32 + r) * 32 + 16 * s + 4 * hh;
    const u32x2 lo = *(const u32x2*)a, hi = *(const u32x2*)(a + 8);
    u32x4 w; w.x = lo.x; w.y = lo.y; w.z = hi.x; w.w = hi.y;
    return __builtin_bit_cast(bf16x8, w);
}

constexpr int ATT_WAVE_LDS = 16384;
struct RawTile { u32x4 k[4], v[4]; };
__device__ __forceinline__ void raw_load(RawTile& t, const bf16_t* Kp, const bf16_t* Vp, int kt, int lane) {
    const u32x4* gk = (const u32x4*)(Kp + (size_t)kt * 2048) + lane;
    const u32x4* gv = (const u32x4*)(Vp + (size_t)kt * 2048) + lane;
#pragma unroll
    for (int i = 0; i < 4; ++i) { t.k[i] = gk[64 * i]; t.v[i] = gv[64 * i]; }
}
__device__ __forceinline__ void raw_store(const RawTile& t, char* wl, int lane) {
#pragma unroll
    for (int i = 0; i < 4; ++i) {
        const int row = i * 8 + (lane >> 3), ch = lane & 7;
        *(u32x4*)(wl + row * 128 + ((ch ^ ((row >> 1) & 7)) * 16)) = t.k[i];
        const int d = i * 16 + (lane >> 2), c4 = lane & 3;
        u32x2 lo, hi; lo.x = t.v[i].x; lo.y = t.v[i].y; hi.x = t.v[i].z; hi.y = t.v[i].w;
        *(u32x2*)(wl + 4096 + d * 72 + c4 * 16) = lo;
        *(u32x2*)(wl + 4096 + d * 72 + c4 * 16 + 8) = hi;
    }
}
__device__ __forceinline__ void frag_read(bf16x8 (&kf)[4], bf16x8 (&vf)[4], const char* wl, int r, int hh) {
#pragma unroll
    for (int kk = 0; kk < 4; ++kk) kf[kk] = *(const bf16x8*)(wl + r * 128 + (((2 * kk + hh) ^ ((r >> 1) & 7)) * 16));
#pragma unroll
    for (int s2 = 0; s2 < 2; ++s2)
#pragma unroll
        for (int dt = 0; dt < 2; ++dt) {
            const char* a = wl + 4096 + (dt * 32 + r) * 72 + 32 * s2 + 8 * hh;
            const u32x2 lo = *(const u32x2*)a, hi = *(const u32x2*)(a + 16);
            u32x4 w; w.x = lo.x; w.y = lo.y; w.z = hi.x; w.w = hi.y;
            vf[2 * s2 + dt] = __builtin_bit_cast(bf16x8, w);
        }
}

template <bool DIAG>
__device__ __forceinline__ void fox_tile(const bf16x8 (&kf)[4], const bf16x8 (&vf)[4], const bf16x8 (&qf)[4], const f32x4 (&fk)[4], float Fq, float off,
                                         int hh, int r, float& m, float& lsum, f32x16& o0, f32x16& o1) {
    f32x16 s;
#pragma unroll
    for (int i = 0; i < 16; ++i) s[i] = 0.f;
#pragma unroll
    for (int kk = 0; kk < 4; ++kk) s = __builtin_amdgcn_mfma_f32_32x32x16_bf16(kf[kk], qf[kk], s, 0, 0, 0);
    const float fb = Fq - off;
    float lg[16]; float tmax = -INFINITY;
#pragma unroll
    for (int i = 0; i < 16; ++i) {
        float v = s[i] * SC2 + (fb - fk[i >> 2][i & 3]);
        if (DIAG && (8 * (i >> 2) + 4 * hh + (i & 3)) > r) v = -INFINITY;
        lg[i] = v; tmax = fmaxf(tmax, v);
    }
    tmax = xor32_max(tmax);
    const float mnew = fmaxf(m, tmax);
    if (!__all(mnew == m)) {
        const float alpha = __builtin_amdgcn_exp2f(m - mnew);
        lsum *= alpha;
#pragma unroll
        for (int i = 0; i < 16; ++i) { o0[i] *= alpha; o1[i] *= alpha; }
        m = mnew;
    }
    float ps = 0.f;
#pragma unroll
    for (int i = 0; i < 16; ++i) { lg[i] = __builtin_amdgcn_exp2f(lg[i] - m); ps += lg[i]; }
    lsum += xor32_sum(ps);
#pragma unroll
    for (int s2 = 0; s2 < 2; ++s2) {
        const bf16x8 pf = pack8(lg[8 * s2], lg[8 * s2 + 1], lg[8 * s2 + 2], lg[8 * s2 + 3], lg[8 * s2 + 4], lg[8 * s2 + 5], lg[8 * s2 + 6], lg[8 * s2 + 7]);
        o0 = __builtin_amdgcn_mfma_f32_32x32x16_bf16(vf[2 * s2], pf, o0, 0, 0, 0);
        o1 = __builtin_amdgcn_mfma_f32_32x32x16_bf16(vf[2 * s2 + 1], pf, o1, 0, 0, 0);
    }
}

template <bool DIAG>
__device__ __forceinline__ void sb_tile(const bf16x8 (&kf)[4], const bf16x8 (&vf)[4], const bf16x8 (&qf)[4], int hh, int r, float& R, f32x16& o0, f32x16& o1) {
    f32x16 s;
#pragma unroll
    for (int i = 0; i < 16; ++i) s[i] = 0.f;
#pragma unroll
    for (int kk = 0; kk < 4; ++kk) s = __builtin_amdgcn_mfma_f32_32x32x16_bf16(kf[kk], qf[kk], s, 0, 0, 0);
    float lom[16], lb[16];
#pragma unroll
    for (int i = 0; i < 16; ++i) {
        const float z = s[i] * SC2;
        const float sp = fmaxf(z, 0.f) + __builtin_amdgcn_logf(1.f + __builtin_amdgcn_exp2f(-fabsf(z)));
        const bool valid = !DIAG || (8 * (i >> 2) + 4 * hh + (i & 3)) < r;
        lom[i] = valid ? -sp : 0.f;
        lb[i] = valid ? (z - sp) : -INFINITY;
    }
    float G[4], PG[4], Tt[4];
#pragma unroll
    for (int g = 0; g < 4; ++g) { G[g] = (lom[4 * g] + lom[4 * g + 1]) + (lom[4 * g + 2] + lom[4 * g + 3]); PG[g] = xor32_get(G[g], hh); Tt[g] = G[g] + PG[g]; }
    float TS[4]; TS[3] = 0.f; TS[2] = Tt[3]; TS[1] = TS[2] + Tt[2]; TS[0] = TS[1] + Tt[1];
    float a[16];
#pragma unroll
    for (int g = 0; g < 4; ++g) {
        const float r3 = R + TS[g] + (hh == 0 ? PG[g] : 0.f);
        const float r2 = r3 + lom[4 * g + 3], r1 = r2 + lom[4 * g + 2], r0 = r1 + lom[4 * g + 1];
        a[4 * g + 3] = __builtin_amdgcn_exp2f(lb[4 * g + 3] + r3); a[4 * g + 2] = __builtin_amdgcn_exp2f(lb[4 * g + 2] + r2);
        a[4 * g + 1] = __builtin_amdgcn_exp2f(lb[4 * g + 1] + r1); a[4 * g + 0] = __builtin_amdgcn_exp2f(lb[4 * g + 0] + r0);
    }
    R += TS[0] + Tt[0];
#pragma unroll
    for (int s2 = 0; s2 < 2; ++s2) {
        const bf16x8 pf = pack8(a[8 * s2], a[8 * s2 + 1], a[8 * s2 + 2], a[8 * s2 + 3], a[8 * s2 + 4], a[8 * s2 + 5], a[8 * s2 + 6], a[8 * s2 + 7]);
        o0 = __builtin_amdgcn_mfma_f32_32x32x16_bf16(vf[2 * s2], pf, o0, 0, 0, 0);
        o1 = __builtin_amdgcn_mfma_f32_32x32x16_bf16(vf[2 * s2 + 1], pf, o1, 0, 0, 0);
    }
}


#define ATT_LAS __attribute__((address_space(3)))
constexpr int ATT_FSLOT_LDS = 132096;
__device__ __forceinline__ void att_dma_tile(char* img, const char* kb, const char* vb, unsigned offKe, unsigned offKo, unsigned offV, char* fslot, const float* fsrc) {
    asm volatile("" ::: "memory");
    const unsigned* ke = (const unsigned*)(kb + offKe); const unsigned* ko = (const unsigned*)(kb + offKo); const unsigned* vv = (const unsigned*)(vb + offV);
    __builtin_amdgcn_global_load_lds(ke, (ATT_LAS unsigned*)img, 16, 0, 0);    __builtin_amdgcn_global_load_lds(ko, (ATT_LAS unsigned*)img, 16, 1024, 0);
    __builtin_amdgcn_global_load_lds(ke, (ATT_LAS unsigned*)img, 16, 2048, 0); __builtin_amdgcn_global_load_lds(ko, (ATT_LAS unsigned*)img, 16, 3072, 0);
    __builtin_amdgcn_global_load_lds(vv, (ATT_LAS unsigned*)(img + 4096), 16, 0, 0);    __builtin_amdgcn_global_load_lds(vv, (ATT_LAS unsigned*)(img + 4096), 16, 1024, 0);
    __builtin_amdgcn_global_load_lds(vv, (ATT_LAS unsigned*)(img + 4096), 16, 2048, 0); __builtin_amdgcn_global_load_lds(vv, (ATT_LAS unsigned*)(img + 4096), 16, 3072, 0);
    __builtin_amdgcn_global_load_lds((const unsigned*)fsrc, (ATT_LAS unsigned*)fslot, 4, 0, 0);
    asm volatile("" ::: "memory");
}
__device__ __forceinline__ void frag_read_dma(bf16x8 (&kf)[4], bf16x8 (&vf)[4], const char* img, int r, int hh) {
#pragma unroll
    for (int kk = 0; kk < 4; ++kk) kf[kk] = *(const bf16x8*)(img + r * 128 + (((2 * kk + hh) ^ ((r >> 1) & 7)) * 16));
#pragma unroll
    for (int s2 = 0; s2 < 2; ++s2)
#pragma unroll
        for (int dt = 0; dt < 2; ++dt) {
            const char* a = img + 4096 + (2 * dt + (r >> 4)) * 1024 + (32 * s2 + (r & 15)) * 16 + 8 * hh;
            const u32x2 lo = *(const u32x2*)a, hi = *(const u32x2*)(a + 256);
            u32x4 w; w.x = lo.x; w.y = lo.y; w.z = hi.x; w.w = hi.y;
            vf[2 * s2 + dt] = __builtin_bit_cast(bf16x8, w);
        }
}
template <int PMODE>
__device__ __forceinline__ void fox_task_dma(const P& p, char* smem, char* wl, const float* gl, int bh, int qt, int lane) {
    asm volatile("" : "+v"(lane));
    const int r = lane & 31, hh = lane >> 5, b = bh >> 3, h = bh & 7;
    const bf16_t* Q = (const bf16_t*)(p.ws + WS_QF) + ((size_t)bh * SEQ + qt * 32) * 64;
    const char* Kp = (const char*)((const bf16_t*)(p.ws + WS_QF + 32 * MiB) + (size_t)bh * SEQ * 64);
    const char* Vp = (const char*)((const bf16_t*)(p.ws + WS_QF + 64 * MiB) + (size_t)bh * 256 * 2048);
    const unsigned offKe = (unsigned)((lane >> 3) * 128 + (((lane & 7) ^ (lane >> 4)) * 16)), offKo = offKe ^ 64u;
    const unsigned offV = (unsigned)((lane & 15) * 64 + (lane >> 4) * 16);
    const float* F = (const float*)(p.ws + WS_FLOC) + (size_t)bh * SEQ;
    const float* Ct = (const float*)(p.ws + WS_CTOT) + bh * 128;
    char* fs = smem + ATT_FSLOT_LDS + (int)((wl - smem) / ATT_WAVE_LDS) * 768;
#define FOX_FSRC(kt) (lane < 32 ? F + (kt) * 32 + lane : Ct + ((kt) >> 1))
    bf16x8 qf[4];
#pragma unroll
    for (int kk = 0; kk < 4; ++kk) qf[kk] = *(const bf16x8*)(Q + r * 64 + kk * 16 + hh * 8);
    const float Fq = F[qt * 32 + r];
    const float kmx = __uint_as_float(((const unsigned*)(p.ws + WS_KMAX))[bh * 2]) + __uint_as_float(((const unsigned*)(p.ws + WS_KMAX))[bh * 2 + 1]);
    const int k1 = qt > 0 ? qt - 1 : 0, k2 = qt > 1 ? qt - 2 : 0;
    att_dma_tile(wl, Kp + (size_t)qt * 4096, Vp + (size_t)qt * 4096, offKe, offKo, offV, fs, FOX_FSRC(qt));
    att_dma_tile(wl + 8192, Kp + (size_t)k1 * 4096, Vp + (size_t)k1 * 4096, offKe, offKo, offV, fs + 256, FOX_FSRC(k1));
    f32x16 o0, o1;
#pragma unroll
    for (int i = 0; i < 16; ++i) { o0[i] = 0.f; o1[i] = 0.f; }
    bf16x8 kf[4], vf[4];
    asm volatile("s_waitcnt vmcnt(9)" ::: "memory");
    float qn2 = 0.f;
#pragma unroll
    for (int kk = 0; kk < 4; ++kk)
#pragma unroll
        for (int jj = 0; jj < 8; ++jj) { const float v = bf2f((bf16_t)qf[kk][jj]); qn2 += v * v; }
    qn2 = xor32_sum(qn2);
    const float qb = (sqrtf(qn2 * kmx) * ATT_SCALE * 1.01f + 0.01f) * LOG2E;
    float off = 0.f, m = -INFINITY, lsum = 0.f;
    f32x4 fk[4];
    frag_read_dma(kf, vf, wl, r, hh);
#pragma unroll
    for (int g = 0; g < 4; ++g) fk[g] = *(const f32x4*)(fs + (8 * g + 4 * hh) * 4);
    asm volatile("s_waitcnt lgkmcnt(0)" ::: "memory");
    att_dma_tile(wl, Kp + (size_t)k2 * 4096, Vp + (size_t)k2 * 4096, offKe, offKo, offV, fs + 512, FOX_FSRC(k2));
    fox_tile<true>(kf, vf, qf, fk, Fq, off, hh, r, m, lsum, o0, o1);
    int j = 1, sl = 1;
    for (int kt = qt - 1; kt >= 0 && PMODE != 1; --kt) {
        asm volatile("s_waitcnt vmcnt(9)" ::: "memory");
        char* img = wl + j * 8192; const char* fsl = fs + sl * 256;
        const float ct = ((const float*)fsl)[32], Flast = ((const float*)fsl)[31];
        off -= (kt & 1) ? ct : 0.f;
        if (__all((qb + Fq - (Flast + off)) - (m + __builtin_amdgcn_logf(lsum)) < -fox_thresh2(qt))) break;
        frag_read_dma(kf, vf, img, r, hh);
#pragma unroll
        for (int g = 0; g < 4; ++g) fk[g] = *(const f32x4*)(fsl + (8 * g + 4 * hh) * 4);
        asm volatile("s_waitcnt lgkmcnt(0)" ::: "memory");
        const int kn = kt > 1 ? kt - 2 : 0, sn = sl == 0 ? 2 : sl - 1;
        att_dma_tile(img, Kp + (size_t)kn * 4096, Vp + (size_t)kn * 4096, offKe, offKo, offV, fs + sn * 256, FOX_FSRC(kn));
        fox_tile<false>(kf, vf, qf, fk, Fq, off, hh, r, m, lsum, o0, o1);
        j ^= 1; sl = sl == 2 ? 0 : sl + 1;
    }
#undef FOX_FSRC
    asm volatile("s_waitcnt vmcnt(0)" ::: "memory");
    attn_store(p, o0, o1, 1.f / lsum, gl, b, h, qt, r, hh, PMODE == 0 ? WS_MIX : WS_H);
}
template <int PMODE>
__device__ __forceinline__ void fox2_task_dma(const P& p, char* smem, char* wl, const float* gl, int bh, int qtA, int lane) {
    asm volatile("" : "+v"(lane));
    const int r = lane & 31, hh = lane >> 5, b = bh >> 3, h = bh & 7, qtB = qtA - 1;
    const bf16_t* Q = (const bf16_t*)(p.ws + WS_QF) + ((size_t)bh * SEQ + qtB * 32) * 64;
    const char* Kp = (const char*)((const bf16_t*)(p.ws + WS_QF + 32 * MiB) + (size_t)bh * SEQ * 64);
    const char* Vp = (const char*)((const bf16_t*)(p.ws + WS_QF + 64 * MiB) + (size_t)bh * 256 * 2048);
    const unsigned offKe = (unsigned)((lane >> 3) * 128 + (((lane & 7) ^ (lane >> 4)) * 16)), offKo = offKe ^ 64u;
    const unsigned offV = (unsigned)((lane & 15) * 64 + (lane >> 4) * 16);
    const float* F = (const float*)(p.ws + WS_FLOC) + (size_t)bh * SEQ;
    const float* Ct = (const float*)(p.ws + WS_CTOT) + bh * 128;
    char* fs = smem + ATT_FSLOT_LDS + (int)((wl - smem) / ATT_WAVE_LDS) * 768;
#define FOX_FSRC(kt) (lane < 32 ? F + (kt) * 32 + lane : Ct + ((kt) >> 1))
#define FOX_REQ(img, slot, kt) att_dma_tile(img, Kp + (size_t)(kt) * 4096, Vp + (size_t)(kt) * 4096, offKe, offKo, offV, slot, FOX_FSRC(kt))
    bf16x8 qfA[4], qfB[4];
#pragma unroll
    for (int kk = 0; kk < 4; ++kk) { qfB[kk] = *(const bf16x8*)(Q + r * 64 + kk * 16 + hh * 8); qfA[kk] = *(const bf16x8*)(Q + 2048 + r * 64 + kk * 16 + hh * 8); }
    const float FqA = F[qtA * 32 + r], FqB = F[qtB * 32 + r];
    const float kmx = __uint_as_float(((const unsigned*)(p.ws + WS_KMAX))[bh * 2]) + __uint_as_float(((const unsigned*)(p.ws + WS_KMAX))[bh * 2 + 1]);
    FOX_REQ(wl, fs, qtA);
    FOX_REQ(wl + 8192, fs + 256, qtB);
    f32x16 oA0, oA1, oB0, oB1;
#pragma unroll
    for (int i = 0; i < 16; ++i) { oA0[i] = 0.f; oA1[i] = 0.f; oB0[i] = 0.f; oB1[i] = 0.f; }
    bf16x8 kf[4], vf[4];
    f32x4 fk[4];
    asm volatile("s_waitcnt vmcnt(9)" ::: "memory");
    float qa = 0.f, qbb = 0.f;
#pragma unroll
    for (int kk = 0; kk < 4; ++kk)
#pragma unroll
        for (int jj = 0; jj < 8; ++jj) { const float va = bf2f((bf16_t)qfA[kk][jj]), vb = bf2f((bf16_t)qfB[kk][jj]); qa += va * va; qbb += vb * vb; }
    qa = xor32_sum(qa); qbb = xor32_sum(qbb);
    const float qbA = (sqrtf(qa * kmx) * ATT_SCALE * 1.01f + 0.01f) * LOG2E, qbB = (sqrtf(qbb * kmx) * ATT_SCALE * 1.01f + 0.01f) * LOG2E;
    float off = 0.f, mA = -INFINITY, lsA = 0.f, mB = -INFINITY, lsB = 0.f;
    frag_read_dma(kf, vf, wl, r, hh);
#pragma unroll
    for (int g = 0; g < 4; ++g) fk[g] = *(const f32x4*)(fs + (8 * g + 4 * hh) * 4);
    asm volatile("s_waitcnt lgkmcnt(0)" ::: "memory");
    { const int kn = qtA > 1 ? qtA - 2 : 0; FOX_REQ(wl, fs + 512, kn); }
    fox_tile<true>(kf, vf, qfA, fk, FqA, off, hh, r, mA, lsA, oA0, oA1);
    asm volatile("s_waitcnt vmcnt(9)" ::: "memory");
    frag_read_dma(kf, vf, wl + 8192, r, hh);
#pragma unroll
    for (int g = 0; g < 4; ++g) fk[g] = *(const f32x4*)(fs + 256 + (8 * g + 4 * hh) * 4);
    asm volatile("s_waitcnt lgkmcnt(0)" ::: "memory");
    { const int kn = qtB > 1 ? qtB - 2 : 0; FOX_REQ(wl + 8192, fs, kn); }
    fox_tile<false>(kf, vf, qfA, fk, FqA, off, hh, r, mA, lsA, oA0, oA1);
    fox_tile<true>(kf, vf, qfB, fk, FqB, off, hh, r, mB, lsB, oB0, oB1);
    int j = 0, sl = 2;
    for (int kt = qtB - 1; kt >= 0 && PMODE != 1; --kt) {
        asm volatile("s_waitcnt vmcnt(9)" ::: "memory");
        char* img = wl + j * 8192; const char* fsl = fs + sl * 256;
        const float ct = ((const float*)fsl)[32], Flast = ((const float*)fsl)[31];
        off -= (kt & 1) ? ct : 0.f;
        const float base = Flast + off;
        if (__all((qbA + FqA - base) - (mA + __builtin_amdgcn_logf(lsA)) < -fox_thresh2(qtA) && (qbB + FqB - base) - (mB + __builtin_amdgcn_logf(lsB)) < -fox_thresh2(qtA))) break;
        frag_read_dma(kf, vf, img, r, hh);
#pragma unroll
        for (int g = 0; g < 4; ++g) fk[g] = *(const f32x4*)(fsl + (8 * g + 4 * hh) * 4);
        asm volatile("s_waitcnt lgkmcnt(0)" ::: "memory");
        const int kn = kt > 1 ? kt - 2 : 0, sn = sl == 0 ? 2 : sl - 1;
        FOX_REQ(img, fs + sn * 256, kn);
        fox_tile<false>(kf, vf, qfA, fk, FqA, off, hh, r, mA, lsA, oA0, oA1);
        fox_tile<false>(kf, vf, qfB, fk, FqB, off, hh, r, mB, lsB, oB0, oB1);
        j ^= 1; sl = sl == 2 ? 0 : sl + 1;
    }
#undef FOX_REQ
#undef FOX_FSRC
    asm volatile("s_waitcnt vmcnt(0)" ::: "memory");
    attn_store(p, oA0, oA1, 1.f / lsA, gl, b, h, qtA, r, hh, PMODE == 0 ? WS_MIX : WS_H);
    attn_store(p, oB0, oB1, 1.f / lsB, gl, b, h, qtB, r, hh, PMODE == 0 ? WS_MIX : WS_H);
}
template <int PMODE>
__device__ __forceinline__ void attn_task(const P& p, char* smem, char* wl, const float* gl, int type, int bh, int qt, int lane) {
    if (type == 0) { fox_task_dma<PMODE>(p, smem, wl, gl, bh, qt, lane); return; }
    const int r = lane & 31, hh = lane >> 5, b = bh >> 3, h = bh & 7;
    const size_t segoff = (size_t)(type * 3) * 32 * MiB;
    const bf16_t* Q = (const bf16_t*)(p.ws + WS_QF + segoff) + ((size_t)bh * SEQ + qt * 32) * 64;
    const bf16_t* Kp = (const bf16_t*)(p.ws + WS_QF + segoff + 32 * MiB) + (size_t)bh * SEQ * 64;
    const bf16_t* Vp = (const bf16_t*)(p.ws + WS_QF + segoff + 64 * MiB) + (size_t)bh * 256 * 2048;
    RawTile raw;
    raw_load(raw, Kp, Vp, qt, lane);
    bf16x8 qf[4];
#pragma unroll
    for (int kk = 0; kk < 4; ++kk) qf[kk] = *(const bf16x8*)(Q + r * 64 + kk * 16 + hh * 8);
    f32x16 o0, o1;
#pragma unroll
    for (int i = 0; i < 16; ++i) { o0[i] = 0.f; o1[i] = 0.f; }
    float rs = 1.f;
    bf16x8 kf[4], vf[4];
    const float* F = (const float*)(p.ws + WS_FLOC) + (size_t)bh * SEQ;
    const float* Ct = (const float*)(p.ws + WS_CTOT) + bh * 128;
    f32x4 fk[4];
#pragma unroll
    for (int g = 0; g < 4; ++g) fk[g] = *(const f32x4*)(F + qt * 32 + 8 * g + 4 * hh);
    const float Fq = F[qt * 32 + r];
    const float kmx = __uint_as_float(((const unsigned*)(p.ws + WS_KMAX))[bh * 2]) + __uint_as_float(((const unsigned*)(p.ws + WS_KMAX))[bh * 2 + 1]);
    raw_store(raw, wl, lane);
    if (type == 0) {
        float Flast = 0.f;
        float qn2 = 0.f;
#pragma unroll
        for (int kk = 0; kk < 4; ++kk)
#pragma unroll
            for (int j = 0; j < 8; ++j) { const float v = bf2f((bf16_t)qf[kk][j]); qn2 += v * v; }
        qn2 = xor32_sum(qn2);
        const float qb = (sqrtf(qn2 * kmx) * ATT_SCALE * 1.01f + 0.01f) * LOG2E;
        float off = 0.f, m = -INFINITY, lsum = 0.f;
        f32x4 fn[4]; float ctn = 0.f;
        frag_read(kf, vf, wl, r, hh);
        if (qt > 0) {
            raw_load(raw, Kp, Vp, qt - 1, lane);
#pragma unroll
            for (int g = 0; g < 4; ++g) fn[g] = *(const f32x4*)(F + (qt - 1) * 32 + 8 * g + 4 * hh);
            Flast = F[(qt - 1) * 32 + 31]; ctn = ((qt - 1) & 1) ? Ct[(qt - 1) >> 1] : 0.f;
        }
        fox_tile<true>(kf, vf, qf, fk, Fq, off, hh, r, m, lsum, o0, o1);
        for (int kt = qt - 1; kt >= 0 && PMODE != 1; --kt) {
            raw_store(raw, wl, lane);
            off -= ctn;
            if (__all((qb + Fq - (Flast + off)) - (m + __builtin_amdgcn_logf(lsum)) < -fox_thresh2(qt))) break;
#pragma unroll
            for (int g = 0; g < 4; ++g) fk[g] = fn[g];
            frag_read(kf, vf, wl, r, hh);
            if (kt > 0) {
                raw_load(raw, Kp, Vp, kt - 1, lane);
#pragma unroll
                for (int g = 0; g < 4; ++g) fn[g] = *(const f32x4*)(F + (kt - 1) * 32 + 8 * g + 4 * hh);
                Flast = F[(kt - 1) * 32 + 31]; ctn = ((kt - 1) & 1) ? Ct[(kt - 1) >> 1] : 0.f;
            }
            fox_tile<false>(kf, vf, qf, fk, Fq, off, hh, r, m, lsum, o0, o1);
        }
        rs = 1.f / lsum;
    } else {
        float R = 0.f;
        frag_read(kf, vf, wl, r, hh);
        if (qt > 0) raw_load(raw, Kp, Vp, qt - 1, lane);
        sb_tile<true>(kf, vf, qf, hh, r, R, o0, o1);
        for (int kt = qt - 1; kt >= 0 && PMODE != 1; --kt) {
            raw_store(raw, wl, lane);
            if (__all(R < -THRESH2_SB)) break;
            frag_read(kf, vf, wl, r, hh);
            if (kt > 0) raw_load(raw, Kp, Vp, kt - 1, lane);
            sb_tile<false>(kf, vf, qf, hh, r, R, o0, o1);
        }
    }
    attn_store(p, o0, o1, rs, gl + type * 64, b, type * 8 + h, qt, r, hh, PMODE == 0 ? WS_MIX : WS_H);
}

__device__ __forceinline__ void expert_cvt_quad(const P& p, int Q, int lane) {
    const int row0 = Q * 4;
    const float* src = row0 < 16384 ? p.e_down : p.e_up;
    unsigned char* dst = p.ws + (row0 < 16384 ? WS_ED : WS_EU);
    float* rs = (float*)(p.ws + (row0 < 16384 ? WS_RSD : WS_RSU));
    const int r0 = row0 & 16383;
    RowF32 rr[4];
#pragma unroll
    for (int k = 0; k < 4; ++k) row_load(rr[k], src, r0 + k, lane);
#pragma unroll
    for (int k = 0; k < 4; ++k) cvt_row_q4(rr[k], dst, rs, r0 + k, lane, row0 < 16384 ? 0x88888888u : 0x80808080u);
}
constexpr int HOOK_QUADS = 32;
__device__ __forceinline__ void hook_quads(const P& p, int bid, int nblk, int j0, int n) {
    const int w = (int)threadIdx.x >> 6;
    if (w >= 1 && w <= n) { const int Q = bid + nblk * (j0 + w - 1); if (Q < 8192) expert_cvt_quad(p, Q, (int)threadIdx.x & 63); }
}
template <int PMODE = 0>
__device__ __forceinline__ void attn_phase(const P& p, char* smem, int bid, int nblk, int cidx = 0, unsigned tlo = 0u, unsigned thi = 1536u) {
    const int tid = tidx(), lane = tid & 63;
    char* wl = smem + __builtin_amdgcn_readfirstlane(tid >> 6) * ATT_WAVE_LDS;
    float* gl = (float*)(smem + NWAVE * ATT_WAVE_LDS + 256);
    if (tid < 128) gl[tid] = tid < 64 ? p.g_fox[tid] : p.g_sb[tid - 64];
    if (tid == 0) *(unsigned*)(smem + ATT_FSLOT_LDS + 6144) = 0u;
    __syncthreads();
    if (PMODE == 0) {
        const int gw = bid * NWAVE + (tid >> 6), ngw = nblk * NWAVE;
        for (int j = HOOK_QUADS + (tid >> 6); bid + nblk * j < 8192; j += NWAVE) expert_cvt_quad(p, bid + nblk * j, lane);
        for (int jb = gw; jb < 2048; jb += ngw) weight_cvt_job(p, jb, (float*)wl, lane);
    }
    unsigned* lctr = (unsigned*)(smem + ATT_FSLOT_LDS + 6144);
    int x = bid & 7, jblk = bid >> 3;
    int gen = bid * NWAVE + __builtin_amdgcn_readfirstlane(tid >> 6);
    for (;;) {
        int i;
        if (nblk == 256) {
            unsigned tk = 0;
            if (lane == 0) tk = atomicAdd(lctr, 1u);
            i = __builtin_amdgcn_readfirstlane((int)tk);
            if (i >= 48) break;
        } else {
            if (gen >= 256 * 48) break;
            const int vb = gen / 48; i = gen - 48 * vb; x = vb & 7; jblk = vb >> 3; gen += nblk * NWAVE;
        }
        int ln = lane; asm volatile("" : "+v"(ln));
        if (i < 16) {
            const int idx = 32 * i + ((jblk + 5 * i) & 31);
            fox2_task_dma<PMODE>(p, smem, wl, gl, 8 * (idx & 3) + ((x + (idx & 3) + (idx >> 6)) & 7), 255 - 2 * (idx >> 2), ln);
        } else {
            const int k = i - 16, idx = 32 * k + ((jblk + 5 * k) & 31);
            attn_task<PMODE>(p, smem, wl, gl, 1, 8 * (idx & 3) + ((x + (idx & 3) + (idx >> 7)) & 7), 255 - (idx >> 2), ln);
        }
    }
}

__device__ __forceinline__ void p5_row(const P& p, const f32x4 (&A2)[4], const f32x4 (&B2)[4], int t, int lane, const u32x4& xa, const u32x4& xb) {
    float v[16]; float ss = 0.f;
#pragma unroll
    for (int i = 0; i < 4; ++i) { v[2 * i] = bf_lo(xa[i]); v[2 * i + 1] = bf_hi(xa[i]); v[8 + 2 * i] = bf_lo(xb[i]); v[8 + 2 * i + 1] = bf_hi(xb[i]); }
#pragma unroll
    for (int i = 0; i < 16; ++i) ss += v[i] * v[i];
    const float inv = rsqrtf(wave_sum(ss) * (1.f / D) + EPS);
    u32x4 o[2];
#pragma unroll
    for (int q = 0; q < 4; ++q) {
        f32x4 h;
#pragma unroll
        for (int e2 = 0; e2 < 4; ++e2) h[e2] = (v[4 * q + e2] * inv) * A2[q][e2] + B2[q][e2];
        o[q >> 1][(q & 1) * 2] = cvt_pk_bf16(h[0], h[1]); o[q >> 1][(q & 1) * 2 + 1] = cvt_pk_bf16(h[2], h[3]);
    }
    bf16_t* hbuf = (bf16_t*)(p.ws + WS_H);
    *(u32x4*)(hbuf + (size_t)t * D + 16 * lane) = o[0]; *(u32x4*)(hbuf + (size_t)t * D + 16 * lane + 8) = o[1];
}
__device__ __forceinline__ void p5_norm2(const P& p, int bid, int nblk) {
    const int tid = tidx(), lane = tid & 63, wid = tid >> 6;
    const float* mod = (const float*)(p.ws + WS_MOD);
    const bf16_t* x1 = (const bf16_t*)(p.ws + WS_X1);
    const int nw = nblk * NWAVE;
    int bcur = -1; f32x4 A2[4], B2[4];
    for (int t = bid * NWAVE + wid; t < T; t += 4 * nw) {
        u32x4 xa[4], xb[4];
#pragma unroll
        for (int k = 0; k < 4; ++k) { xa[k] = *(const u32x4*)(x1 + (size_t)(t + k * nw) * D + 16 * lane); xb[k] = *(const u32x4*)(x1 + (size_t)(t + k * nw) * D + 16 * lane + 8); }
#pragma unroll
        for (int k = 0; k < 4; ++k) {
            const int tk = t + k * nw, b = tk >> 13;
            if (b != bcur) {
                bcur = b;
#pragma unroll
                for (int q = 0; q < 4; ++q) {
                    const f32x4 g = *(const f32x4*)(p.g_ffn + 16 * lane + 4 * q);
                    const f32x4 s = *(const f32x4*)(mod + b * NMOD + 4096 + 16 * lane + 4 * q);
                    A2[q] = g * (s + 1.0f); B2[q] = *(const f32x4*)(mod + b * NMOD + 3072 + 16 * lane + 4 * q);
                }
            }
            p5_row(p, A2, B2, tk, lane, xa[k], xb[k]);
        }
    }
}

__device__ __forceinline__ int enc_key(float v) { const int u = __float_as_int(v); return u ^ ((u >> 31) & 0x7fffffff); }
__device__ __forceinline__ float dec_key(int k) { return __int_as_float(k ^ ((k >> 31) & 0x7fffffff)); }
#define KEY_LOWEST ((int)0x80000000)
#define INS16(L, v) do { int _v = (v); _Pragma("unroll") for (int _s = 0; _s < 16; ++_s) { const int _h = max(L[_s], _v); _v = min(L[_s], _v); L[_s] = _h; } } while (0)

#define CEX(a,i,j) { const int _h = max(a[i], a[j]); const int _l = min(a[i], a[j]); a[i] = _h; a[j] = _l; }
#define SORT16_DESC(a) do { CEX(a,0,1); CEX(a,2,3); CEX(a,0,2); CEX(a,1,3); CEX(a,1,2); CEX(a,4,5); CEX(a,6,7); CEX(a,4,6); CEX(a,5,7); CEX(a,5,6); CEX(a,0,4); CEX(a,2,6); CEX(a,2,4); CEX(a,1,5); CEX(a,3,7); CEX(a,3,5); CEX(a,1,2); CEX(a,3,4); CEX(a,5,6); CEX(a,8,9); CEX(a,10,11); CEX(a,8,10); CEX(a,9,11); CEX(a,9,10); CEX(a,12,13); CEX(a,14,15); CEX(a,12,14); CEX(a,13,15); CEX(a,13,14); CEX(a,8,12); CEX(a,10,14); CEX(a,10,12); CEX(a,9,13); CEX(a,11,15); CEX(a,11,13); CEX(a,9,10); CEX(a,11,12); CEX(a,13,14); CEX(a,0,8); CEX(a,4,12); CEX(a,4,8); CEX(a,2,10); CEX(a,6,14); CEX(a,6,10); CEX(a,2,4); CEX(a,6,8); CEX(a,10,12); CEX(a,1,9); CEX(a,5,13); CEX(a,5,9); CEX(a,3,11); CEX(a,7,15); CEX(a,7,11); CEX(a,3,5); CEX(a,7,9); CEX(a,11,13); CEX(a,1,2); CEX(a,3,4); CEX(a,5,6); CEX(a,7,8); CEX(a,9,10); CEX(a,11,12); CEX(a,13,14); } while (0)
#define BMERGE16_DESC(a) do { CEX(a,0,8); CEX(a,1,9); CEX(a,2,10); CEX(a,3,11); CEX(a,4,12); CEX(a,5,13); CEX(a,6,14); CEX(a,7,15); CEX(a,0,4); CEX(a,1,5); CEX(a,2,6); CEX(a,3,7); CEX(a,8,12); CEX(a,9,13); CEX(a,10,14); CEX(a,11,15); CEX(a,0,2); CEX(a,1,3); CEX(a,4,6); CEX(a,5,7); CEX(a,8,10); CEX(a,9,11); CEX(a,12,14); CEX(a,13,15); CEX(a,0,1); CEX(a,2,3); CEX(a,4,5); CEX(a,6,7); CEX(a,8,9); CEX(a,10,11); CEX(a,12,13); CEX(a,14,15); } while (0)
#define MERGE_TOP16(A, B) do { _Pragma("unroll") for (int _i = 0; _i < 16; ++_i) A[_i] = max(A[_i], B[15 - _i]); BMERGE16_DESC(A); } while (0)
constexpr int SK_ROW = 272;

struct QFrag { bf16x8 f[16]; };
__device__ __forceinline__ void topk_load_q(QFrag& q, const P& p, int tt, int h, int lane) {
    const bf16_t* qb = (const bf16_t*)(p.ws + WS_QUERY) + ((size_t)tt * 8 + h) * 16 * 512 + lane * 8;
#pragma unroll
    for (int i = 0; i < 16; ++i) q.f[i] = *(const bf16x8*)(qb + i * 512);
}
__device__ __forceinline__ void topk_tile(const bf16x8* qf, const char* img, int mt, int r, int hh, int (&Kk)[16]) {
    f32x16 sc;
#pragma unroll
    for (int i = 0; i < 16; ++i) sc[i] = 0.f;
#pragma unroll
    for (int kk = 0; kk < 8; ++kk) {
        const bf16x8 kf = *(const bf16x8*)(img + (mt * 32 + r) * SK_ROW + kk * 32 + hh * 16);
        sc = __builtin_amdgcn_mfma_f32_32x32x16_bf16(kf, qf[kk], sc, 0, 0, 0);
    }
#pragma unroll
    for (int i = 0; i < 16; ++i) Kk[i] = (enc_key(sc[i]) & ~127) | (mt * 32 + 8 * (i >> 2) + 4 * hh + (i & 3));
    SORT16_DESC(Kk);
}
__device__ __forceinline__ void topk_half(const bf16x8* qf, const char* img, int r, int hh, int (&Lk)[16]) {
    topk_tile(qf, img, 0, r, hh, Lk);
#pragma unroll 1
    for (int mt = 1; mt < 4; ++mt) {
        int Kk[16];
        topk_tile(qf, img, mt, r, hh, Kk);
        MERGE_TOP16(Lk, Kk);
    }
    int Pn[16];
#pragma unroll
    for (int s = 0; s < 16; ++s) Pn[s] = __shfl_xor(Lk[s], 32);
    MERGE_TOP16(Lk, Pn);
}

__device__ __forceinline__ void topk_task(const P& p, const char* img, QFrag& qf, int tt, int tt_next, int h, int lane) {
    const int r = lane & 31, hh = lane >> 5, t = tt * 32 + r;
    int La[16], Lb[16];
    topk_half(qf.f, img, r, hh, La);
    topk_half(qf.f + 8, img + 128 * SK_ROW, r, hh, Lb);
    if (tt_next < T / 32) topk_load_q(qf, p, tt_next, h, lane);
    float v1[16], v2[16];
#pragma unroll
    for (int s = 0; s < 16; ++s) { v1[s] = dec_key(La[s] & ~127); v2[s] = dec_key(Lb[s] & ~127); }
    unsigned long long I1lo = 0, I1hi = 0, I2lo = 0, I2hi = 0;
#pragma unroll
    for (int s = 0; s < 8; ++s) {
        I1lo |= (unsigned long long)(unsigned)(La[s] & 127) << (8 * s); I1hi |= (unsigned long long)(unsigned)(La[s + 8] & 127) << (8 * s);
        I2lo |= (unsigned long long)(unsigned)(Lb[s] & 127) << (8 * s); I2hi |= (unsigned long long)(unsigned)(Lb[s + 8] & 127) << (8 * s);
    }
#define CK(a, b) ((enc_key(v1[a] + v2[b]) & ~255) | ((a) * 16 + (b)))
    int C[16], G[16];
#pragma unroll
    for (int bq = 0; bq < 16; ++bq) C[bq] = CK(0, bq);
#pragma unroll
    for (int bq = 0; bq < 8; ++bq) G[bq] = CK(1, bq);
#pragma unroll
    for (int bq = 0; bq < 5; ++bq) G[8 + bq] = CK(2, bq);
#pragma unroll
    for (int bq = 0; bq < 3; ++bq) G[13 + bq] = CK(4, bq);
    SORT16_DESC(G); MERGE_TOP16(C, G);
#pragma unroll
    for (int bq = 0; bq < 4; ++bq) G[bq] = CK(3, bq);
    G[4] = CK(5, 0); G[5] = CK(5, 1); G[6] = CK(6, 0); G[7] = CK(6, 1); G[8] = CK(7, 0); G[9] = CK(7, 1);
    G[10] = CK(8, 0); G[11] = CK(9, 0); G[12] = CK(10, 0); G[13] = CK(11, 0); G[14] = CK(12, 0); G[15] = CK(13, 0);
    SORT16_DESC(G); MERGE_TOP16(C, G);
    INS16(C, CK(14, 0)); INS16(C, CK(15, 0));
#undef CK
    float tv[16]; float sum = 0.f;
    const float mx = dec_key(C[0] & ~255);
#pragma unroll
    for (int s = 0; s < 16; ++s) { tv[s] = __expf(dec_key(C[s] & ~255) - mx); sum += tv[s]; }
    const float rinv = 1.f / sum;
    unsigned* ex = (unsigned*)(p.ws + WS_EXP) + (size_t)t * 128 + h * 16 + hh * 8;
    u32x4 eo[2];
#pragma unroll
    for (int s = 0; s < 8; ++s) {
        const int hm = -hh;
        const unsigned cs = (unsigned)(C[s] ^ ((C[s] ^ C[s + 8]) & hm));
        const float gv = __uint_as_float(__float_as_uint(tv[s]) ^ ((__float_as_uint(tv[s]) ^ __float_as_uint(tv[s + 8])) & (unsigned)hm)) * rinv;
        const unsigned pos = cs & 255u, a = pos >> 4, bq = pos & 15u;
        const unsigned i1 = (unsigned)(((a & 8u) ? I1hi : I1lo) >> (8 * (a & 7u))) & 127u;
        const unsigned i2 = (unsigned)(((bq & 8u) ? I2hi : I2lo) >> (8 * (bq & 7u))) & 127u;
        eo[s >> 2][s & 3] = (i1 * 128u + i2) | (cvt_pk_bf16(gv, 0.f) << 16);
    }
    *(u32x4*)ex = eo[0]; *(u32x4*)(ex + 4) = eo[1];
}

__device__ __forceinline__ void topk_stage(const P& p, char* smem, int bid) {
    const int t = (int)threadIdx.x - 320;
    if (t < 0) return;
    const bf16_t* sk = (const bf16_t*)(p.ws + WS_SK) + (size_t)(bid & 7) * 2 * 128 * 128;
    u32x4 v[22];
#pragma unroll
    for (int i = 0; i < 22; ++i) { const int idx = t + 192 * i; if (idx < 4096) v[i] = *(const u32x4*)(sk + (size_t)idx * 8); }
#pragma unroll
    for (int i = 0; i < 22; ++i) { const int idx = t + 192 * i; if (idx < 4096) *(u32x4*)(smem + (idx >> 4) * SK_ROW + (idx & 15) * 16) = v[i]; }
}
__device__ __forceinline__ void topk_phase(const P& p, char* smem, int bid, int nblk) {
    const int tid = tidx(), lane = tid & 63, wid = tid >> 6, h = bid & 7;
    const int nslots = (nblk >> 3) * NWAVE;
    QFrag qf;
    const int tt0 = (bid >> 3) * NWAVE + wid;
    if (tt0 < T / 32) topk_load_q(qf, p, tt0, h, lane);

    for (int tt = tt0; tt < T / 32; tt += nslots) topk_task(p, smem, qf, tt, tt + nslots, h, lane);
    __syncthreads();
}

__device__ __forceinline__ float gelu_erf(float v) { return 0.5f * v * (1.f + erff(v * 0.70710678118654752f)); }

struct PeerIdx { int e0, e1; };
struct Rows8 { u32x4 r[8]; float sc[8]; };
__device__ __forceinline__ void peer_rows8(Rows8& b, const unsigned char* tab, const float* scale, const PeerIdx& ix, int jb, int lane) {
#pragma unroll
    for (int q = 0; q < 8; ++q) {
        const int e = __builtin_amdgcn_readlane(jb < 64 ? ix.e0 : ix.e1, (jb + q) & 63);
        b.r[q] = *(const u32x4*)(tab + (size_t)e * 1024 + 16 * lane);
        b.sc[q] = scale[e];
    }
}
struct Rows16h { u32x4 r[8]; float sc[8]; };
__device__ __forceinline__ void peer_rows16h(Rows16h& b, const unsigned char* tab, const float* scale, const PeerIdx& ix, int jb, int lane) {
    const int hh = lane >> 5, l5 = lane & 31;
#pragma unroll
    for (int i = 0; i < 8; ++i) {
        const int ee = __builtin_amdgcn_readlane(jb < 64 ? ix.e0 : ix.e1, (jb + 2 * i) & 63);
        const int eo = __builtin_amdgcn_readlane(jb < 64 ? ix.e0 : ix.e1, (jb + 2 * i + 1) & 63);
        const int e = hh ? eo : ee;
        b.r[i] = *(const u32x4*)(tab + (size_t)e * 512 + 16 * l5);
        b.sc[i] = scale[e];
    }
}
__device__ __forceinline__ void stage_scales(const float* src, char* smem) {
    for (int i = tidx(); i < 4096; i += NTHR) ((f32x4*)smem)[i] = ((const f32x4*)src)[i];
    __syncthreads();
}
__device__ __forceinline__ int peer_down_reduce8(const int (&dot)[8], int lane) {
    const int b4 = lane & 16, b3 = lane & 8, b2 = lane & 4;
    int k4[4], k2[2];
#pragma unroll
    for (int j = 0; j < 4; ++j) { const int snd = b4 ? dot[j] : dot[j + 4]; k4[j] = (b4 ? dot[j + 4] : dot[j]) + __shfl_xor(snd, 16); }
#pragma unroll
    for (int j = 0; j < 2; ++j) { const int snd = b3 ? k4[j] : k4[j + 2]; k2[j] = (b3 ? k4[j + 2] : k4[j]) + __shfl_xor(snd, 8); }
    const int snd = b2 ? k2[0] : k2[1];
    int v = (b2 ? k2[1] : k2[0]) + __shfl_xor(snd, 4);
    v += __shfl_xor(v, 2); v += __shfl_xor(v, 1);
    return v;
}
struct DownIn { u32x4 hraw[4]; float sq; };
__device__ __forceinline__ void down_in_load(DownIn& d, const P& p, int t, int lane) {
    const bf16_t* hrow = (const bf16_t*)(p.ws + WS_X1) + (size_t)t * D + 32 * (lane & 31);
#pragma unroll
    for (int i = 0; i < 4; ++i) d.hraw[i] = *(const u32x4*)(hrow + 8 * i);
    d.sq = ((const float*)(p.ws + WS_SSQ))[(size_t)t * 16 + (lane & 15)];
}
struct SlotRec { unsigned rc0, rc1; };
__device__ __forceinline__ void rec_load(SlotRec& r, const unsigned char* ws, size_t base, int t, int lane) {
    const unsigned* ex = (const unsigned*)(ws + base) + (size_t)t * 128;
    r.rc0 = ex[lane]; r.rc1 = ex[64 + lane];
}
#define PEER_PAIR_LOAD(dst, tab, e0v, e1v, m) do { \
    const int ee_ = __builtin_amdgcn_readlane((m) < 32 ? (e0v) : (e1v), (2 * (m)) & 63), eo_ = __builtin_amdgcn_readlane((m) < 32 ? (e0v) : (e1v), (2 * (m) + 1) & 63); \
    dst = *(const u32x4*)((tab) + ((unsigned)(hh ? eo_ : ee_) * 512u + l5off)); } while (0)
constexpr int PEER_IDS_LDS = 98304;
constexpr int DGRP = 8;
__device__ __forceinline__ int peer_ids_slot(int s) { return (s >> 3) * 8 + (s & 1) * 4 + ((s >> 1) & 3); }
struct DownQ { unsigned Hhi[4], Hlo[4]; float hscale, hbias; };
__device__ __forceinline__ void down_quant(DownQ& q, DownIn& din, int t, const float* GS2, const float* SH2, int lane) {
    float mx = 0.f;
    {
        const float rstd = rsqrtf(wave_sum(din.sq) * (0.25f / D) + EPS);
        const float* gsb = GS2 + (t >> 13) * 1024 + 32 * (lane & 31); const float* shb = SH2 + (t >> 13) * 1024 + 32 * (lane & 31);
#pragma unroll
        for (int i = 0; i < 4; ++i) {
            const f32x4 ga = *(const f32x4*)(gsb + 8 * i), gb = *(const f32x4*)(gsb + 8 * i + 4), sa = *(const f32x4*)(shb + 8 * i), sb = *(const f32x4*)(shb + 8 * i + 4);
#pragma unroll
            for (int k = 0; k < 4; ++k) {
                const float g0 = k < 2 ? ga[2 * k] : gb[2 * k - 4], g1 = k < 2 ? ga[2 * k + 1] : gb[2 * k - 3], s0 = k < 2 ? sa[2 * k] : sb[2 * k - 4], s1 = k < 2 ? sa[2 * k + 1] : sb[2 * k - 3];
                const float h0 = (bf_lo(din.hraw[i][k]) * rstd) * g0 + s0, h1 = (bf_hi(din.hraw[i][k]) * rstd) * g1 + s1;
                din.hraw[i][k] = cvt_pk_bf16(h0, h1);
                mx = fmaxf(mx, fmaxf(fabsf(h0), fabsf(h1)));
            }
        }
    }
    mx = wave_max(mx);
    const float qs = mx > 0.f ? 119.f / mx : 1.f;
    q.hscale = mx > 0.f ? mx * (1.f / 119.f) : 1.f;
    float hsum = 0.f;
#pragma unroll
    for (int d = 0; d < 4; ++d) {
        float ve[4], vo[4];
#pragma unroll
        for (int k = 0; k < 4; ++k) { ve[k] = __builtin_rintf(bf_lo(din.hraw[d][k]) * qs); vo[k] = __builtin_rintf(bf_hi(din.hraw[d][k]) * qs); hsum += ve[k] + vo[k]; }
        const unsigned E = pack_i8x4(ve[0], ve[1], ve[2], ve[3]), O = pack_i8x4(vo[0], vo[1], vo[2], vo[3]);
        const unsigned tE = ((E & 0x7f7f7f7fu) + 0x08080808u) ^ (E & 0x80808080u), tO = ((O & 0x7f7f7f7fu) + 0x08080808u) ^ (O & 0x80808080u);
        q.Hhi[d] = ((tE >> 4) & 0x0f0f0f0fu) | (tO & 0xf0f0f0f0u);
        q.Hlo[d] = ((tE & 0x0f0f0f0fu) | ((tO << 4) & 0xf0f0f0f0u)) ^ 0x88888888u;
    }
    q.hbias = 0.25f * wave_sum(hsum);
}
template <int MODE, int N0, int N1>
__device__ __forceinline__ void down_steps(const P& p, u32x4 (&ring)[32], int (&res)[8], int (&dot)[8], u32x4 (&o4)[2], u32x4& o4n, const DownQ& qc, const char* tcur, const char* tnxt,
                                           const unsigned char* ED, unsigned l5off0, int lane, DownIn& din, int tnext) {
#pragma unroll
    for (int n = N0; n < N1; ++n) {
                u32x4& rr = ring[n & 31];
                if (MODE == 1) dot[n & 7] = (int)((rr[0] ^ rr[1] ^ rr[2] ^ rr[3]) & 0xffffu);
                else {
                    int sh = 0, sl = 0;
#pragma unroll
                    for (int d = 0; d < 4; ++d) {
                        sh = __builtin_amdgcn_sdot8((int)rr[d], (int)qc.Hhi[d], sh, false);
                        sl = __builtin_amdgcn_sdot8((int)rr[d], (int)qc.Hlo[d], sl, false);
                    }
                    dot[n & 7] = (sh << 4) + sl;
                }
                if ((n & 3) == 0) {
                    o4[(n >> 2) & 1] = o4n;
                    const int q = n + 4 + 32;
                    o4n = *(const u32x4*)((q < 64 ? tcur : tnxt) + 32 * ((q & 63) >> 2));
                }
                if (MODE != 2 && (n % DGRP) == DGRP - 1) {
                    unsigned off[DGRP];
#pragma unroll
                    for (int i = 0; i < DGRP; ++i) { const int m = n - (DGRP - 1) + i; off[i] = o4[(m >> 2) & 1][m & 3] + l5off0; }
                    asm volatile("" : "+v"(off[0]) : "v"(dot[n & 7]));
#pragma unroll
                    for (int i = 0; i < DGRP; ++i) { if (i) asm volatile("" : "+v"(off[i]) : "v"(off[i - 1])); ring[(n - (DGRP - 1) + i) & 31] = *(const u32x4*)(ED + off[i]); }
                }
                __builtin_amdgcn_sched_barrier(0);
                if ((n & 7) == 7) res[n >> 3] = peer_down_reduce8(dot, lane);
                if (n == 15) down_in_load(din, p, tnext, lane);
                }
}
__device__ __forceinline__ void down_stage(const P& p, char* smem) {
    const int t = (int)threadIdx.x - 64;
    if (t < 0) return;
    f32x4* GS2 = (f32x4*)(smem + 65536); f32x4* SH2 = GS2 + 1024;
    f32x4 g[3], sc[3], sh[3], r[10];
#pragma unroll
    for (int k = 0; k < 3; ++k) {
        const int i = t + 448 * k;
        if (i < 1024) { const float* mb = (const float*)(p.ws + WS_MOD) + (i >> 8) * NMOD; g[k] = ((const f32x4*)p.g_ffn)[i & 255]; sc[k] = ((const f32x4*)(mb + 4096))[i & 255]; sh[k] = ((const f32x4*)(mb + 3072))[i & 255]; }
    }
#pragma unroll
    for (int k = 0; k < 10; ++k) { const int i = t + 448 * k; if (i < 4096) r[k] = ((const f32x4*)(p.ws + WS_RSD))[i]; }
#pragma unroll
    for (int k = 0; k < 3; ++k) { const int i = t + 448 * k; if (i < 1024) { GS2[i] = g[k] * (sc[k] + 1.f); SH2[i] = sh[k]; } }
#pragma unroll
    for (int k = 0; k < 10; ++k) { const int i = t + 448 * k; if (i < 4096) ((f32x4*)smem)[i] = r[k]; }
}
template <int MODE = 0>
__device__ __forceinline__ void peer_down_pass(const P& p, char* smem, int bid, int nblk) {
    const int tid = tidx(), lane = tid & 63, wid = tid >> 6, hh = lane >> 5;
    const unsigned l5off0 = 16u * (lane & 31);
    float* GS2 = (float*)(smem + 65536); float* SH2 = GS2 + 4096;
    const float* RSD = (const float*)smem;
    const unsigned char* ED = p.ws + WS_ED;
    char* idtab = smem + PEER_IDS_LDS + wid * 1024;
    const int wofs = 4 * peer_ids_slot(lane), rofs = 16 * hh;
    const int t0 = bid * NWAVE + wid, tstep = nblk * NWAVE;
    if (t0 < T) {
        DownIn din; SlotRec rec, recn;
        rec_load(rec, p.ws, WS_EXP, t0, lane);
        rec_load(recn, p.ws, WS_EXP, t0 + tstep < T ? t0 + tstep : t0, lane);
        down_in_load(din, p, t0, lane);
#pragma unroll
        for (int i = 0; i < 4; ++i) asm volatile("" : "+v"(din.hraw[i]), "+v"(din.sq));
        asm volatile("" : "+v"(recn.rc0), "+v"(recn.rc1));
        DownQ qn; down_quant(qn, din, t0, GS2, SH2, lane);
        int cur = 0;
        *(unsigned*)(idtab + wofs) = (rec.rc0 & 0xffffu) * 512u; *(unsigned*)(idtab + 256 + wofs) = (rec.rc1 & 0xffffu) * 512u;
        u32x4 ring[32];
#pragma unroll
        for (int B = 0; B < 8; ++B) {
            const u32x4 o4 = *(const u32x4*)(idtab + rofs + 32 * B);
#pragma unroll
            for (int k = 0; k < 4; ++k) { ring[4 * B + k] = *(const u32x4*)(ED + (o4[k] + l5off0)); __builtin_amdgcn_sched_barrier(0); }
        }
        u32x4 o4n = *(const u32x4*)(idtab + rofs + 32 * 8);
#pragma unroll 1
        for (int t = t0; t < T; t += tstep) {
            const unsigned rc0 = rec.rc0, rc1 = rec.rc1;
            const char* tcur = idtab + cur + rofs; const char* tnxt = idtab + (cur ^ 512) + rofs;
            *(unsigned*)(idtab + (cur ^ 512) + wofs) = (recn.rc0 & 0xffffu) * 512u; *(unsigned*)(idtab + (cur ^ 512) + 256 + wofs) = (recn.rc1 & 0xffffu) * 512u;
            cur ^= 512;
            rec = recn;
            rec_load(recn, p.ws, WS_EXP, t + 2 * tstep < T ? t + 2 * tstep : t, lane);
            const DownQ qc = qn;
            const float hscale = qc.hscale, hbias = qc.hbias;
            int res[8], dot[8];
            u32x4 o4[2];
            const int tnext = t + tstep < T ? t + tstep : t;
            down_steps<MODE, 0, 48>(p, ring, res, dot, o4, o4n, qc, tcur, tnxt, ED, l5off0, lane, din, tnext);
            down_quant(qn, din, tnext, GS2, SH2, lane);
            down_steps<MODE, 48, 64>(p, ring, res, dot, o4, o4n, qc, tcur, tnxt, ED, l5off0, lane, din, tnext);
            const int sl = (lane & 1) * 32 + ((lane >> 1) & 7) * 4, bsel = lane >> 4;
            int i0 = __shfl(res[0], sl), i1 = __shfl(res[4], sl);
#pragma unroll
            for (int k = 1; k < 4; ++k) { const int x0 = __shfl(res[k], sl), x1 = __shfl(res[4 + k], sl); i0 = bsel == k ? x0 : i0; i1 = bsel == k ? x1 : i1; }
            const float s0 = ((float)i0 + hbias) * (RSD[rc0 & 0xffffu] * hscale), s1 = ((float)i1 + hbias) * (RSD[rc1 & 0xffffu] * hscale);
            unsigned* act = (unsigned*)(p.ws + WS_ACT) + (size_t)t * 128;
            act[lane] = (rc0 & 0xffffu) | (cvt_pk_bf16(gelu_erf(s0) * bf_hi(rc0), 0.f) << 16); act[64 + lane] = (rc1 & 0xffffu) | (cvt_pk_bf16(gelu_erf(s1) * bf_hi(rc1), 0.f) << 16);
        }
    }
    __syncthreads();
}
__device__ __forceinline__ int xor32_geti(int v, int hh) { auto rr = __builtin_amdgcn_permlane32_swap((unsigned)v, (unsigned)v, false, false); return (int)(hh ? rr[0] : rr[1]); }
__device__ __forceinline__ unsigned up_pack_coef(int q) {
    const int a2 = __builtin_amdgcn_update_dpp(0, q, 0x102, 0xf, 0xf, true), a4 = __builtin_amdgcn_update_dpp(0, q, 0x104, 0xf, 0xf, true), a6 = __builtin_amdgcn_update_dpp(0, q, 0x106, 0xf, 0xf, true);
    return ((unsigned)q & 0xffu) | (((unsigned)a2 & 0xffu) << 8) | (((unsigned)a4 & 0xffu) << 16) | ((unsigned)a6 << 24);
}
constexpr int UPG = 8;
__device__ __forceinline__ void up_stage(const P& p, char* smem) {
    const int t = (int)threadIdx.x - 64;
    if (t < 0) return;
    f32x4 v[12];
#pragma unroll
    for (int k = 0; k < 12; ++k) {
        const int i = t + 448 * k;
        const f32x4* s = i < 4096 ? (const f32x4*)(p.ws + WS_RSU) + i : i < 4352 ? (const f32x4*)p.g_final + (i - 4096) : (const f32x4*)((const float*)(p.ws + WS_MOD) + ((i - 4352) >> 8) * NMOD + 5120) + ((i - 4352) & 255);
        v[k] = *s;
    }
#pragma unroll
    for (int k = 0; k < 12; ++k) ((f32x4*)smem)[t + 448 * k] = v[k];
}
template <int MODE = 0>
__device__ __forceinline__ void peer_up_pass(const P& p, char* smem, int bid, int nblk, float* outbuf) {
    const int tid = tidx(), lane = tid & 63, wid = tid >> 6, hh = lane >> 5;
    const unsigned l5off0 = 16u * (lane & 31);
    float* RSU = (float*)smem; float* GF = RSU + 16384; float* GT = GF + 1024;
    const unsigned char* EU = p.ws + WS_EU;
    const int col = 32 * (lane & 31) + 16 * hh;
    const int t0 = bid * NWAVE + wid, tstep = nblk * NWAVE;
    if (t0 < T) {
        SlotRec rec, recn;
        rec_load(rec, p.ws, WS_ACT, t0, lane);
        rec_load(recn, p.ws, WS_ACT, t0 + tstep < T ? t0 + tstep : t0, lane);
        asm volatile("" : "+v"(recn.rc0), "+v"(recn.rc1));
        u32x4 ring[4 * UPG];
        {
            const int e0 = (int)(rec.rc0 & 0xffffu);
            const unsigned l5off = l5off0;
#pragma unroll
            for (int m = 0; m < 4 * UPG; ++m) { PEER_PAIR_LOAD(ring[m], EU, e0, e0, m); __builtin_amdgcn_sched_barrier(0); }
        }
#pragma unroll 1
        for (int t = t0; t < T; t += tstep) {
            const unsigned rc0 = rec.rc0, rc1 = rec.rc1;
            const int e0 = (int)(rc0 & 0xffffu), e1 = (int)(rc1 & 0xffffu), e0n = (int)(recn.rc0 & 0xffffu);
            rec = recn;
            rec_load(recn, p.ws, WS_ACT, t + 2 * tstep < T ? t + 2 * tstep : t, lane);
            const float c0 = bf_hi(rc0) * RSU[rc0 & 0xffffu], c1 = bf_hi(rc1) * RSU[rc1 & 0xffffu];
            const float cmx = wave_max(fmaxf(fabsf(c0), fabsf(c1)));
            const float qs = cmx > 0.f ? 127.f * __builtin_amdgcn_rcpf(cmx) : 0.f, cstep = cmx * (1.f / 127.f);
            const int q0 = (int)__builtin_rintf(c0 * qs), q1 = (int)__builtin_rintf(c1 * qs);
            const float S = wave_sum((float)(q0 + q1));
            const unsigned P0 = up_pack_coef(q0), P1 = up_pack_coef(q1);
            int accF[16], accL[16];
#pragma unroll
            for (int i = 0; i < 16; ++i) { accF[i] = 0; accL[i] = 0; }
            u32x4 xa, xb;
#pragma unroll
            for (int G = 0; G < 16; ++G) {
                u32x4 (&r)[4] = *(u32x4 (*)[4])&ring[4 * (G % UPG)];
                if (MODE == 1) {
#pragma unroll
                    for (int k = 0; k < 4; ++k)
#pragma unroll
                        for (int d = 0; d < 4; ++d) accF[4 * k + d] ^= (int)r[k][d];
                } else {
                    const int ce = __builtin_amdgcn_readlane((int)(G < 8 ? P0 : P1), (8 * G) & 63), co = __builtin_amdgcn_readlane((int)(G < 8 ? P0 : P1), (8 * G + 1) & 63);
                    const int C = hh ? co : ce;
#pragma unroll
                    for (int d = 0; d < 4; ++d) {
                        const unsigned p01l = __builtin_amdgcn_perm(r[1][d], r[0][d], 0x05010400u), p01h = __builtin_amdgcn_perm(r[1][d], r[0][d], 0x07030602u);
                        const unsigned p23l = __builtin_amdgcn_perm(r[3][d], r[2][d], 0x05010400u), p23h = __builtin_amdgcn_perm(r[3][d], r[2][d], 0x07030602u);
                        unsigned tb[4];
                        tb[0] = __builtin_amdgcn_perm(p23l, p01l, 0x05040100u); tb[1] = __builtin_amdgcn_perm(p23l, p01l, 0x07060302u);
                        tb[2] = __builtin_amdgcn_perm(p23h, p01h, 0x05040100u); tb[3] = __builtin_amdgcn_perm(p23h, p01h, 0x07060302u);
#pragma unroll
                        for (int b = 0; b < 4; ++b) {
                            accF[4 * d + b] = __builtin_amdgcn_sdot4((int)tb[b], C, accF[4 * d + b], false);
                            accL[4 * d + b] = __builtin_amdgcn_sdot4((int)(tb[b] & 0x0f0f0f0fu), C, accL[4 * d + b], false);
                        }
                    }
                }
                if (MODE != 2) {
                    unsigned l5off = l5off0;
#define ACC16(a) "v"(a[0]), "v"(a[1]), "v"(a[2]), "v"(a[3]), "v"(a[4]), "v"(a[5]), "v"(a[6]), "v"(a[7]), "v"(a[8]), "v"(a[9]), "v"(a[10]), "v"(a[11]), "v"(a[12]), "v"(a[13]), "v"(a[14]), "v"(a[15])
                    asm volatile("" : "+v"(l5off) : ACC16(accF));
                    asm volatile("" : "+v"(l5off) : ACC16(accL));
#undef ACC16
#pragma unroll
                    for (int k = 0; k < 4; ++k) {
                        if (G + UPG < 16) PEER_PAIR_LOAD(r[k], EU, e0, e1, 4 * (G + UPG) + k);
                        else              PEER_PAIR_LOAD(r[k], EU, e0n, e0n, 4 * (G + UPG - 16) + k);
                    }
                    __builtin_amdgcn_sched_barrier(0);
                }
                if (G == 11) {
                    const bf16_t* xrow = (const bf16_t*)(p.ws + WS_X1) + (size_t)t * D + col;
                    xa = *(const u32x4*)xrow; xb = *(const u32x4*)(xrow + 8);
                }
            }
            float tot[16];
#pragma unroll
            for (int j = 0; j < 8; ++j) {
                const int F = (hh ? accF[8 + j] : accF[j]) + xor32_geti(hh ? accF[j] : accF[8 + j], hh);
                const int L = (hh ? accL[8 + j] : accL[j]) + xor32_geti(hh ? accL[j] : accL[8 + j], hh);
                tot[2 * j] = ((float)L - 7.5f * S) * cstep;
                tot[2 * j + 1] = ((float)(F - L) * 0.0625f + 0.5f * S) * cstep;
            }
            float xv[16];
#pragma unroll
            for (int i = 0; i < 4; ++i) { xv[2 * i] = bf_lo(xa[i]); xv[2 * i + 1] = bf_hi(xa[i]); xv[8 + 2 * i] = bf_lo(xb[i]); xv[8 + 2 * i + 1] = bf_hi(xb[i]); }
            const float* gt = GT + (t >> 13) * 1024 + col;
            f32x4 x2[4]; float ss = 0.f;
#pragma unroll
            for (int i = 0; i < 4; ++i) {
                const f32x4 g = *(const f32x4*)(gt + 4 * i);
#pragma unroll
                for (int e = 0; e < 4; ++e) { const float y = xv[4 * i + e] + g[e] * tot[4 * i + e]; x2[i][e] = y; ss += y * y; }
            }
            const float inv = rsqrtf(wave_sum(ss) * (1.f / D) + EPS);
#pragma unroll
            for (int i = 0; i < 4; ++i) *(f32x4*)(outbuf + (size_t)t * D + col + 4 * i) = x2[i] * inv * *(const f32x4*)(GF + col + 4 * i);
        }
    }
}

#define XB_TMO      128
#define XB_XCNT(j)  (256  + 64 * (j))
#define XB_XSUB(j)  (1280 + 64 * (j))
#define XB_XGEN(j)  (2304 + 64 * (j))
#define XB_TOP      3328
#define XB_TOPGEN   3392
#define XCD_BAR_WORDS 3456
#define XB_SPIN_CAP (1u << 18)
__device__ __forceinline__ unsigned xb_ld(unsigned* p)              { return __hip_atomic_load(p, __ATOMIC_RELAXED, __HIP_MEMORY_SCOPE_AGENT); }
__device__ __forceinline__ unsigned xb_add(unsigned* p, unsigned v) { return __hip_atomic_fetch_add(p, v, __ATOMIC_RELAXED, __HIP_MEMORY_SCOPE_AGENT); }
__device__ __forceinline__ unsigned xb_xcc_id() { return (unsigned)__builtin_amdgcn_s_getreg((3 << 11) | 20) & 0xFu; }
#define XB_SPIN(cond, bar) do { unsigned _sp = 0; while (cond) { __builtin_amdgcn_s_sleep(1); \
    if ((++_sp & 255u) == 0u) { if (xb_ld(&(bar)[XB_TMO])) break; if (_sp > XB_SPIN_CAP) { atomicAdd(&(bar)[XB_TMO], 1u); break; } } } } while (0)
struct XcdBarrier { unsigned* bar; unsigned x; volatile unsigned* st; };
__device__ __forceinline__ XcdBarrier xcd_barrier_post(unsigned* bar, volatile unsigned* st) {
    XcdBarrier b; b.bar = bar; b.x = xb_xcc_id(); b.st = st;
    if (threadIdx.x == 0) (void)xb_add(&bar[XB_XCNT(b.x)], 1u);
    return b;
}
__device__ __forceinline__ void xcd_barrier_complete(unsigned* bar, unsigned x, unsigned& nloc, unsigned& nx) {
    const unsigned G = gridDim.x * gridDim.y * gridDim.z;
    unsigned sum, cnt, mine, sp = 0u;
    for (;;) {
        sum = 0u; cnt = 0u; mine = 0u;
#pragma unroll
        for (unsigned j = 0; j < 16; ++j) { const unsigned c = xb_ld(&bar[XB_XCNT(j)]); sum += c; cnt += (c > 0u) ? 1u : 0u; mine = (j == x) ? c : mine; }
        if (sum == G) break;
        __builtin_amdgcn_s_sleep(1);
        if ((++sp & 255u) == 0u) { if (xb_ld(&bar[XB_TMO])) break; if (sp > XB_SPIN_CAP) { atomicAdd(&bar[XB_TMO], 1u); break; } }
    }
    nloc = mine > 0u ? mine : 1u; nx = cnt > 0u ? cnt : 1u;
}
__device__ __forceinline__ void xcd_barrier(const XcdBarrier& b) {
    asm volatile("s_waitcnt vmcnt(0)" ::: "memory");
    __syncthreads();
    if (threadIdx.x == 0) {
        unsigned* bar = b.bar;
        __builtin_amdgcn_s_waitcnt(0);
        unsigned nloc = b.st[0], nx = b.st[1];
        if (nloc == 0u) { xcd_barrier_complete(bar, b.x, nloc, nx); b.st[0] = nloc; b.st[1] = nx; }
        const unsigned old = xb_add(&bar[XB_XSUB(b.x)], 1u);
        const unsigned gen = old / nloc;
        if (old + 1u == (gen + 1u) * nloc) {
            __builtin_amdgcn_fence(__ATOMIC_RELEASE, "agent");
            asm volatile("s_waitcnt vmcnt(0)" ::: "memory");
            const unsigned og = xb_add(&bar[XB_TOP], 1u);
            const unsigned tgt = (og / nx + 1u) * nx;
            if (og + 1u != tgt) XB_SPIN(xb_ld(&bar[XB_TOP]) < tgt, bar);
            __builtin_amdgcn_fence(__ATOMIC_ACQUIRE, "agent");
            xb_add(&bar[XB_XGEN(b.x)], 1u);
            asm volatile("s_waitcnt vmcnt(0)" ::: "memory");
        } else {
            XB_SPIN(xb_ld(&bar[XB_XGEN(b.x)]) == gen, bar);
            __builtin_amdgcn_fence(__ATOMIC_ACQUIRE, "agent");
            asm volatile("s_waitcnt vmcnt(0)" ::: "memory");
        }
    }
    __syncthreads();
}
template <class F>
__device__ __forceinline__ void xcd_barrier_hook(const XcdBarrier& b, F&& f) {
    asm volatile("s_waitcnt vmcnt(0)" ::: "memory");
    __syncthreads();
    f();
    if (threadIdx.x == 0) {
        unsigned* bar = b.bar;
        __builtin_amdgcn_s_waitcnt(0);
        unsigned nloc = b.st[0], nx = b.st[1];
        if (nloc == 0u) { xcd_barrier_complete(bar, b.x, nloc, nx); b.st[0] = nloc; b.st[1] = nx; }
        const unsigned old = xb_add(&bar[XB_XSUB(b.x)], 1u);
        const unsigned gen = old / nloc;
        if (old + 1u == (gen + 1u) * nloc) {
            __builtin_amdgcn_fence(__ATOMIC_RELEASE, "agent");
            asm volatile("s_waitcnt vmcnt(0)" ::: "memory");
            const unsigned og = xb_add(&bar[XB_TOP], 1u);
            const unsigned tgt = (og / nx + 1u) * nx;
            if (og + 1u != tgt) XB_SPIN(xb_ld(&bar[XB_TOP]) < tgt, bar);
            __builtin_amdgcn_fence(__ATOMIC_ACQUIRE, "agent");
            xb_add(&bar[XB_XGEN(b.x)], 1u);
            asm volatile("s_waitcnt vmcnt(0)" ::: "memory");
        } else {
            XB_SPIN(xb_ld(&bar[XB_XGEN(b.x)]) == gen, bar);
            __builtin_amdgcn_fence(__ATOMIC_ACQUIRE, "agent");
            asm volatile("s_waitcnt vmcnt(0)" ::: "memory");
        }
    }
    __syncthreads();
}

__global__ void __launch_bounds__(NTHR, 2) mega_kernel(P p) {
    extern __shared__ __attribute__((aligned(16))) char smem[];
    const int bid = blockIdx.x, nblk = gridDim.x;
    volatile unsigned* st = (volatile unsigned*)(smem + STAGE_LDS);
    if (threadIdx.x < 16) st[threadIdx.x] = 0u;
    __syncthreads();
    const XcdBarrier bar = xcd_barrier_post((unsigned*)(p.ws + WS_BAR), st);
    p0_mod(p, smem, bid, nblk);
    xcd_barrier_hook(bar, [&]() { norm1_stage(p, smem); hook_quads(p, bid, nblk, 0, 7); });
    p0_convert(p, smem, bid, nblk);
    p1_norm1(p, smem, bid, nblk);
#if PROBE_DUP == 1
    __syncthreads(); p1_norm1(p, smem, bid, nblk);
#endif
#if PROBE_DUP == 0
    __syncthreads(); p0_convert(p, smem, bid, nblk);
#endif
    xcd_barrier_hook(bar, [&]() { hook_quads(p, bid, nblk, 7, 6); });
    gemm_proj(p, smem);
#if PROBE_DUP == 2
    gemm_proj(p, smem);
#endif
    xcd_barrier_hook(bar, [&]() { hook_quads(p, bid, nblk, 13, 6); });
    attn_phase(p, smem, bid, nblk);
#if PROBE_DUP == 3
    attn_phase(p, smem, bid, nblk, 1);
#endif
#if PROBE_DUP == 33
    attn_phase<1>(p, smem, bid, nblk, 1);
#endif
#if PROBE_DUP == 41
    attn_phase<9>(p, smem, bid, nblk, 1);
#endif
    xcd_barrier_hook(bar, [&]() { hook_quads(p, bid, nblk, 19, 6); });
    gemm_out(p, smem);
#if PROBE_DUP == 4
    gemm_out(p, smem);
#endif
    xcd_barrier_hook(bar, [&]() { hook_quads(p, bid, nblk, 25, 6); });
    gemm_query(p, smem);
#if PROBE_DUP == 6
    gemm_query(p, smem);
#endif
    xcd_barrier_hook(bar, [&]() { topk_stage(p, smem, bid); hook_quads(p, bid, nblk, 31, 1); });
    topk_phase(p, smem, bid, nblk);
#if PROBE_DUP == 7
    __syncthreads(); topk_stage(p, smem, bid); __syncthreads(); topk_phase(p, smem, bid, nblk);
#endif
    xcd_barrier_hook(bar, [&]() { down_stage(p, smem); });
#if PROBE_DUP == 8
    peer_down_pass(p, smem, bid, nblk);
#endif
#if PROBE_DUP == 9
    peer_down_pass(p, smem, bid, nblk); xcd_barrier(bar);
    peer_up_pass(p, smem, bid, nblk, (float*)(p.ws + WS_QF));
#endif
#if PROBE_DUP == 13
    peer_down_pass<1>(p, smem, bid, nblk);
#endif
#if PROBE_DUP == 14
    peer_down_pass<2>(p, smem, bid, nblk);
#endif
#if PROBE_DUP == 15
    peer_down_pass<3>(p, smem, bid, nblk);
#endif
#if PROBE_DUP == 16
    peer_down_pass<0>(p, smem, bid, nblk);
#endif
    peer_down_pass(p, smem, bid, nblk);
    xcd_barrier_hook(bar, [&]() { up_stage(p, smem); });
#if PROBE_DUP == 10
    peer_up_pass<0>(p, smem, bid, nblk, p.out); __syncthreads();
#endif
#if PROBE_DUP == 11
    peer_up_pass<1>(p, smem, bid, nblk, p.out); __syncthreads();
#endif
#if PROBE_DUP == 12
    peer_up_pass<2>(p, smem, bid, nblk, p.out); __syncthreads();
#endif
    peer_up_pass(p, smem, bid, nblk, p.out);
}

extern "C" void kernel_launch(void* const* d_in, const int* in_sizes, int n_in, void* d_out, int out_size, void* d_ws, size_t ws_size, hipStream_t stream) {
    if (n_in != 16 || out_size != T * D || ws_size < WS_END) { fprintf(stderr, "kernel_launch: unexpected shapes (n_in %d out %d ws %zu)\n", n_in, out_size, ws_size); return; }
    P p{};
    p.x = (const float*)d_in[0]; p.c = (const float*)d_in[1]; p.w_ada = (const float*)d_in[2]; p.b_ada = (const float*)d_in[3];
    p.g_mix = (const float*)d_in[4]; p.w_in = (const float*)d_in[5]; p.b_forget = (const float*)d_in[6]; p.g_fox = (const float*)d_in[7];
    p.g_sb = (const float*)d_in[8]; p.w_out = (const float*)d_in[9]; p.g_ffn = (const float*)d_in[10]; p.w_query = (const float*)d_in[11];
    p.sub_keys = (const float*)d_in[12]; p.e_down = (const float*)d_in[13]; p.e_up = (const float*)d_in[14]; p.g_final = (const float*)d_in[15];
    p.out = (float*)d_out; p.ws = (unsigned char*)d_ws;
    (void)hipMemsetAsync((char*)d_ws + WS_KMAX, 0, 24 * 1024, stream);
    static int grid_blocks = 0;
    if (!grid_blocks) {
        int dev = 0, cus = 0, per_cu = 0;
        (void)hipGetDevice(&dev);
        (void)hipDeviceGetAttribute(&cus, hipDeviceAttributeMultiprocessorCount, dev);
        (void)hipFuncSetAttribute((const void*)mega_kernel, hipFuncAttributeMaxDynamicSharedMemorySize, LDS_BYTES);
        (void)hipOccupancyMaxActiveBlocksPerMultiprocessor(&per_cu, mega_kernel, NTHR, LDS_BYTES);
        if (per_cu > 1) per_cu = 1;
        grid_blocks = cus * per_cu;
        if (grid_blocks % 8) grid_blocks -= grid_blocks % 8;
    }
    void* args[] = {&p};
    hipError_t e = hipLaunchCooperativeKernel((void*)mega_kernel, dim3(grid_blocks), dim3(NTHR), args, LDS_BYTES, stream);
    if (e != hipSuccess) fprintf(stderr, "cooperative launch failed: %s (grid %d)\n", hipGetErrorString(e), grid_blocks);
}
```
